# Optimizing an MI355X kernel written in HIP

```python
import math
import jax, jax.numpy as jnp
from jax import lax
import numpy as np

D_MODEL = 1024
BATCH = 4
SEQ = 4096
DEPTH = 2

HEAD_DIM = 64
SB_HEADS = D_MODEL // HEAD_DIM
SW_Q_HEADS = D_MODEL // HEAD_DIM
SW_KV_HEADS = 4
WINDOW = 128
BLOCK = 128
PEER_HEADS = 8
PEER_KEYS = 128
PEER_N_EXPERTS = PEER_KEYS * PEER_KEYS
PEER_QDIM = 256
PEER_HALF = PEER_QDIM // 2
PEER_TOPK = 16
PEER_CHUNK = 128
RMS_EPS = 1e-6
N_SB = (DEPTH + 1) // 2
N_SW = DEPTH // 2

kernel_name = 'hybrid_stickbreak_swa_sink_peer'


def rmsnorm(x, gain):
    xf = x.astype(jnp.float32)
    y = xf * lax.rsqrt(jnp.mean(xf * xf, axis=-1, keepdims=True) + RMS_EPS)
    return (y * gain.astype(jnp.float32)).astype(x.dtype)


def alibi_slopes(n_heads):
    return jnp.asarray(2.0 ** (-8.0 * np.arange(1, n_heads + 1) / n_heads), dtype=jnp.float32)


def stick_breaking_attention(x, w_qkv, w_o):
    B, S, _ = x.shape
    qkv = x @ w_qkv
    q, k, v = jnp.split(qkv, 3, axis=-1)
    to_heads = lambda a: a.reshape(B, S, SB_HEADS, HEAD_DIM).transpose(0, 2, 1, 3)
    q, k, v = to_heads(q), to_heads(k), to_heads(v)
    scale = HEAD_DIM ** -0.5
    outs = []
    for n in range(S // BLOCK):
        t0 = n * BLOCK
        end = t0 + BLOCK
        z = jnp.einsum('bhtd,bhsd->bhts', q[:, :, t0:end], k[:, :, :end]).astype(jnp.float32) * scale
        t_pos = t0 + jnp.arange(BLOCK)[:, None]
        s_pos = jnp.arange(end)[None, :]
        causal = s_pos < t_pos
        log_fail = jnp.where(causal, jax.nn.log_sigmoid(-z), 0.0)
        suffix = lax.cumsum(log_fail, axis=3, reverse=True) - log_fail
        log_a = jax.nn.log_sigmoid(z) + suffix
        a = jnp.where(causal, jnp.exp(log_a), 0.0)
        outs.append(jnp.einsum('bhts,bhsd->bhtd', a.astype(v.dtype), v[:, :, :end]))
    o = jnp.concatenate(outs, axis=2)
    o = o.transpose(0, 2, 1, 3).reshape(B, S, SB_HEADS * HEAD_DIM)
    return o @ w_o


def sliding_window_attention(x, w_qkv, q_gain, k_gain, sinks, w_o):
    B, S, _ = x.shape
    G = SW_Q_HEADS // SW_KV_HEADS
    nb = S // BLOCK
    qkv = x @ w_qkv
    q, k, v = jnp.split(qkv, [SW_Q_HEADS * HEAD_DIM, (SW_Q_HEADS + SW_KV_HEADS) * HEAD_DIM], axis=-1)
    q = rmsnorm(q.reshape(B, S, SW_KV_HEADS, G, HEAD_DIM), q_gain)
    k = rmsnorm(k.reshape(B, S, SW_KV_HEADS, HEAD_DIM), k_gain)
    v = v.reshape(B, S, SW_KV_HEADS, HEAD_DIM)
    qb = q.reshape(B, nb, BLOCK, SW_KV_HEADS, G, HEAD_DIM)

    def band(a):
        a = jnp.pad(a, ((0, 0), (BLOCK, 0), (0, 0), (0, 0)))
        a = a.reshape(B, nb + 1, BLOCK, SW_KV_HEADS, HEAD_DIM)
        return jnp.concatenate([a[:, :-1], a[:, 1:]], axis=2)

    kb, vb = band(k), band(v)
    scores = jnp.einsum('bnikgd,bnjkd->bnkgij', qb, kb).astype(jnp.float32) * (HEAD_DIM ** -0.5)
    i = jnp.arange(BLOCK)[:, None]
    j = jnp.arange(2 * BLOCK)[None, :]
    dist = BLOCK + i - j
    blk = jnp.arange(nb)[:, None, None]
    valid = (dist >= 0) & (dist < WINDOW) & (blk * BLOCK + j - BLOCK >= 0)
    slopes = alibi_slopes(SW_Q_HEADS).reshape(SW_KV_HEADS, G)
    scores = scores - slopes[:, :, None, None] * dist.astype(jnp.float32)
    scores = jnp.where(valid[None, :, None, None], scores, -jnp.inf)
    sink = sinks.astype(jnp.float32).reshape(SW_KV_HEADS, G)
    m = jnp.maximum(jnp.max(scores, axis=-1), sink[:, :, None])
    p = jnp.exp(scores - m[..., None])
    denom = jnp.sum(p, axis=-1) + jnp.exp(sink[:, :, None] - m)
    probs = (p / denom[..., None]).astype(vb.dtype)
    o = jnp.einsum('bnkgij,bnjkd->bnikgd', probs, vb)
    o = o.reshape(B, S, SW_Q_HEADS * HEAD_DIM)
    return o @ w_o


def peer(x, w_query, sub_keys, expert_u, expert_v):
    B, S, D = x.shape
    T = B * S
    xt = x.reshape(T, D)
    q = (xt @ w_query).reshape(T, PEER_HEADS, 2, PEER_HALF)
    sc = jnp.einsum('thpc,hpnc->thpn', q, sub_keys).astype(jnp.float32)
    top_s, top_i = lax.top_k(sc, PEER_TOPK)
    cand = top_s[:, :, 0, :, None] + top_s[:, :, 1, None, :]
    cand_s, cand_i = lax.top_k(cand.reshape(T, PEER_HEADS, PEER_TOPK * PEER_TOPK), PEER_TOPK)
    i1 = jnp.take_along_axis(top_i[:, :, 0], cand_i // PEER_TOPK, axis=-1)
    i2 = jnp.take_along_axis(top_i[:, :, 1], cand_i % PEER_TOPK, axis=-1)
    expert = i1 * PEER_KEYS + i2
    gate = jax.nn.softmax(cand_s, axis=-1)

    def chunk(args):
        xc, ec, gc = args
        h = jnp.einsum('cd,chkd->chk', xc, expert_u[ec])
        coef = (gc * jax.nn.gelu(h.astype(jnp.float32))).astype(xc.dtype)
        return jnp.einsum('chk,chkd->cd', coef, expert_v[ec])

    nc = T // PEER_CHUNK
    out = lax.map(chunk, (xt.reshape(nc, PEER_CHUNK, D),
                          expert.reshape(nc, PEER_CHUNK, PEER_HEADS, PEER_TOPK),
                          gate.reshape(nc, PEER_CHUNK, PEER_HEADS, PEER_TOPK)))
    return out.reshape(B, S, D)


def setup_inputs(seed: int = 0) -> dict:
    key = jax.random.key(seed)
    ks = jax.random.split(key, 16)
    nrm = lambda k, shape, s: jax.random.normal(k, shape, jnp.float32) * s
    gain = lambda k, shape: 1.0 + 0.02 * jax.random.normal(k, shape, jnp.float32)
    d_inv = D_MODEL ** -0.5
    sw_cols = (SW_Q_HEADS + 2 * SW_KV_HEADS) * HEAD_DIM
    return {
        'x': jax.random.normal(ks[0], (BATCH, SEQ, D_MODEL), jnp.float32),
        'sb_norm': gain(ks[1], (N_SB, D_MODEL)),
        'sb_w_qkv': nrm(ks[2], (N_SB, D_MODEL, 3 * SB_HEADS * HEAD_DIM), d_inv),
        'sb_w_o': nrm(ks[3], (N_SB, SB_HEADS * HEAD_DIM, D_MODEL), d_inv),
        'sw_norm': gain(ks[4], (N_SW, D_MODEL)),
        'sw_w_qkv': nrm(ks[5], (N_SW, D_MODEL, sw_cols), d_inv),
        'sw_q_gain': gain(ks[6], (N_SW, HEAD_DIM)),
        'sw_k_gain': gain(ks[7], (N_SW, HEAD_DIM)),
        'sw_sinks': nrm(ks[8], (N_SW, SW_Q_HEADS), 0.5),
        'sw_w_o': nrm(ks[9], (N_SW, SW_Q_HEADS * HEAD_DIM, D_MODEL), d_inv),
        'ffn_norm': gain(ks[10], (DEPTH, D_MODEL)),
        'peer_w_query': nrm(ks[11], (DEPTH, D_MODEL, PEER_HEADS * PEER_QDIM), d_inv),
        'peer_sub_keys': nrm(ks[12], (DEPTH, PEER_HEADS, 2, PEER_KEYS, PEER_HALF), PEER_HALF ** -0.5),
        'peer_u': nrm(ks[13], (DEPTH, PEER_N_EXPERTS, D_MODEL), d_inv),
        'peer_v': nrm(ks[14], (DEPTH, PEER_N_EXPERTS, D_MODEL), PEER_HEADS ** -0.5),
    }


def reference(x, sb_norm, sb_w_qkv, sb_w_o, sw_norm, sw_w_qkv, sw_q_gain, sw_k_gain, sw_sinks, sw_w_o,
              ffn_norm, peer_w_query, peer_sub_keys, peer_u, peer_v):
    h = x
    for i in range(DEPTH):
        j = i // 2
        if i % 2 == 0:
            h = h + stick_breaking_attention(rmsnorm(h, sb_norm[j]), sb_w_qkv[j], sb_w_o[j])
        else:
            h = h + sliding_window_attention(rmsnorm(h, sw_norm[j]), sw_w_qkv[j], sw_q_gain[j],
                                             sw_k_gain[j], sw_sinks[j], sw_w_o[j])
        h = h + peer(rmsnorm(h, ffn_norm[i]), peer_w_query[i], peer_sub_keys[i], peer_u[i], peer_v[i])
    return h
```

```cpp
#include <hip/hip_runtime.h>
#include <cstdint>
#include <cstdio>

namespace nv {
constexpr int D = 1024, B = 4, S = 4096, T = B * S, HD = 64;
constexpr int PH = 8, PK = 128, PTOP = 16;

__device__ __forceinline__ float wave_sum(float v) {
#pragma unroll
    for (int o = 1; o < 64; o <<= 1) v += __shfl_xor(v, o);
    return v;
}
__device__ __forceinline__ float wave_max(float v) {
#pragma unroll
    for (int o = 1; o < 64; o <<= 1) v = fmaxf(v, __shfl_xor(v, o));
    return v;
}
__device__ __forceinline__ float softplus(float z) { return fmaxf(z, 0.f) + log1pf(expf(-fabsf(z))); }
__device__ __forceinline__ float gelu_tanh(float x) {
    const float k = 0.7978845608028654f;
    return 0.5f * x * (1.f + tanhf(k * (x + 0.044715f * x * x * x)));
}

__global__ void __launch_bounds__(256) k_rmsnorm(const float* __restrict__ x, const float* __restrict__ g, float* __restrict__ y) {
    const int row = blockIdx.x * 4 + (threadIdx.x >> 6), lane = threadIdx.x & 63;
    const float4* xr = (const float4*)(x + (size_t)row * D);
    const float4* gr = (const float4*)g;
    float4 v[4]; float s = 0.f;
#pragma unroll
    for (int j = 0; j < 4; ++j) { v[j] = xr[lane + 64 * j]; s += v[j].x * v[j].x + v[j].y * v[j].y + v[j].z * v[j].z + v[j].w * v[j].w; }
    s = wave_sum(s);
    const float r = rsqrtf(s * (1.f / D) + 1e-6f);
    float4* yr = (float4*)(y + (size_t)row * D);
#pragma unroll
    for (int j = 0; j < 4; ++j) { const float4 gg = gr[lane + 64 * j]; float4 o; o.x = v[j].x * r * gg.x; o.y = v[j].y * r * gg.y; o.z = v[j].z * r * gg.z; o.w = v[j].w * r * gg.w; yr[lane + 64 * j] = o; }
}

__global__ void __launch_bounds__(256) k_gemm(const float* __restrict__ A, const float* __restrict__ W, const float* R, float* C, int M, int N, int K) {
    __shared__ float As[16][68];
    __shared__ float Bs[16][68];
    const int tid = threadIdx.x, tx = tid & 15, ty = tid >> 4;
    const int m0 = blockIdx.y * 64, n0 = blockIdx.x * 64;
    float acc[4][4];
#pragma unroll
    for (int i = 0; i < 4; ++i)
#pragma unroll
        for (int j = 0; j < 4; ++j) acc[i][j] = 0.f;
    const int ar = tid >> 2, ak = (tid & 3) * 4;
    const int bk = tid >> 4, bn = (tid & 15) * 4;
    for (int k0 = 0; k0 < K; k0 += 16) {
        const float4 a = *(const float4*)(A + (size_t)(m0 + ar) * K + k0 + ak);
        const float4 b = *(const float4*)(W + (size_t)(k0 + bk) * N + n0 + bn);
        __syncthreads();
        As[ak + 0][ar] = a.x; As[ak + 1][ar] = a.y; As[ak + 2][ar] = a.z; As[ak + 3][ar] = a.w;
        *(float4*)&Bs[bk][bn] = b;
        __syncthreads();
#pragma unroll
        for (int k = 0; k < 16; ++k) {
            const float4 av = *(const float4*)&As[k][ty * 4];
            const float4 bv = *(const float4*)&Bs[k][tx * 4];
            const float aa[4] = {av.x, av.y, av.z, av.w}, bb[4] = {bv.x, bv.y, bv.z, bv.w};
#pragma unroll
            for (int i = 0; i < 4; ++i)
#pragma unroll
                for (int j = 0; j < 4; ++j) acc[i][j] = fmaf(aa[i], bb[j], acc[i][j]);
        }
    }
#pragma unroll
    for (int i = 0; i < 4; ++i) {
        const size_t off = (size_t)(m0 + ty * 4 + i) * N + n0 + tx * 4;
        float4 o = {acc[i][0], acc[i][1], acc[i][2], acc[i][3]};
        if (R) { const float4 r = *(const float4*)(R + off); o.x += r.x; o.y += r.y; o.z += r.z; o.w += r.w; }
        *(float4*)(C + off) = o;
    }
}

__global__ void __launch_bounds__(256) k_sb_attn(const float* __restrict__ qkv, float* __restrict__ o) {
    __shared__ float Ks[64][65];
    __shared__ float Vs[64][65];
    __shared__ float qs[4][64];
    const int tid = threadIdx.x, w = tid >> 6, lane = tid & 63;
    const int nblk = S / 4;
    const int bh = blockIdx.x / nblk, t0 = (blockIdx.x % nblk) * 4;
    const int b = bh / 16, h = bh % 16;
    const int t = t0 + w;
    const size_t rowb = (size_t)b * S;
    qs[w][lane] = qkv[(rowb + t) * 3072 + h * 64 + lane];
    float acc = 0.f, carry = 0.f;
    const int ntile = (t0 + 3) / 64 + 1;
    for (int tile = ntile - 1; tile >= 0; --tile) {
        const int s0 = tile * 64;
        __syncthreads();
#pragma unroll
        for (int i = 0; i < 16; ++i) {
            const int idx = tid + 256 * i, r = idx >> 6, d = idx & 63;
            const size_t g = (rowb + s0 + r) * 3072 + h * 64 + d;
            Ks[r][d] = qkv[g + 1024]; Vs[r][d] = qkv[g + 2048];
        }
        __syncthreads();
        float z = 0.f;
#pragma unroll 16
        for (int d = 0; d < 64; ++d) z = fmaf(qs[w][d], Ks[lane][d], z);
        z *= 0.125f;
        const int s = s0 + lane;
        const bool valid = s < t;
        const float sp = softplus(z);
        const float L = valid ? -sp : 0.f;
        float x = L;
#pragma unroll
        for (int off = 1; off < 64; off <<= 1) { const float y = __shfl_down(x, off); if (lane + off < 64) x += y; }
        const float excl = x - L;
        const float total = __shfl(x, 0);
        const float log_a = (z - sp) + carry + excl;
        const float a = valid ? expf(log_a) : 0.f;
        carry += total;
#pragma unroll 16
        for (int j = 0; j < 64; ++j) acc = fmaf(__shfl(a, j), Vs[j][lane], acc);
    }
    o[(rowb + t) * 1024 + h * 64 + lane] = acc;
}

__global__ void __launch_bounds__(256) k_sw_attn(const float* __restrict__ qkv, const float* __restrict__ qg, const float* __restrict__ kg,
                                                 const float* __restrict__ sinks, float* __restrict__ o) {
    __shared__ float sc[4][128];
    const int tid = threadIdx.x, w = tid >> 6, lane = tid & 63;
    const int gw = blockIdx.x * 4 + w;
    const int h = gw & 15, bt = gw >> 4, t = bt % S, b = bt / S;
    const int kvh = h >> 2;
    const size_t rowb = (size_t)b * S;
    float q = qkv[(rowb + t) * 1536 + h * 64 + lane];
    { const float ss = wave_sum(q * q); q = q * rsqrtf(ss * (1.f / 64.f) + 1e-6f) * qg[lane]; }
    const float kgl = kg[lane];
    const float slope = exp2f(-8.f * (float)(h + 1) / 16.f);
    const int slo = (t - 127) > 0 ? (t - 127) : 0;
    const int nk = t - slo + 1;
    for (int i = 0; i < nk; ++i) {
        const int s = slo + i;
        float kd = qkv[(rowb + s) * 1536 + 1024 + kvh * 64 + lane];
        const float ss = wave_sum(kd * kd);
        kd = kd * rsqrtf(ss * (1.f / 64.f) + 1e-6f) * kgl;
        const float dot = wave_sum(q * kd);
        if (lane == 0) sc[w][i] = dot * 0.125f - slope * (float)(t - s);
    }
    __syncthreads();
    const float sink = sinks[h];
    float m = sink;
    for (int i = lane; i < nk; i += 64) m = fmaxf(m, sc[w][i]);
    m = wave_max(m);
    float den = 0.f;
    for (int i = lane; i < nk; i += 64) { const float p = expf(sc[w][i] - m); sc[w][i] = p; den += p; }
    den = wave_sum(den) + expf(sink - m);
    __syncthreads();
    const float inv = 1.f / den;
    float acc = 0.f;
    for (int i = 0; i < nk; ++i) acc = fmaf(sc[w][i] * inv, qkv[(rowb + slo + i) * 1536 + 1280 + kvh * 64 + lane], acc);
    o[(rowb + t) * 1024 + h * 64 + lane] = acc;
}

__global__ void __launch_bounds__(256) k_peer_topk(const float* __restrict__ qp, const float* __restrict__ subk, int* __restrict__ eid, float* __restrict__ gate) {
    __shared__ float qs[4][256];
    const int tid = threadIdx.x, w = tid >> 6, lane = tid & 63;
    const int gw = blockIdx.x * 4 + w;
    const int h = gw & 7, t = gw >> 3;
#pragma unroll
    for (int i = 0; i < 4; ++i) qs[w][lane + 64 * i] = qp[(size_t)t * 2048 + h * 256 + lane + 64 * i];
    __syncthreads();
    float ts[2], ti_f[2];
    int tii[2];
#pragma unroll
    for (int p = 0; p < 2; ++p) {
        const float* k0 = subk + ((size_t)(h * 2 + p) * 128 + lane) * 128;
        const float* k1 = k0 + 64 * 128;
        float v0 = 0.f, v1 = 0.f;
        for (int c = 0; c < 128; ++c) { const float qq = qs[w][p * 128 + c]; v0 = fmaf(qq, k0[c], v0); v1 = fmaf(qq, k1[c], v1); }
        float mys = 0.f; int myi = 0;
        for (int r = 0; r < 16; ++r) {
            float bv; int bi;
            if (v0 >= v1) { bv = v0; bi = lane; } else { bv = v1; bi = lane + 64; }
#pragma unroll
            for (int off = 1; off < 64; off <<= 1) {
                const float ov = __shfl_xor(bv, off); const int oi = __shfl_xor(bi, off);
                if (ov > bv || (ov == bv && oi < bi)) { bv = ov; bi = oi; }
            }
            if (lane == r) { mys = bv; myi = bi; }
            if (bi == lane) v0 = -INFINITY;
            if (bi == lane + 64) v1 = -INFINITY;
        }
        ts[p] = mys; tii[p] = myi;
    }
    (void)ti_f;
    float cv[4];
    {
        const float s0 = __shfl(ts[0], lane >> 2);
#pragma unroll
        for (int c = 0; c < 4; ++c) cv[c] = s0 + __shfl(ts[1], (lane & 3) * 4 + c);
    }
    float cs = 0.f; int cf = 0;
    for (int r = 0; r < 16; ++r) {
        float bv = cv[0]; int bi = lane * 4;
#pragma unroll
        for (int c = 1; c < 4; ++c) if (cv[c] > bv) { bv = cv[c]; bi = lane * 4 + c; }
#pragma unroll
        for (int off = 1; off < 64; off <<= 1) {
            const float ov = __shfl_xor(bv, off); const int oi = __shfl_xor(bi, off);
            if (ov > bv || (ov == bv && oi < bi)) { bv = ov; bi = oi; }
        }
        if (lane == r) { cs = bv; cf = bi; }
#pragma unroll
        for (int c = 0; c < 4; ++c) if (bi == lane * 4 + c) cv[c] = -INFINITY;
    }
    const float mval = wave_max(lane < 16 ? cs : -INFINITY);
    const float ex = lane < 16 ? expf(cs - mval) : 0.f;
    const float den = wave_sum(ex);
    const int i1 = __shfl(tii[0], (cf >> 4) & 15), i2 = __shfl(tii[1], cf & 15);
    if (lane < 16) {
        eid[(size_t)t * 128 + h * 16 + lane] = i1 * 128 + i2;
        gate[(size_t)t * 128 + h * 16 + lane] = ex / den;
    }
}

__global__ void __launch_bounds__(256) k_peer_gather(const float* __restrict__ xn, const float* __restrict__ hin, const int* __restrict__ eid, const float* __restrict__ gate,
                                                     const float* __restrict__ U, const float* __restrict__ V, float* __restrict__ hout) {
    const int t = blockIdx.x * 4 + (threadIdx.x >> 6), lane = threadIdx.x & 63;
    const float4* xr = (const float4*)(xn + (size_t)t * D);
    float4 x[4], acc[4];
#pragma unroll
    for (int j = 0; j < 4; ++j) { x[j] = xr[lane + 64 * j]; acc[j] = make_float4(0.f, 0.f, 0.f, 0.f); }
    for (int k = 0; k < 128; ++k) {
        const int e = eid[(size_t)t * 128 + k];
        const float g = gate[(size_t)t * 128 + k];
        const float4* ur = (const float4*)(U + (size_t)e * D);
        float s = 0.f;
#pragma unroll
        for (int j = 0; j < 4; ++j) { const float4 u = ur[lane + 64 * j]; s += u.x * x[j].x + u.y * x[j].y + u.z * x[j].z + u.w * x[j].w; }
        s = wave_sum(s);
        const float coef = g * gelu_tanh(s);
        const float4* vr = (const float4*)(V + (size_t)e * D);
#pragma unroll
        for (int j = 0; j < 4; ++j) { const float4 v = vr[lane + 64 * j]; acc[j].x = fmaf(coef, v.x, acc[j].x); acc[j].y = fmaf(coef, v.y, acc[j].y); acc[j].z = fmaf(coef, v.z, acc[j].z); acc[j].w = fmaf(coef, v.w, acc[j].w); }
    }
    const float4* hr = (const float4*)(hin + (size_t)t * D);
    float4* orow = (float4*)(hout + (size_t)t * D);
#pragma unroll
    for (int j = 0; j < 4; ++j) { const float4 hh = hr[lane + 64 * j]; float4 oo; oo.x = hh.x + acc[j].x; oo.y = hh.y + acc[j].y; oo.z = hh.z + acc[j].z; oo.w = hh.w + acc[j].w; orow[lane + 64 * j] = oo; }
}
}

extern "C" void kernel_launch(void* const* d_in, const int* in_sizes, int n_in, void* d_out, int out_size, void* d_ws, size_t ws_size, hipStream_t stream) {
    using namespace nv;
    const float* x = (const float*)d_in[0];
    const float* sb_norm = (const float*)d_in[1];
    const float* sb_w_qkv = (const float*)d_in[2];
    const float* sb_w_o = (const float*)d_in[3];
    const float* sw_norm = (const float*)d_in[4];
    const float* sw_w_qkv = (const float*)d_in[5];
    const float* sw_q_gain = (const float*)d_in[6];
    const float* sw_k_gain = (const float*)d_in[7];
    const float* sw_sinks = (const float*)d_in[8];
    const float* sw_w_o = (const float*)d_in[9];
    const float* ffn_norm = (const float*)d_in[10];
    const float* peer_wq = (const float*)d_in[11];
    const float* peer_sk = (const float*)d_in[12];
    const float* peer_u = (const float*)d_in[13];
    const float* peer_v = (const float*)d_in[14];
    float* out = (float*)d_out;
    char* ws = (char*)d_ws;
    const size_t MiB = 1u << 20;
    float* xn = (float*)(ws + 0 * MiB);
    float* qkv = (float*)(ws + 64 * MiB);
    float* ao = (float*)(ws + 256 * MiB);
    float* h1 = (float*)(ws + 320 * MiB);
    float* h2 = (float*)(ws + 384 * MiB);
    int* eid = (int*)(ws + 448 * MiB);
    float* gate = (float*)(ws + 456 * MiB);
    if (ws_size < 464 * MiB) { fprintf(stderr, "ws too small\n"); return; }

    k_rmsnorm<<<T / 4, 256, 0, stream>>>(x, sb_norm, xn);
    k_gemm<<<dim3(3072 / 64, T / 64), 256, 0, stream>>>(xn, sb_w_qkv, nullptr, qkv, T, 3072, D);
    k_sb_attn<<<B * 16 * (S / 4), 256, 0, stream>>>(qkv, ao);
    k_gemm<<<dim3(1024 / 64, T / 64), 256, 0, stream>>>(ao, sb_w_o, x, h1, T, 1024, D);
    k_rmsnorm<<<T / 4, 256, 0, stream>>>(h1, ffn_norm, xn);
    k_gemm<<<dim3(2048 / 64, T / 64), 256, 0, stream>>>(xn, peer_wq, nullptr, qkv, T, 2048, D);
    k_peer_topk<<<T * 8 / 4, 256, 0, stream>>>(qkv, peer_sk, eid, gate);
    k_peer_gather<<<T / 4, 256, 0, stream>>>(xn, h1, eid, gate, peer_u, peer_v, h2);
    k_rmsnorm<<<T / 4, 256, 0, stream>>>(h2, sw_norm, xn);
    k_gemm<<<dim3(1536 / 64, T / 64), 256, 0, stream>>>(xn, sw_w_qkv, nullptr, qkv, T, 1536, D);
    k_sw_attn<<<T * 16 / 4, 256, 0, stream>>>(qkv, sw_q_gain, sw_k_gain, sw_sinks, ao);
    k_gemm<<<dim3(1024 / 64, T / 64), 256, 0, stream>>>(ao, sw_w_o, h2, h1, T, 1024, D);
    k_rmsnorm<<<T / 4, 256, 0, stream>>>(h1, ffn_norm + D, xn);
    k_gemm<<<dim3(2048 / 64, T / 64), 256, 0, stream>>>(xn, peer_wq + (size_t)D * 2048, nullptr, qkv, T, 2048, D);
    k_peer_topk<<<T * 8 / 4, 256, 0, stream>>>(qkv, peer_sk + (size_t)8 * 2 * 128 * 128, eid, gate);
    k_peer_gather<<<T / 4, 256, 0, stream>>>(xn, h1, eid, gate, peer_u + (size_t)16384 * D, peer_v + (size_t)16384 * D, out);
}
```

```cpp
#include <hip/hip_runtime.h>
#include <cstdint>
#include <cstdio>

constexpr int D = 1024, NB = 4, S = 4096, T = NB * S;
constexpr float LOG2E = 1.4426950408889634f;
constexpr float C2 = 0.125f * LOG2E;

constexpr size_t MiB = 1u << 20;
constexpr size_t WS_CTL = 0, CTL_ZERO_BYTES = 1 * MiB;
constexpr size_t WS_WQKV0 = 2 * MiB, WS_WO0 = 8 * MiB, WS_WQKV1 = 10 * MiB, WS_WO1 = 13 * MiB, WS_WPQ0 = 15 * MiB, WS_WPQ1 = 19 * MiB;
constexpr size_t WS_SUBK = 23 * MiB;
constexpr size_t WS_ISU = 24 * MiB;
constexpr size_t WS_ISV = WS_ISU + 2 * 16384 * 4;
constexpr size_t WS_SSP = 25 * MiB;
constexpr size_t WS_U8 = 32 * MiB, WS_V8 = 64 * MiB;
constexpr size_t WS_HB = 96 * MiB;
constexpr size_t WS_QB = 128 * MiB, WS_KB = 160 * MiB, WS_VB = 192 * MiB;
constexpr size_t WS_AO = 224 * MiB;
constexpr size_t WS_QP = 256 * MiB;
constexpr size_t WS_EID = 320 * MiB, WS_GATE = 328 * MiB;
constexpr size_t WS_END = 336 * MiB;
namespace pg8 {
#define PG8_LAS __attribute__((address_space(3)))
typedef unsigned short bf16_t;
typedef short bf16x8 __attribute__((ext_vector_type(8)));
typedef float f32x4 __attribute__((ext_vector_type(4)));
typedef unsigned u32x4 __attribute__((ext_vector_type(4)));
constexpr int BM = 256, BK = 64, HALF = 128, HTB = HALF * BK * 2  , STAGE_BYTES = 8 * HTB, NXCD = 8, WGM = 8;

__host__ __device__ __forceinline__ int lds_byte(int r, int c) { const int st = (r >> 4) * 2 + (c >> 5), rr = r & 15, cc = c & 31, ob = rr * 64 + cc * 2; return st * 1024 + (ob ^ (((ob >> 9) & 1) << 5)); }
__host__ __device__ __forceinline__ void stage_rc(int b, int& R, int& C) { const int st = b / 1024, sb = b % 1024, swz = sb ^ (((sb >> 9) & 1) << 5); R = (st >> 1) * 16 + swz / 64; C = (st & 1) * 32 + (swz % 64) / 2; }
__host__ __device__ __forceinline__ int perm32(int rho) { const int n = rho >> 4, i = rho & 15; return 8 * (i >> 2) + 4 * n + (i & 3); }

struct Unit { int pm, pn; };
struct Gemm { const bf16_t* A; const bf16_t* Bt; int M, N, K; };

struct StaticOrder {
    int nM, nN, nwg, G, c;
    __host__ __device__ void init(int M, int N, int G_, int c_) { nM = M / BM; nN = N / BM; nwg = nM * nN; G = G_; c = c_; }
    __host__ __device__ bool next(int i, Unit& u) const {
        const long L = (long)i * G + c; if (L >= nwg) return false;
        int wgid = (int)L; { const int q = nwg / NXCD, r = nwg % NXCD, xcd = wgid % NXCD, off = wgid / NXCD; wgid = (xcd < r ? xcd * (q + 1) : r * (q + 1) + (xcd - r) * q) + off; }
        const int nig = WGM * nN, gid = wgid / nig, fm = gid * WGM, gsz = (nM - fm) < WGM ? (nM - fm) : WGM;
        u.pm = fm + ((wgid % nig) % gsz); u.pn = (wgid % nig) / gsz; return true;
    }
    __device__ __forceinline__ void a_ready(const Unit&) const {}
    __device__ __forceinline__ void done(const Unit&) const {}
};


__device__ __forceinline__ unsigned cvt_pk_bf16(float lo, float hi) { unsigned r; asm volatile("v_cvt_pk_bf16_f32 %0, %1, %2" : "=v"(r) : "v"(lo), "v"(hi)); return r; }

struct EpiScaleBf16 {
    static constexpr bool PERM = true, AFTER_DRAIN = false;
    bf16_t* O; int ldc; int split_cols; size_t split_stride; float scale0; const PG8_LAS float* rs;
    __device__ __forceinline__ void operator()(const f32x4 (&acc)[2][2][4][2], const Unit& u, int ui, int wr, int wc, int fr, int fq) const {
        const int row0 = u.pm * BM + wr * 64 + fr; int colt = u.pn * BM; bf16_t* base = O;
        float sc = 1.f; if (split_cols) { const int t = colt / split_cols; base += (size_t)t * split_stride; colt -= t * split_cols; if (t == 0) sc = scale0; }
        const int col0 = colt + wc * 32 + 8 * fq;
        const PG8_LAS float* rsu = rs + (ui & 3) * 256 + wr * 64 + fr;
#pragma unroll
        for (int ai = 0; ai < 2; ++ai)
#pragma unroll
            for (int m = 0; m < 4; ++m) { bf16_t* rowp = base + (size_t)(row0 + ai * HALF + m * 16) * ldc + col0; const float s = rsu[ai * HALF + m * 16] * sc;
#pragma unroll
                for (int bj = 0; bj < 2; ++bj) { const f32x4 v0 = acc[ai][bj][m][0] * s, v1 = acc[ai][bj][m][1] * s;
                    u32x4 w; w.x = cvt_pk_bf16(v0[0], v0[1]); w.y = cvt_pk_bf16(v0[2], v0[3]); w.z = cvt_pk_bf16(v1[0], v1[1]); w.w = cvt_pk_bf16(v1[2], v1[3]);
                    *(u32x4*)(rowp + bj * HALF) = w; } }
    }
};
struct EpiResid {
    static constexpr bool PERM = true, AFTER_DRAIN = false;
    const float* resid; float* out; bf16_t* hb; float* ssp; int nrows;
    __device__ __forceinline__ void operator()(const f32x4 (&acc)[2][2][4][2], const Unit& u, int ui, int wr, int wc, int fr, int fq) const {
        const int col0 = u.pn * BM + wc * 32 + 8 * fq;
#pragma unroll
        for (int ai = 0; ai < 2; ++ai)
#pragma unroll
            for (int m = 0; m < 4; ++m) { const int row = u.pm * BM + ai * HALF + wr * 64 + m * 16 + fr; const size_t off = (size_t)row * 1024 + col0; float ss = 0.f;
#pragma unroll
                for (int bj = 0; bj < 2; ++bj) { const f32x4 r0 = *(const f32x4*)(resid + off + bj * HALF), r1 = *(const f32x4*)(resid + off + bj * HALF + 4);
                    const f32x4 v0 = acc[ai][bj][m][0] + r0, v1 = acc[ai][bj][m][1] + r1;
                    *(f32x4*)(out + off + bj * HALF) = v0; *(f32x4*)(out + off + bj * HALF + 4) = v1;
                    ss += (v0[0] * v0[0] + v0[1] * v0[1]) + (v0[2] * v0[2] + v0[3] * v0[3]) + (v1[0] * v1[0] + v1[1] * v1[1]) + (v1[2] * v1[2] + v1[3] * v1[3]);
                    u32x4 w; w.x = cvt_pk_bf16(v0[0], v0[1]); w.y = cvt_pk_bf16(v0[2], v0[3]); w.z = cvt_pk_bf16(v1[0], v1[1]); w.w = cvt_pk_bf16(v1[2], v1[3]);
                    *(u32x4*)(hb + off + bj * HALF) = w; }
                ss += __shfl_xor(ss, 16); ss += __shfl_xor(ss, 32);
                if (fq == 0) ssp[(size_t)(u.pn * 4 + wc) * nrows + row] = ss;
                asm volatile("" ::: "memory"); }
    }
};
template <class Epi, class Sched, bool ALIGN_EPI = false, bool SP2 = false>
__device__ __forceinline__ void gemm_phase(PG8_LAS unsigned char* lds, const Gemm g, const Sched& S, const Epi& E) {
    const int tid = threadIdx.x, wid = __builtin_amdgcn_readfirstlane(tid >> 6), lane = tid & 63, wr = wid >> 2, wc = wid & 3, fr = lane & 15, fq = lane >> 4;
    const int K = g.K, nt = K / BK;
    unsigned voffA[2], voffB[2];
#pragma unroll
    for (int i = 0; i < 2; ++i) { int R, C; stage_rc(tid * 16 + i * 8192, R, C); const int Rb = Epi::PERM ? ((R & ~31) + perm32(R & 31)) : R;
        voffA[i] = (unsigned)(R * K + C) * 2u; voffB[i] = (unsigned)(Rb * K + C) * 2u; }
    const size_t kstep = (size_t)(BK * 2);
    const size_t hstep = (size_t)HALF * K * 2;
    const size_t tstep = 2 * hstep;
    const unsigned ldsw = (unsigned)wid * 1024u;
    const int aoff = lds_byte(wr * 64 + fr, fq * 8), boff = lds_byte(wc * 32 + fr, fq * 8);
#define PG8_SA(b, h) (((b) * 2 + (h)) * HTB)
#define PG8_SB(b, h) ((4 + (b) * 2 + (h)) * HTB)
#define PG8_STAGE(bufoff, gbase, voff) do { _Pragma("unroll") for (int _i = 0; _i < 2; ++_i) \
        __builtin_amdgcn_global_load_lds((const unsigned*)((const char*)(gbase) + (voff)[_i]), (PG8_LAS unsigned*)(lds + (bufoff) + ldsw + _i * 8192), 16, 0, 0); } while (0)
#define PG8_LDA(dst, b, h) do { _Pragma("unroll") for (int m = 0; m < 4; ++m) _Pragma("unroll") for (int k = 0; k < 2; ++k) dst[m][k] = *(const PG8_LAS bf16x8*)(lds + PG8_SA(b, h) + aoff + m * 2048 + k * 1024); } while (0)
#define PG8_LDB(dst, b, h) do { _Pragma("unroll") for (int n = 0; n < 2; ++n) _Pragma("unroll") for (int k = 0; k < 2; ++k) dst[n][k] = *(const PG8_LAS bf16x8*)(lds + PG8_SB(b, h) + boff + n * 2048 + k * 1024); } while (0)
#define PG8_MMA(ai, bj, At, Bt) do { __builtin_amdgcn_s_setprio(1); _Pragma("unroll") for (int m = 0; m < 4; ++m) _Pragma("unroll") for (int n = 0; n < 2; ++n) _Pragma("unroll") for (int k = 0; k < 2; ++k) \
        acc[ai][bj][m][n] = __builtin_amdgcn_mfma_f32_16x16x32_bf16(Bt[n][k], At[m][k], acc[ai][bj][m][n], 0, 0, 0); __builtin_amdgcn_s_setprio(0); } while (0)
#define PG8_WAIT_V(n) asm volatile("s_waitcnt vmcnt(" #n ")" ::: "memory")
#define PG8_WAIT_L(n) asm volatile("s_waitcnt lgkmcnt(" #n ")" ::: "memory")
#define PG8_BAR __builtin_amdgcn_s_barrier()
#define PG8_SCHED __builtin_amdgcn_sched_barrier(0)
    Unit cur, nxt; int ui = 0;
    if (!S.next(0, cur)) return;
    f32x4 acc[2][2][4][2];
#pragma unroll
    for (int a = 0; a < 2; ++a)
#pragma unroll
        for (int b = 0; b < 2; ++b)
#pragma unroll
            for (int m = 0; m < 4; ++m)
#pragma unroll
                for (int n = 0; n < 2; ++n) acc[a][b][m][n] = (f32x4){0.f, 0.f, 0.f, 0.f};
    bf16x8 At[4][2], B0[2][2], B1[2][2];
    const char* cA = (const char*)g.A + (size_t)cur.pm * tstep; const char* cB = (const char*)g.Bt + (size_t)cur.pn * tstep;
    S.a_ready(cur);
    if constexpr (SP2) {
        PG8_STAGE(PG8_SB(0, 0), cB, voffB); PG8_STAGE(PG8_SB(0, 1), cB + hstep, voffB); PG8_STAGE(PG8_SA(0, 0), cA, voffA); PG8_STAGE(PG8_SA(0, 1), cA + hstep, voffA);
        if (wr == 1) PG8_BAR;
        PG8_WAIT_V(2); PG8_BAR;
        PG8_STAGE(PG8_SB(1, 0), cB + kstep, voffB); PG8_STAGE(PG8_SA(1, 0), cA + kstep, voffA); PG8_STAGE(PG8_SB(1, 1), cB + hstep + kstep, voffB);
        PG8_WAIT_V(6); PG8_BAR;
    } else {
        PG8_STAGE(PG8_SB(0, 0), cB, voffB); PG8_STAGE(PG8_SA(0, 0), cA, voffA); PG8_STAGE(PG8_SB(0, 1), cB + hstep, voffB); PG8_STAGE(PG8_SA(0, 1), cA + hstep, voffA);
        if (wr == 1) PG8_BAR;
        PG8_WAIT_V(4); PG8_BAR;
        PG8_STAGE(PG8_SB(1, 0), cB + kstep, voffB); PG8_STAGE(PG8_SA(1, 0), cA + kstep, voffA); PG8_STAGE(PG8_SB(1, 1), cB + hstep + kstep, voffB);
        PG8_WAIT_V(6); PG8_BAR;
    }
    for (;;) {
        const bool has_next = S.next(ui + 1, nxt);
        const char* nA = has_next ? (const char*)g.A + (size_t)nxt.pm * tstep : cA; const char* nB = has_next ? (const char*)g.Bt + (size_t)nxt.pn * tstep : cB;
        for (int t = 0; t < nt; t += 2) {
            const bool last = (t == nt - 2);
            const char* a1 = cA + (size_t)(t + 1) * kstep;
            const char* a2 = last ? nA : cA + (size_t)(t + 2) * kstep; const char* b2 = last ? nB : cB + (size_t)(t + 2) * kstep;
            const char* a3 = a2 + kstep; const char* b3 = b2 + kstep;
            if (last && has_next) S.a_ready(nxt);
            if constexpr (SP2) {
            PG8_LDB(B0, 0, 0); PG8_LDB(B1, 0, 1); PG8_SCHED; PG8_LDA(At, 0, 0); PG8_STAGE(PG8_SA(1, 1), a1 + hstep, voffA);
            PG8_WAIT_V(8); PG8_WAIT_L(0); PG8_BAR; PG8_MMA(0, 0, At, B0); PG8_MMA(0, 1, At, B1); PG8_BAR; PG8_SCHED;
            PG8_LDA(At, 0, 1); PG8_STAGE(PG8_SB(0, 0), b2, voffB); PG8_STAGE(PG8_SB(0, 1), b2 + hstep, voffB); PG8_STAGE(PG8_SA(0, 0), a2, voffA);
            PG8_WAIT_V(8); PG8_WAIT_L(0); PG8_BAR; PG8_MMA(1, 0, At, B0); PG8_MMA(1, 1, At, B1); PG8_BAR; PG8_SCHED;
            PG8_LDB(B0, 1, 0); PG8_LDB(B1, 1, 1); PG8_SCHED; PG8_LDA(At, 1, 0); PG8_STAGE(PG8_SA(0, 1), a2 + hstep, voffA);
            PG8_WAIT_V(8); PG8_WAIT_L(0); PG8_BAR; PG8_MMA(0, 0, At, B0); PG8_MMA(0, 1, At, B1); PG8_BAR; PG8_SCHED;
            PG8_LDA(At, 1, 1); PG8_STAGE(PG8_SB(1, 0), b3, voffB); PG8_STAGE(PG8_SB(1, 1), b3 + hstep, voffB); PG8_STAGE(PG8_SA(1, 0), a3, voffA);
            PG8_WAIT_V(8); PG8_WAIT_L(0); PG8_BAR; PG8_MMA(1, 0, At, B0); PG8_MMA(1, 1, At, B1); PG8_BAR; PG8_SCHED;
            } else {
            PG8_LDB(B0, 0, 0); PG8_SCHED; PG8_LDA(At, 0, 0); PG8_STAGE(PG8_SA(1, 1), a1 + hstep, voffA);
            PG8_WAIT_L(8); PG8_BAR; PG8_WAIT_L(0); PG8_MMA(0, 0, At, B0); PG8_BAR; PG8_SCHED;
            PG8_LDB(B1, 0, 1); PG8_STAGE(PG8_SB(0, 0), b2, voffB);
            PG8_BAR; PG8_WAIT_L(0); PG8_MMA(0, 1, At, B1); PG8_BAR;
            PG8_LDA(At, 0, 1); PG8_STAGE(PG8_SA(0, 0), a2, voffA);
            PG8_BAR; PG8_WAIT_L(0); PG8_MMA(1, 0, At, B0); PG8_BAR; PG8_SCHED;
            PG8_STAGE(PG8_SB(0, 1), b2 + hstep, voffB);
            PG8_WAIT_V(6); PG8_BAR; PG8_MMA(1, 1, At, B1); PG8_BAR;
            PG8_LDB(B0, 1, 0); PG8_SCHED; PG8_LDA(At, 1, 0); PG8_STAGE(PG8_SA(0, 1), a2 + hstep, voffA);
            PG8_WAIT_L(8); PG8_BAR; PG8_WAIT_L(0); PG8_MMA(0, 0, At, B0); PG8_BAR; PG8_SCHED;
            PG8_LDB(B1, 1, 1); PG8_STAGE(PG8_SB(1, 0), b3, voffB);
            PG8_BAR; PG8_WAIT_L(0); PG8_MMA(0, 1, At, B1); PG8_BAR;
            PG8_LDA(At, 1, 1); PG8_STAGE(PG8_SA(1, 0), a3, voffA);
            PG8_BAR; PG8_WAIT_L(0); PG8_MMA(1, 0, At, B0); PG8_BAR; PG8_SCHED;
            PG8_STAGE(PG8_SB(1, 1), b3 + hstep, voffB);
            PG8_WAIT_V(6); PG8_BAR; PG8_MMA(1, 1, At, B1); PG8_BAR;
            }
        }
        if constexpr (ALIGN_EPI) { if (wr == 0) PG8_BAR; }
        if constexpr (!Epi::AFTER_DRAIN) { E(acc, cur, ui, wr, wc, fr, fq); S.done(cur); }
        if (!has_next) break;
#pragma unroll
        for (int a = 0; a < 2; ++a)
#pragma unroll
            for (int b = 0; b < 2; ++b)
#pragma unroll
                for (int m = 0; m < 4; ++m)
#pragma unroll
                    for (int n = 0; n < 2; ++n) acc[a][b][m][n] = (f32x4){0.f, 0.f, 0.f, 0.f};
        cur = nxt; cA = nA; cB = nB; ++ui;
        if constexpr (ALIGN_EPI) { if (wr == 1) PG8_BAR; }
    }
    PG8_WAIT_V(0);
    if constexpr (!ALIGN_EPI) { if (wr == 0) PG8_BAR; }
    PG8_BAR;
    if constexpr (Epi::AFTER_DRAIN) { E.fused(acc, cur, wr, wc, fr, fq, lds, wid, lane); S.done(cur); }
#undef PG8_SA
#undef PG8_SB
#undef PG8_STAGE
#undef PG8_LDA
#undef PG8_LDB
#undef PG8_MMA
#undef PG8_WAIT_V
#undef PG8_WAIT_L
#undef PG8_BAR
#undef PG8_SCHED
}
}

#define GAS __attribute__((address_space(1)))
#define LAS __attribute__((address_space(3)))
typedef unsigned short bf16;
typedef unsigned v4u __attribute__((ext_vector_type(4)));
typedef float f32x4 __attribute__((ext_vector_type(4)));
typedef float f32x2 __attribute__((ext_vector_type(2)));
typedef float f32x16 __attribute__((ext_vector_type(16)));
typedef short bf16x8 __attribute__((ext_vector_type(8)));
typedef GAS unsigned gu32;
#define RLX_AGENT __ATOMIC_RELAXED, __HIP_MEMORY_SCOPE_AGENT
#define LDS_WAIT() asm volatile("s_waitcnt lgkmcnt(0)" ::: "memory")
#define VM_WAIT() asm volatile("s_waitcnt vmcnt(0)" ::: "memory")
__device__ __forceinline__ unsigned f2bf(float f) { unsigned u = __builtin_bit_cast(unsigned, f); return (u + 0x7fffu + ((u >> 16) & 1u)) >> 16; }
__device__ __forceinline__ unsigned pk2(float lo, float hi) { return f2bf(lo) | (f2bf(hi) << 16); }
__device__ __forceinline__ float bf2f(unsigned short b) { return __builtin_bit_cast(float, (unsigned)b << 16); }
__device__ __forceinline__ float bflo(unsigned w) { return __builtin_bit_cast(float, w << 16); }
__device__ __forceinline__ float bfhi(unsigned w) { return __builtin_bit_cast(float, w & 0xffff0000u); }
__device__ __forceinline__ float wave_sum(float v) {
#pragma unroll
    for (int o = 1; o < 64; o <<= 1) v += __shfl_xor(v, o);
    return v;
}
__device__ __forceinline__ float wave_max(float v) {
#pragma unroll
    for (int o = 1; o < 64; o <<= 1) v = fmaxf(v, __shfl_xor(v, o));
    return v;
}

#define XB_TMO      128
#define XB_XCNT(j)  (256  + 64 * (j))
#define XB_XSUB(j)  (1280 + 64 * (j))
#define XB_XGEN(j)  (2304 + 64 * (j))
#define XB_TOP      3328
#define XB_TOPGEN   3392
#define XCD_BAR_WORDS 3456
#define XB_SPIN_CAP (1u << 18)

__device__ __forceinline__ unsigned xb_ld(unsigned* p)              { return __hip_atomic_load(p, __ATOMIC_RELAXED, __HIP_MEMORY_SCOPE_AGENT); }
__device__ __forceinline__ unsigned xb_add(unsigned* p, unsigned v) { return __hip_atomic_fetch_add(p, v, __ATOMIC_RELAXED, __HIP_MEMORY_SCOPE_AGENT); }
__device__ __forceinline__ unsigned xb_xcc_id() { return (unsigned)__builtin_amdgcn_s_getreg((3 << 11) | 20) & 0xFu; }
#define XB_SPIN(cond, bar) do { unsigned _sp = 0; while (cond) { __builtin_amdgcn_s_sleep(1); \
    if ((++_sp & 255u) == 0u) { if (xb_ld(&(bar)[XB_TMO])) break; if (_sp > XB_SPIN_CAP) { atomicAdd(&(bar)[XB_TMO], 1u); break; } } } } while (0)

struct XcdBarrier {
    unsigned* bar; unsigned x;
    volatile LAS unsigned* st;
};

__device__ __forceinline__ XcdBarrier xcd_barrier_post(unsigned* bar, volatile LAS unsigned* st) {
    XcdBarrier b; b.bar = bar; b.x = xb_xcc_id(); b.st = st;
    if (threadIdx.x == 0) (void)xb_add(&bar[XB_XCNT(b.x)], 1u);
    return b;
}
__device__ __forceinline__ void xcd_barrier_complete(unsigned* bar, unsigned x, unsigned& nloc, unsigned& nx) {
    const unsigned G = gridDim.x * gridDim.y * gridDim.z;
    unsigned sum, cnt, mine, sp = 0u;
    for (;;) {
        sum = 0u; cnt = 0u; mine = 0u;
#pragma unroll
        for (unsigned j = 0; j < 16; ++j) { const unsigned c = xb_ld(&bar[XB_XCNT(j)]); sum += c; cnt += (c > 0u) ? 1u : 0u; mine = (j == x) ? c : mine; }
        if (sum == G) break;
        __builtin_amdgcn_s_sleep(1);
        if ((++sp & 255u) == 0u) { if (xb_ld(&bar[XB_TMO])) break; if (sp > XB_SPIN_CAP) { atomicAdd(&bar[XB_TMO], 1u); break; } }
    }
    nloc = mine > 0u ? mine : 1u; nx = cnt > 0u ? cnt : 1u;
}

__device__ __forceinline__ void xcd_barrier(const XcdBarrier& b) {
    asm volatile("s_waitcnt vmcnt(0)" ::: "memory");
    __syncthreads();
    if (threadIdx.x == 0) {
        unsigned* bar = b.bar;
        __builtin_amdgcn_s_waitcnt(0);
        unsigned nloc = b.st[0], nx = b.st[1];
        if (nloc == 0u) { xcd_barrier_complete(bar, b.x, nloc, nx); b.st[0] = nloc; b.st[1] = nx; }
        const unsigned old = xb_add(&bar[XB_XSUB(b.x)], 1u);
        const unsigned gen = old / nloc;
        if (old + 1u == (gen + 1u) * nloc) {
            __builtin_amdgcn_fence(__ATOMIC_RELEASE, "agent");
            asm volatile("s_waitcnt vmcnt(0)" ::: "memory");
            const unsigned og = xb_add(&bar[XB_TOP], 1u);
            const unsigned tg = og / nx;
            if (og + 1u == (tg + 1u) * nx) xb_add(&bar[XB_TOPGEN], 1u);
            else XB_SPIN(xb_ld(&bar[XB_TOPGEN]) == tg, bar);
            __builtin_amdgcn_fence(__ATOMIC_ACQUIRE, "agent");
            xb_add(&bar[XB_XGEN(b.x)], 1u);
            asm volatile("s_waitcnt vmcnt(0)" ::: "memory");
        } else {
            XB_SPIN(xb_ld(&bar[XB_XGEN(b.x)]) == gen, bar);
            __builtin_amdgcn_fence(__ATOMIC_ACQUIRE, "agent");
            asm volatile("s_waitcnt vmcnt(0)" ::: "memory");
        }
    }
    __syncthreads();
}

constexpr int NWAVES = 8;
constexpr int RING_BYTES = 131072;
constexpr int RS_OFF = RING_BYTES;
constexpr int MISC_OFF = RS_OFF + 4096;
constexpr int LDS_BYTES = 147456;
constexpr int CW_BAR = 4096;

struct Args { const float* in[15]; float* out; unsigned char* ws; unsigned mask; int li; };

__device__ __forceinline__ void p0_transpose_item(const float* W, const float* gain, int K, int N, bf16* WT, LAS float* scr, int item, int lane) {
    const int nblk = N / 32, kb = item / nblk, nb = item % nblk, k0 = 64 * kb, n0 = 32 * nb;
#pragma unroll 8
    for (int i = 0; i < 32; ++i) { const int kk = 2 * i + (lane >> 5); float w = W[(size_t)(k0 + kk) * N + n0 + (lane & 31)]; if (gain) w *= gain[k0 + kk]; scr[kk * 33 + (lane & 31)] = w; }
    LDS_WAIT(); asm volatile("" ::: "memory");
    const int c = lane & 7;
#pragma unroll
    for (int j = 0; j < 4; ++j) { const int n = (lane >> 3) + 8 * j; const LAS float* s = scr + (8 * c) * 33 + n;
        v4u o; o.x = pk2(s[0 * 33], s[1 * 33]); o.y = pk2(s[2 * 33], s[3 * 33]); o.z = pk2(s[4 * 33], s[5 * 33]); o.w = pk2(s[6 * 33], s[7 * 33]);
        *(v4u*)(WT + (size_t)(n0 + n) * K + k0 + 8 * c) = o; }
    LDS_WAIT(); asm volatile("" ::: "memory");
}
__device__ __forceinline__ void conv_row_fp8(const float* src, const float* gain, unsigned char* dst, float* inv_scale, int lane) {
    f32x4 v[4]; float am = 0.f;
#pragma unroll
    for (int j = 0; j < 4; ++j) { v[j] = *(const f32x4*)(src + lane * 16 + 4 * j); if (gain) v[j] = v[j] * *(const f32x4*)(gain + lane * 16 + 4 * j);
        am = fmaxf(am, fmaxf(fmaxf(fabsf(v[j][0]), fabsf(v[j][1])), fmaxf(fabsf(v[j][2]), fabsf(v[j][3])))); }
    am = wave_max(am);
    const float sc = am > 0.f ? 224.f / am : 1.f;
    v4u o;
#pragma unroll
    for (int j = 0; j < 4; ++j) { int w = __builtin_amdgcn_cvt_pk_fp8_f32(v[j][0] * sc, v[j][1] * sc, 0, false); w = __builtin_amdgcn_cvt_pk_fp8_f32(v[j][2] * sc, v[j][3] * sc, w, true); o[j] = (unsigned)w; }
    *(v4u*)(dst + lane * 16) = o;
    if (lane == 0) *inv_scale = am > 0.f ? am * (1.f / 224.f) : 1.f;
}
__device__ __forceinline__ void phase_prep(const Args& a, LAS unsigned char* lds, int gw, int NGW, int wave, int lane) {
    LAS float* scr = (LAS float*)(lds + wave * 16384);
    unsigned char* ws = a.ws;
    constexpr int I0 = 16 * (3072 / 32), I1 = 16 * (1024 / 32), I2 = 16 * (1536 / 32), I3 = I1, I4 = 16 * (2048 / 32), I5 = I4;
    constexpr int NIT = I0 + I1 + I2 + I3 + I4 + I5;
    for (int it = gw; it < NIT; it += NGW) {
        int r = it;
        if (r < I0) { p0_transpose_item(a.in[2], a.in[1], 1024, 3072, (bf16*)(ws + WS_WQKV0), scr, r, lane); continue; } r -= I0;
        if (r < I1) { p0_transpose_item(a.in[3], nullptr, 1024, 1024, (bf16*)(ws + WS_WO0), scr, r, lane); continue; } r -= I1;
        if (r < I2) { p0_transpose_item(a.in[5], a.in[4], 1024, 1536, (bf16*)(ws + WS_WQKV1), scr, r, lane); continue; } r -= I2;
        if (r < I3) { p0_transpose_item(a.in[9], nullptr, 1024, 1024, (bf16*)(ws + WS_WO1), scr, r, lane); continue; } r -= I3;
        if (r < I4) { p0_transpose_item(a.in[11], a.in[10], 1024, 2048, (bf16*)(ws + WS_WPQ0), scr, r, lane); continue; } r -= I4;
        p0_transpose_item(a.in[11] + (size_t)1024 * 2048, a.in[10] + 1024, 1024, 2048, (bf16*)(ws + WS_WPQ1), scr, r, lane);
    }
    for (int it = gw; it < 1024; it += NGW) {
        const float* s = a.in[12] + (size_t)it * 512 + lane * 8; const f32x4 a0 = *(const f32x4*)s, a1 = *(const f32x4*)(s + 4);
        v4u o; o.x = pk2(a0[0], a0[1]); o.y = pk2(a0[2], a0[3]); o.z = pk2(a1[0], a1[1]); o.w = pk2(a1[2], a1[3]);
        *(v4u*)((bf16*)(ws + WS_SUBK) + (size_t)it * 512 + lane * 8) = o;
    }
    for (int r = gw; r < 65536; r += NGW) {
        const int tb = r >> 15, row = r & 32767;
        const float* src = (tb ? a.in[14] : a.in[13]) + (size_t)row * 1024;
        const float* gain = tb ? nullptr : a.in[10] + (row >> 14) * 1024;
        conv_row_fp8(src, gain, ws + (tb ? WS_V8 : WS_U8) + (size_t)row * 1024, (float*)(ws + (tb ? WS_ISV : WS_ISU)) + row, lane);
    }
    for (int t = gw; t < T; t += NGW) {
        const float* xr = a.in[0] + (size_t)t * 1024 + lane * 16; f32x4 v[4]; float ss = 0.f;
#pragma unroll
        for (int j = 0; j < 4; ++j) { v[j] = *(const f32x4*)(xr + 4 * j); ss += (v[j][0] * v[j][0] + v[j][1] * v[j][1]) + (v[j][2] * v[j][2] + v[j][3] * v[j][3]); }
        ss = wave_sum(ss);
        v4u o0, o1; o0.x = pk2(v[0][0], v[0][1]); o0.y = pk2(v[0][2], v[0][3]); o0.z = pk2(v[1][0], v[1][1]); o0.w = pk2(v[1][2], v[1][3]);
        o1.x = pk2(v[2][0], v[2][1]); o1.y = pk2(v[2][2], v[2][3]); o1.z = pk2(v[3][0], v[3][1]); o1.w = pk2(v[3][2], v[3][3]);
        bf16* hb = (bf16*)(ws + WS_HB) + (size_t)t * 1024 + lane * 16;
        *(v4u*)hb = o0; *(v4u*)(hb + 8) = o1;
        if (lane == 0) ((float*)(ws + WS_SSP))[t] = ss;
    }
}
template <class Sched> __device__ __forceinline__ void fill_rs(LAS float* rs, const Sched& So, const float* ssp, int np, int tid) {
    pg8::Unit u;
    for (int ui = 0; ui < 4 && So.next(ui, u); ++ui) {
        if (tid < 256) { const int row = u.pm * 256 + tid; float s = 0.f; for (int p = 0; p < np; ++p) s += ssp[(size_t)p * T + row]; rs[ui * 256 + tid] = rsqrtf(s * (1.f / 1024.f) + 1e-6f); }
    }
    __syncthreads();
}

namespace nv {
__device__ __forceinline__ float softplus(float z) { return fmaxf(z, 0.f) + log1pf(expf(-fabsf(z))); }
__device__ __forceinline__ float gelu_tanh(float x) { const float k = 0.7978845608028654f; return 0.5f * x * (1.f + tanhf(k * (x + 0.044715f * x * x * x))); }

__global__ void __launch_bounds__(256) k_sb_attn_b(const bf16* __restrict__ Q, const bf16* __restrict__ K, const bf16* __restrict__ V, bf16* __restrict__ O) {
    __shared__ float Ks[64][65];
    __shared__ float Vs[64][65];
    __shared__ float qs[4][64];
    const int tid = threadIdx.x, w = tid >> 6, lane = tid & 63;
    const int nblk = S / 4;
    const int bh = blockIdx.x / nblk, t0 = (blockIdx.x % nblk) * 4;
    const int b = bh / 16, h = bh % 16;
    const int t = t0 + w;
    const size_t rowb = (size_t)b * S;
    qs[w][lane] = bf2f(Q[(rowb + t) * 1024 + h * 64 + lane]);
    float acc = 0.f, carry = 0.f;
    const int ntile = (t0 + 3) / 64 + 1;
    for (int tile = ntile - 1; tile >= 0; --tile) {
        const int s0 = tile * 64;
        __syncthreads();
#pragma unroll
        for (int i = 0; i < 16; ++i) {
            const int idx = tid + 256 * i, r = idx >> 6, d = idx & 63;
            const size_t g = (rowb + s0 + r) * 1024 + h * 64 + d;
            Ks[r][d] = bf2f(K[g]); Vs[r][d] = bf2f(V[g]);
        }
        __syncthreads();
        float z = 0.f;
#pragma unroll 16
        for (int d = 0; d < 64; ++d) z = fmaf(qs[w][d], Ks[lane][d], z);
        z *= 0.6931471805599453f;
        const int s = s0 + lane;
        const bool valid = s < t;
        const float sp = softplus(z);
        const float L = valid ? -sp : 0.f;
        float x = L;
#pragma unroll
        for (int off = 1; off < 64; off <<= 1) { const float y = __shfl_down(x, off); if (lane + off < 64) x += y; }
        const float excl = x - L;
        const float total = __shfl(x, 0);
        const float log_a = (z - sp) + carry + excl;
        const float a = valid ? expf(log_a) : 0.f;
        carry += total;
#pragma unroll 16
        for (int j = 0; j < 64; ++j) acc = fmaf(__shfl(a, j), Vs[j][lane], acc);
    }
    O[(rowb + t) * 1024 + h * 64 + lane] = (bf16)f2bf(acc);
}

__global__ void __launch_bounds__(256) k_sw_attn_b(const bf16* __restrict__ qkv, const float* __restrict__ qg, const float* __restrict__ kg,
                                                   const float* __restrict__ sinks, bf16* __restrict__ O) {
    __shared__ float sc[4][128];
    const int tid = threadIdx.x, w = tid >> 6, lane = tid & 63;
    const int gw = blockIdx.x * 4 + w;
    const int h = gw & 15, bt = gw >> 4, t = bt % S, b = bt / S;
    const int kvh = h >> 2;
    const size_t rowb = (size_t)b * S;
    float q = bf2f(qkv[(rowb + t) * 1536 + h * 64 + lane]);
    { const float ss = wave_sum(q * q); q = q * rsqrtf(ss * (1.f / 64.f) + 1e-6f) * qg[lane]; }
    const float kgl = kg[lane];
    const float slope = exp2f(-8.f * (float)(h + 1) / 16.f);
    const int slo = (t - 127) > 0 ? (t - 127) : 0;
    const int nk = t - slo + 1;
    for (int i = 0; i < nk; ++i) {
        const int s = slo + i;
        float kd = bf2f(qkv[(rowb + s) * 1536 + 1024 + kvh * 64 + lane]);
        const float ss = wave_sum(kd * kd);
        kd = kd * rsqrtf(ss * (1.f / 64.f) + 1e-6f) * kgl;
        const float dot = wave_sum(q * kd);
        if (lane == 0) sc[w][i] = dot * 0.125f - slope * (float)(t - s);
    }
    __syncthreads();
    const float sink = sinks[h];
    float m = sink;
    for (int i = lane; i < nk; i += 64) m = fmaxf(m, sc[w][i]);
    m = wave_max(m);
    float den = 0.f;
    for (int i = lane; i < nk; i += 64) { const float p = expf(sc[w][i] - m); sc[w][i] = p; den += p; }
    den = wave_sum(den) + expf(sink - m);
    __syncthreads();
    const float inv = 1.f / den;
    float acc = 0.f;
    for (int i = 0; i < nk; ++i) acc = fmaf(sc[w][i] * inv, bf2f(qkv[(rowb + slo + i) * 1536 + 1280 + kvh * 64 + lane]), acc);
    O[(rowb + t) * 1024 + h * 64 + lane] = (bf16)f2bf(acc);
}

__global__ void __launch_bounds__(256) k_peer_topk_b(const bf16* __restrict__ qp, const bf16* __restrict__ subk, int* __restrict__ eid, float* __restrict__ gate) {
    __shared__ float qs[4][256];
    const int tid = threadIdx.x, w = tid >> 6, lane = tid & 63;
    const int gw = blockIdx.x * 4 + w;
    const int h = gw & 7, t = gw >> 3;
#pragma unroll
    for (int i = 0; i < 4; ++i) qs[w][lane + 64 * i] = bf2f(qp[(size_t)t * 2048 + h * 256 + lane + 64 * i]);
    __syncthreads();
    float ts[2]; int tii[2];
#pragma unroll
    for (int p = 0; p < 2; ++p) {
        const bf16* k0 = subk + ((size_t)(h * 2 + p) * 128 + lane) * 128;
        const bf16* k1 = k0 + 64 * 128;
        float v0 = 0.f, v1 = 0.f;
        for (int c = 0; c < 128; ++c) { const float qq = qs[w][p * 128 + c]; v0 = fmaf(qq, bf2f(k0[c]), v0); v1 = fmaf(qq, bf2f(k1[c]), v1); }
        float mys = 0.f; int myi = 0;
        for (int r = 0; r < 16; ++r) {
            float bv; int bi;
            if (v0 >= v1) { bv = v0; bi = lane; } else { bv = v1; bi = lane + 64; }
#pragma unroll
            for (int off = 1; off < 64; off <<= 1) {
                const float ov = __shfl_xor(bv, off); const int oi = __shfl_xor(bi, off);
                if (ov > bv || (ov == bv && oi < bi)) { bv = ov; bi = oi; }
            }
            if (lane == r) { mys = bv; myi = bi; }
            if (bi == lane) v0 = -INFINITY;
            if (bi == lane + 64) v1 = -INFINITY;
        }
        ts[p] = mys; tii[p] = myi;
    }
    float cv[4];
    {
        const float s0 = __shfl(ts[0], lane >> 2);
#pragma unroll
        for (int c = 0; c < 4; ++c) cv[c] = s0 + __shfl(ts[1], (lane & 3) * 4 + c);
    }
    float cs = 0.f; int cf = 0;
    for (int r = 0; r < 16; ++r) {
        float bv = cv[0]; int bi = lane * 4;
#pragma unroll
        for (int c = 1; c < 4; ++c) if (cv[c] > bv) { bv = cv[c]; bi = lane * 4 + c; }
#pragma unroll
        for (int off = 1; off < 64; off <<= 1) {
            const float ov = __shfl_xor(bv, off); const int oi = __shfl_xor(bi, off);
            if (ov > bv || (ov == bv && oi < bi)) { bv = ov; bi = oi; }
        }
        if (lane == r) { cs = bv; cf = bi; }
#pragma unroll
        for (int c = 0; c < 4; ++c) if (bi == lane * 4 + c) cv[c] = -INFINITY;
    }
    const float mval = wave_max(lane < 16 ? cs : -INFINITY);
    const float ex = lane < 16 ? expf(cs - mval) : 0.f;
    const float den = wave_sum(ex);
    const int i1 = __shfl(tii[0], (cf >> 4) & 15), i2 = __shfl(tii[1], cf & 15);
    if (lane < 16) {
        eid[(size_t)t * 128 + h * 16 + lane] = i1 * 128 + i2;
        gate[(size_t)t * 128 + h * 16 + lane] = ex / den;
    }
}

__global__ void __launch_bounds__(256) k_peer_gather_b(float* h, const float* __restrict__ ssp_in, int np, const unsigned char* __restrict__ U8, const unsigned char* __restrict__ V8,
                                                       const float* __restrict__ isu, const float* __restrict__ isv, const int* __restrict__ eid, const float* __restrict__ gate,
                                                       bf16* __restrict__ hb, float* __restrict__ ssp_out) {
    const int t = blockIdx.x * 4 + (threadIdx.x >> 6), lane = threadIdx.x & 63;
    float x[16], acc[16];
#pragma unroll
    for (int j = 0; j < 4; ++j) { const f32x4 v = *(const f32x4*)(h + (size_t)t * 1024 + lane * 16 + 4 * j); x[4 * j] = v[0]; x[4 * j + 1] = v[1]; x[4 * j + 2] = v[2]; x[4 * j + 3] = v[3]; }
#pragma unroll
    for (int j = 0; j < 16; ++j) acc[j] = 0.f;
    float ssum = 0.f; for (int p = 0; p < np; ++p) ssum += ssp_in[(size_t)p * T + t];
    const float rstd = rsqrtf(ssum * (1.f / 1024.f) + 1e-6f);
    for (int k = 0; k < 128; ++k) {
        const int e = eid[(size_t)t * 128 + k];
        const float g = gate[(size_t)t * 128 + k];
        const v4u uw = *(const v4u*)(U8 + (size_t)e * 1024 + lane * 16);
        float s = 0.f;
#pragma unroll
        for (int j = 0; j < 4; ++j) { const f32x2 a = __builtin_amdgcn_cvt_pk_f32_fp8((int)uw[j], false), c = __builtin_amdgcn_cvt_pk_f32_fp8((int)uw[j], true);
            s += a[0] * x[4 * j] + a[1] * x[4 * j + 1] + c[0] * x[4 * j + 2] + c[1] * x[4 * j + 3]; }
        s = wave_sum(s);
        const float coef = g * gelu_tanh(s * rstd * isu[e]) * isv[e];
        const v4u vw = *(const v4u*)(V8 + (size_t)e * 1024 + lane * 16);
#pragma unroll
        for (int j = 0; j < 4; ++j) { const f32x2 a = __builtin_amdgcn_cvt_pk_f32_fp8((int)vw[j], false), c = __builtin_amdgcn_cvt_pk_f32_fp8((int)vw[j], true);
            acc[4 * j] = fmaf(coef, a[0], acc[4 * j]); acc[4 * j + 1] = fmaf(coef, a[1], acc[4 * j + 1]); acc[4 * j + 2] = fmaf(coef, c[0], acc[4 * j + 2]); acc[4 * j + 3] = fmaf(coef, c[1], acc[4 * j + 3]); }
    }
    float ss = 0.f;
#pragma unroll
    for (int j = 0; j < 16; ++j) { acc[j] += x[j]; ss += acc[j] * acc[j]; }
    ss = wave_sum(ss);
#pragma unroll
    for (int j = 0; j < 4; ++j) { f32x4 o = {acc[4 * j], acc[4 * j + 1], acc[4 * j + 2], acc[4 * j + 3]}; *(f32x4*)(h + (size_t)t * 1024 + lane * 16 + 4 * j) = o; }
    v4u o0, o1; o0.x = pk2(acc[0], acc[1]); o0.y = pk2(acc[2], acc[3]); o0.z = pk2(acc[4], acc[5]); o0.w = pk2(acc[6], acc[7]);
    o1.x = pk2(acc[8], acc[9]); o1.y = pk2(acc[10], acc[11]); o1.z = pk2(acc[12], acc[13]); o1.w = pk2(acc[14], acc[15]);
    *(v4u*)(hb + (size_t)t * 1024 + lane * 16) = o0; *(v4u*)(hb + (size_t)t * 1024 + lane * 16 + 8) = o1;
    if (lane == 0) ssp_out[t] = ss;
}
}

typedef short v4i16_t __attribute__((ext_vector_type(4)));
__device__ __forceinline__ int crow(int r, int hi) { return (r & 3) + 8 * (r >> 2) + 4 * hi; }
__device__ __forceinline__ unsigned cvtpk(float lo, float hi) { typedef __bf16 bf16x2_t __attribute__((ext_vector_type(2))); f32x2 v = {lo, hi}; bf16x2_t b = __builtin_convertvector(v, bf16x2_t); return __builtin_bit_cast(unsigned, b); }
__device__ __forceinline__ bf16x8 mk8(unsigned a, unsigned b, unsigned c, unsigned d) { v4u w = {a, b, c, d}; return __builtin_bit_cast(bf16x8, w); }
__device__ __forceinline__ bf16x8 vfrag(LAS const unsigned char* p) {
    const v4i16_t lo = __builtin_amdgcn_ds_read_tr16_b64_v4i16((LAS v4i16_t*)p), hi = __builtin_amdgcn_ds_read_tr16_b64_v4i16((LAS v4i16_t*)(p + 512));
    return (bf16x8){lo[0], lo[1], lo[2], lo[3], hi[0], hi[1], hi[2], hi[3]};
}
__device__ __forceinline__ void vtile_load(v4u (&vv)[8], const bf16* vp0, int pitch, int lane) {
    const bf16* vp = vp0 + (size_t)(lane >> 3) * pitch + (lane & 7) * 8;
#pragma unroll
    for (int i = 0; i < 8; ++i) vv[i] = *(const v4u*)(vp + (size_t)i * 8 * pitch);
}
__device__ __forceinline__ void vtile_store(const v4u (&vv)[8], LAS unsigned char* wl, int lane) {
    const int c = lane & 7;
#pragma unroll
    for (int i = 0; i < 8; ++i) { const int kv = 8 * i + (lane >> 3); *(LAS v4u*)(wl + (c >> 2) * 4096 + (kv >> 4) * 1024 + (kv & 15) * 64 + (c & 3) * 16) = vv[i]; }
}
__device__ __forceinline__ void otile_store(const f32x16& o0, const f32x16& o1, LAS unsigned char* stg, bf16* Orow0, int pitch, int lane) {
    const int r32 = lane & 31, hi = lane >> 5;
    LAS unsigned short* s16 = (LAS unsigned short*)stg;
#pragma unroll
    for (int r = 0; r < 16; ++r) { const int orow = crow(r, hi); s16[orow * 64 + r32] = (unsigned short)f2bf(o0[r]); s16[orow * 64 + 32 + r32] = (unsigned short)f2bf(o1[r]); }
#pragma unroll
    for (int i = 0; i < 4; ++i) { const int row = i * 8 + (lane >> 3), ch = lane & 7; const v4u v = *(LAS const v4u*)(stg + row * 128 + ch * 16); *(v4u*)(Orow0 + (size_t)row * pitch + ch * 8) = v; }
}
#define MFMA32(A, B, C) __builtin_amdgcn_mfma_f32_32x32x16_bf16((A), (B), (C), 0, 0, 0)

__device__ __forceinline__ void sb_unit(const bf16* Q, const bf16* K, const bf16* V, bf16* O, int b, int h, int t0, LAS unsigned char* wl, int lane,
                                        const bf16x8 tri0, const bf16x8 tri1, const bf16x8 ones) {
    const int r32 = lane & 31, hi = lane >> 5;
    const size_t rowb = (size_t)b * S;
    const bf16* qp = Q + (rowb + t0 + r32) * 1024 + h * 64 + hi * 8;
    bf16x8 qf[4];
#pragma unroll
    for (int d0 = 0; d0 < 4; ++d0) qf[d0] = *(const bf16x8*)(qp + d0 * 16);
    f32x16 o0 = {}, o1 = {};
    float carry = 0.f;
    const int tdiag = t0 >> 6;
    LAS const unsigned char* vb = wl + ((lane >> 4) & 1) * 32 + (lane & 3) * 8 + (4 * hi + ((lane & 15) >> 2)) * 64;
    for (int tile = tdiag; tile >= 0; --tile) {
        const int s0 = tile * 64;
        const bf16* kp = K + (rowb + s0 + r32) * 1024 + h * 64 + hi * 8;
        bf16x8 kf[8];
#pragma unroll
        for (int d0 = 0; d0 < 4; ++d0) { kf[2 * d0] = *(const bf16x8*)(kp + d0 * 16); kf[2 * d0 + 1] = *(const bf16x8*)(kp + 32 * 1024 + d0 * 16); }
        v4u vv[8];
        vtile_load(vv, V + (rowb + s0) * 1024 + h * 64, 1024, lane);
        f32x16 p0 = {}, p1 = {};
#pragma unroll
        for (int d0 = 0; d0 < 4; ++d0) { p0 = MFMA32(kf[2 * d0], qf[d0], p0); p1 = MFMA32(kf[2 * d0 + 1], qf[d0], p1); }
        vtile_store(vv, wl, lane);
        const int lim = t0 + r32 - s0;
        unsigned lw[16]; float sumL = 0.f;
#pragma unroll
        for (int r = 0; r < 16; r += 2) {
            float La[2], Lb[2];
#pragma unroll
            for (int q = 0; q < 2; ++q) {
                { const float zc = fminf(p0[r + q], 126.f); const float sp = __builtin_amdgcn_logf(1.f + __builtin_amdgcn_exp2f(zc)); const bool ok = crow(r + q, hi) < lim;
                  La[q] = ok ? -sp : 0.f; p0[r + q] = ok ? zc - sp : -INFINITY; }
                { const float zc = fminf(p1[r + q], 126.f); const float sp = __builtin_amdgcn_logf(1.f + __builtin_amdgcn_exp2f(zc)); const bool ok = crow(r + q, hi) + 32 < lim;
                  Lb[q] = ok ? -sp : 0.f; p1[r + q] = ok ? zc - sp : -INFINITY; }
            }
            sumL += (La[0] + La[1]) + (Lb[0] + Lb[1]);
            lw[r >> 1] = cvtpk(La[0], La[1]); lw[8 + (r >> 1)] = cvtpk(Lb[0], Lb[1]);
        }
        f32x16 cinit;
#pragma unroll
        for (int r = 0; r < 16; ++r) cinit[r] = carry;
        const bf16x8 x00 = mk8(lw[0], lw[1], lw[2], lw[3]), x01 = mk8(lw[4], lw[5], lw[6], lw[7]), x10 = mk8(lw[8], lw[9], lw[10], lw[11]), x11 = mk8(lw[12], lw[13], lw[14], lw[15]);
        f32x16 y0 = MFMA32(tri0, x00, cinit); y0 = MFMA32(tri1, x01, y0); y0 = MFMA32(ones, x10, y0); y0 = MFMA32(ones, x11, y0);
        f32x16 y1 = MFMA32(tri0, x10, cinit); y1 = MFMA32(tri1, x11, y1);
        unsigned aw[16];
#pragma unroll
        for (int r = 0; r < 16; r += 2) {
            const float a0 = __builtin_amdgcn_exp2f(p0[r] + y0[r]), a1 = __builtin_amdgcn_exp2f(p0[r + 1] + y0[r + 1]);
            const float c0 = __builtin_amdgcn_exp2f(p1[r] + y1[r]), c1 = __builtin_amdgcn_exp2f(p1[r + 1] + y1[r + 1]);
            aw[r >> 1] = cvtpk(a0, a1); aw[8 + (r >> 1)] = cvtpk(c0, c1);
        }
#pragma unroll
        for (int ks = 0; ks < 4; ++ks) {
            const bf16x8 pa = mk8(aw[4 * ks], aw[4 * ks + 1], aw[4 * ks + 2], aw[4 * ks + 3]);
            o0 = MFMA32(pa, vfrag(vb + ks * 1024), o0);
            o1 = MFMA32(pa, vfrag(vb + 4096 + ks * 1024), o1);
        }
        { const auto rr = __builtin_amdgcn_permlane32_swap(__float_as_uint(sumL), __float_as_uint(sumL), false, false); carry += __uint_as_float(rr[0]) + __uint_as_float(rr[1]); }
        if (__all(carry < -160.f)) break;
    }
    otile_store(o0, o1, wl + 8192, O + (rowb + t0) * 1024 + h * 64, 1024, lane);
}
__device__ __forceinline__ void phase_sbatt(const bf16* Q, const bf16* K, const bf16* V, bf16* O, LAS unsigned char* lds, int vcu, int G, int wave, int lane) {
    const int r32 = lane & 31, hi = lane >> 5;
    unsigned t0w[4], t1w[4];
#pragma unroll
    for (int j = 0; j < 8; ++j) {
        const int kv0 = 8 * (j >> 2) + 4 * hi + (j & 3);
        const unsigned b0 = (kv0 > r32) ? 0x3F80u : 0u, b1 = (kv0 + 16 > r32) ? 0x3F80u : 0u;
        if (j & 1) { t0w[j >> 1] |= b0 << 16; t1w[j >> 1] |= b1 << 16; } else { t0w[j >> 1] = b0; t1w[j >> 1] = b1; }
    }
    const bf16x8 tri0 = mk8(t0w[0], t0w[1], t0w[2], t0w[3]), tri1 = mk8(t1w[0], t1w[1], t1w[2], t1w[3]), ones = mk8(0x3F803F80u, 0x3F803F80u, 0x3F803F80u, 0x3F803F80u);
    LAS unsigned char* wl = lds + wave * 12288;
    const int nunits = NB * 16 * (S / 32);
    for (int it = 0; ; ++it) {
        const int u = (it * G + vcu) * NWAVES + wave;
        if (u >= nunits) break;
        const int bh = u >> 7, qb = u & 127;
        sb_unit(Q, K, V, O, bh >> 4, bh & 15, qb * 32, wl, lane, tri0, tri1, ones);
    }
}

__device__ __forceinline__ void sw_unit(const bf16* QKV, const float* qg, const float* kg, float sink2, float slope2, bf16* O, int b, int h, int t0, LAS unsigned char* wl, int lane) {
    const int r32 = lane & 31, hi = lane >> 5, kvh = h >> 2;
    const size_t rowb = (size_t)b * S;
    LAS float* wsf = (LAS float*)(wl + 12288);
    bf16x8 qf[4];
    {
        const bf16* qp = QKV + (rowb + t0 + r32) * 1536 + h * 64 + hi * 8;
        v4u raw[4]; float ss = 0.f;
#pragma unroll
        for (int d0 = 0; d0 < 4; ++d0) { raw[d0] = *(const v4u*)(qp + d0 * 16);
#pragma unroll
            for (int w = 0; w < 4; ++w) { const float a = bflo(raw[d0][w]), c = bfhi(raw[d0][w]); ss += a * a + c * c; } }
        { const auto rr = __builtin_amdgcn_permlane32_swap(__float_as_uint(ss), __float_as_uint(ss), false, false); ss = __uint_as_float(rr[0]) + __uint_as_float(rr[1]); }
        const float rq = rsqrtf(ss * (1.f / 64.f) + 1e-6f) * C2;
#pragma unroll
        for (int d0 = 0; d0 < 4; ++d0) { const f32x4 g0 = *(const f32x4*)(qg + d0 * 16 + hi * 8), g1 = *(const f32x4*)(qg + d0 * 16 + hi * 8 + 4);
            qf[d0] = mk8(cvtpk(bflo(raw[d0][0]) * rq * g0[0], bfhi(raw[d0][0]) * rq * g0[1]), cvtpk(bflo(raw[d0][1]) * rq * g0[2], bfhi(raw[d0][1]) * rq * g0[3]),
                         cvtpk(bflo(raw[d0][2]) * rq * g1[0], bfhi(raw[d0][2]) * rq * g1[1]), cvtpk(bflo(raw[d0][3]) * rq * g1[2], bfhi(raw[d0][3]) * rq * g1[3])); }
    }
    float m = sink2, l = 1.f;
    f32x16 o0 = {}, o1 = {};
    LAS const unsigned char* vb = wl + ((lane >> 4) & 1) * 32 + (lane & 3) * 8 + (4 * hi + ((lane & 15) >> 2)) * 64;
    const int thi = t0 >> 6, tlo = (t0 >= 127) ? ((t0 - 127) >> 6) : 0;
    for (int tile = thi; tile >= tlo; --tile) {
        const int s0 = tile * 64;
        bf16x8 kf[8];
#pragma unroll
        for (int half = 0; half < 2; ++half) {
            const bf16* kp = QKV + (rowb + s0 + 32 * half + r32) * 1536 + 1024 + kvh * 64 + hi * 8;
            v4u raw[4]; float ss = 0.f;
#pragma unroll
            for (int d0 = 0; d0 < 4; ++d0) { raw[d0] = *(const v4u*)(kp + d0 * 16);
#pragma unroll
                for (int w = 0; w < 4; ++w) { const float a = bflo(raw[d0][w]), c = bfhi(raw[d0][w]); ss += a * a + c * c; } }
            { const auto rr = __builtin_amdgcn_permlane32_swap(__float_as_uint(ss), __float_as_uint(ss), false, false); ss = __uint_as_float(rr[0]) + __uint_as_float(rr[1]); }
            const float rk = rsqrtf(ss * (1.f / 64.f) + 1e-6f);
#pragma unroll
            for (int d0 = 0; d0 < 4; ++d0) { const f32x4 g0 = *(const f32x4*)(kg + d0 * 16 + hi * 8), g1 = *(const f32x4*)(kg + d0 * 16 + hi * 8 + 4);
                kf[2 * d0 + half] = mk8(cvtpk(bflo(raw[d0][0]) * rk * g0[0], bfhi(raw[d0][0]) * rk * g0[1]), cvtpk(bflo(raw[d0][1]) * rk * g0[2], bfhi(raw[d0][1]) * rk * g0[3]),
                                        cvtpk(bflo(raw[d0][2]) * rk * g1[0], bfhi(raw[d0][2]) * rk * g1[1]), cvtpk(bflo(raw[d0][3]) * rk * g1[2], bfhi(raw[d0][3]) * rk * g1[3])); }
        }
        v4u vv[8];
        vtile_load(vv, QKV + (rowb + s0) * 1536 + 1280 + kvh * 64, 1536, lane);
        f32x16 p0 = {}, p1 = {};
#pragma unroll
        for (int d0 = 0; d0 < 4; ++d0) { p0 = MFMA32(kf[2 * d0], qf[d0], p0); p1 = MFMA32(kf[2 * d0 + 1], qf[d0], p1); }
        vtile_store(vv, wl, lane);
        const int dq = t0 + r32 - s0;
        float rmax = -INFINITY;
#pragma unroll
        for (int r = 0; r < 16; ++r) {
            { const int dist = dq - crow(r, hi); const bool ok = dist >= 0 && dist < 128; p0[r] = ok ? p0[r] - slope2 * (float)dist : -INFINITY; rmax = fmaxf(rmax, p0[r]); }
            { const int dist = dq - crow(r, hi) - 32; const bool ok = dist >= 0 && dist < 128; p1[r] = ok ? p1[r] - slope2 * (float)dist : -INFINITY; rmax = fmaxf(rmax, p1[r]); }
        }
        { const auto rr = __builtin_amdgcn_permlane32_swap(__float_as_uint(rmax), __float_as_uint(rmax), false, false); rmax = fmaxf(__uint_as_float(rr[0]), __uint_as_float(rr[1])); }
        const float mn = fmaxf(m, rmax);
        const float alpha = __builtin_amdgcn_exp2f(m - mn);
        m = mn;
        float rsum = 0.f; unsigned aw[16];
#pragma unroll
        for (int r = 0; r < 16; r += 2) {
            const float a0 = __builtin_amdgcn_exp2f(p0[r] - mn), a1 = __builtin_amdgcn_exp2f(p0[r + 1] - mn), c0 = __builtin_amdgcn_exp2f(p1[r] - mn), c1 = __builtin_amdgcn_exp2f(p1[r + 1] - mn);
            rsum += (a0 + a1) + (c0 + c1);
            aw[r >> 1] = cvtpk(a0, a1); aw[8 + (r >> 1)] = cvtpk(c0, c1);
        }
        { const auto rr = __builtin_amdgcn_permlane32_swap(__float_as_uint(rsum), __float_as_uint(rsum), false, false); rsum = __uint_as_float(rr[0]) + __uint_as_float(rr[1]); }
        l = l * alpha + rsum;
        if (hi == 0) wsf[r32] = alpha;
#pragma unroll
        for (int r = 0; r < 16; ++r) { const float f = wsf[crow(r, hi)]; o0[r] *= f; o1[r] *= f; }
#pragma unroll
        for (int ks = 0; ks < 4; ++ks) {
            const bf16x8 pa = mk8(aw[4 * ks], aw[4 * ks + 1], aw[4 * ks + 2], aw[4 * ks + 3]);
            o0 = MFMA32(pa, vfrag(vb + ks * 1024), o0);
            o1 = MFMA32(pa, vfrag(vb + 4096 + ks * 1024), o1);
        }
    }
    if (hi == 0) wsf[32 + r32] = 1.f / l;
#pragma unroll
    for (int r = 0; r < 16; ++r) { const float f = wsf[32 + crow(r, hi)]; o0[r] *= f; o1[r] *= f; }
    otile_store(o0, o1, wl + 8192, O + (rowb + t0) * 1024 + h * 64, 1024, lane);
}
__device__ __forceinline__ void phase_swatt(const bf16* QKV, const float* qg, const float* kg, const float* sinks, bf16* O, LAS unsigned char* lds, int vcu, int G, int wave, int lane) {
    LAS unsigned char* wl = lds + wave * 12544;
    const int nunits = NB * 16 * (S / 32);
    for (int it = 0; ; ++it) {
        const int u = (it * G + vcu) * NWAVES + wave;
        if (u >= nunits) break;
        const int bh = u >> 7, qb = u & 127, h = bh & 15;
        sw_unit(QKV, qg, kg, sinks[h] * LOG2E, exp2f(-0.5f * (float)(h + 1)) * LOG2E, O, bh >> 4, h, qb * 32, wl, lane);
    }
}

__device__ __forceinline__ void ce_desc(float& a, float& b) { float mx, mn; asm("v_max_f32_e32 %0, %1, %2" : "=v"(mx) : "v"(a), "v"(b)); asm("v_min_f32_e32 %0, %1, %2" : "=v"(mn) : "v"(a), "v"(b)); a = mx; b = mn; }
__device__ __forceinline__ float maxf_raw(float a, float b) { float mx; asm("v_max_f32_e32 %0, %1, %2" : "=v"(mx) : "v"(a), "v"(b)); return mx; }
__device__ __forceinline__ void sort16_desc(float (&v)[16]) {
#pragma unroll
    for (int k = 2; k <= 16; k <<= 1)
#pragma unroll
        for (int j = k >> 1; j > 0; j >>= 1)
#pragma unroll
            for (int i = 0; i < 16; ++i) { const int l = i ^ j; if (l > i) { if ((i & k) == 0) ce_desc(v[i], v[l]); else ce_desc(v[l], v[i]); } }
}
__device__ __forceinline__ void merge16_desc(float (&a)[16], const float (&b)[16]) {
#pragma unroll
    for (int i = 0; i < 16; ++i) a[i] = maxf_raw(a[i], b[15 - i]);
#pragma unroll
    for (int j = 8; j > 0; j >>= 1)
#pragma unroll
        for (int i = 0; i < 16; ++i) { const int l = i ^ j; if (l > i) ce_desc(a[i], a[l]); }
}
__device__ __forceinline__ void top16_of_4x16(float (&g0)[16], float (&g1)[16], float (&g2)[16], float (&g3)[16]) {
    sort16_desc(g0); sort16_desc(g1); sort16_desc(g2); sort16_desc(g3);
    merge16_desc(g0, g1); merge16_desc(g2, g3); merge16_desc(g0, g2);
}
__device__ __forceinline__ float setcode(float v, unsigned clear_mask, unsigned code) { return __uint_as_float((__float_as_uint(v) & clear_mask) | code); }

__device__ __forceinline__ void topk_unit(const bf16* QP, const bf16* SUBK, int* EID, float* GATE, int tt, int h, int lane) {
    const int r32 = lane & 31, hi = lane >> 5;
    float L[2][16];
#pragma unroll
    for (int p = 0; p < 2; ++p) {
        const bf16* qp = QP + (size_t)(tt * 32 + r32) * 2048 + h * 256 + p * 128 + hi * 8;
        bf16x8 qf[8];
#pragma unroll
        for (int ks = 0; ks < 8; ++ks) qf[ks] = *(const bf16x8*)(qp + ks * 16);
        const bf16* kp = SUBK + ((size_t)(h * 2 + p) * 128 + r32) * 128 + hi * 8;
        float g[4][16];
#pragma unroll
        for (int mt = 0; mt < 4; ++mt) {
            f32x16 acc = {};
#pragma unroll
            for (int ks = 0; ks < 8; ++ks) acc = MFMA32(*(const bf16x8*)(kp + (size_t)mt * 32 * 128 + ks * 16), qf[ks], acc);
#pragma unroll
            for (int r = 0; r < 16; ++r) g[mt][r] = setcode(acc[r], 0xFFFFFF80u, (unsigned)(32 * mt + (r & 3) + 8 * (r >> 2)));
            asm volatile("" ::: "memory");
        }
        top16_of_4x16(g[0], g[1], g[2], g[3]);
        float other[16];
#pragma unroll
        for (int i = 0; i < 16; ++i) {
            g[0][i] = __uint_as_float(__float_as_uint(g[0][i]) | (unsigned)(hi << 2));
            const auto rr = __builtin_amdgcn_permlane32_swap(__float_as_uint(g[0][i]), __float_as_uint(g[0][i]), false, false);
            other[i] = __uint_as_float(hi ? rr[0] : rr[1]);
        }
        merge16_desc(g[0], other);
#pragma unroll
        for (int i = 0; i < 16; ++i) L[p][i] = g[0][i];
    }
    unsigned TA[4], TB[4];
#pragma unroll
    for (int k = 0; k < 16; ++k) {
        const unsigned ca = (__float_as_uint(L[0][k]) & 0x7Fu) << (8 * (k & 3)), cb = (__float_as_uint(L[1][k]) & 0x7Fu) << (8 * (k & 3));
        if ((k & 3) == 0) { TA[k >> 2] = ca; TB[k >> 2] = cb; } else { TA[k >> 2] |= ca; TB[k >> 2] |= cb; }
    }
    float c[4][16];
    {
        int n = 0;
#pragma unroll
        for (int i = 0; i < 16; ++i)
#pragma unroll
            for (int j = 0; j < 16; ++j)
                if ((i + 1) * (j + 1) <= 16) { c[n >> 4][n & 15] = setcode(L[0][i] + L[1][j], 0xFFFFFF00u, (unsigned)(i * 16 + j)); ++n; }
#pragma unroll
        for (int k = 50; k < 64; ++k) c[k >> 4][k & 15] = -INFINITY;
    }
    top16_of_4x16(c[0], c[1], c[2], c[3]);
    float ex[16]; float den = 0.f;
#pragma unroll
    for (int r = 0; r < 16; ++r) { ex[r] = __builtin_amdgcn_exp2f((c[0][r] - c[0][0]) * LOG2E); den += ex[r]; }
    const float inv = 1.f / den;
    unsigned eidv[16];
#pragma unroll
    for (int r = 0; r < 16; ++r) {
        const unsigned code = __float_as_uint(c[0][r]) & 0xFFu, i = code >> 4, j = code & 15u;
        const unsigned sa = (i & 7u) | 0x0C0C0C00u, sb = (j & 7u) | 0x0C0C0C00u;
        const unsigned ia = (i & 8u) ? __builtin_amdgcn_perm(TA[3], TA[2], sa) : __builtin_amdgcn_perm(TA[1], TA[0], sa);
        const unsigned ib = (j & 8u) ? __builtin_amdgcn_perm(TB[3], TB[2], sb) : __builtin_amdgcn_perm(TB[1], TB[0], sb);
        eidv[r] = ia * 128u + ib;
        ex[r] *= inv;
    }
    if (hi == 0) {
        const size_t off = (size_t)(tt * 32 + r32) * 128 + h * 16;
#pragma unroll
        for (int q = 0; q < 4; ++q) {
            v4u e4 = {eidv[4 * q], eidv[4 * q + 1], eidv[4 * q + 2], eidv[4 * q + 3]}; *(v4u*)(EID + off + 4 * q) = e4;
            f32x4 g4 = {ex[4 * q], ex[4 * q + 1], ex[4 * q + 2], ex[4 * q + 3]}; *(f32x4*)(GATE + off + 4 * q) = g4;
        }
    }
}
__device__ __forceinline__ void phase_topk(const bf16* QP, const bf16* SUBK, int* EID, float* GATE, int vcu, int G, int wave, int lane) {
    const int nunits = (T / 32) * 8;
    for (int it = 0; ; ++it) {
        const int u = (it * G + vcu) * NWAVES + wave;
        if (u >= nunits) break;
        topk_unit(QP, SUBK, EID, GATE, u >> 3, u & 7, lane);
    }
}

__device__ __forceinline__ float gelu_tanh_f(float x) { const float u = 0.7978845608028654f * (x + 0.044715f * x * x * x); const float e = __builtin_amdgcn_exp2f(u * (2.f * LOG2E)); return x * (1.f - __builtin_amdgcn_rcpf(e + 1.f)); }
__device__ __forceinline__ void gather_token(float* h, const float* ssp_in, int np, const unsigned char* U8, const unsigned char* V8, const float* isu, const float* isv,
                                             const int* eid, const float* gate, bf16* hb, float* ssp_out, int t, int lane) {
    float x[16], acc[16];
#pragma unroll
    for (int j = 0; j < 4; ++j) { const f32x4 v = *(const f32x4*)(h + (size_t)t * 1024 + lane * 16 + 4 * j); x[4 * j] = v[0]; x[4 * j + 1] = v[1]; x[4 * j + 2] = v[2]; x[4 * j + 3] = v[3]; }
#pragma unroll
    for (int j = 0; j < 16; ++j) acc[j] = 0.f;
    float ssum = 0.f; for (int p = 0; p < np; ++p) ssum += ssp_in[(size_t)p * T + t];
    const float rstd = rsqrtf(ssum * (1.f / 1024.f) + 1e-6f);
    for (int k = 0; k < 128; ++k) {
        const int e = eid[(size_t)t * 128 + k];
        const float g = gate[(size_t)t * 128 + k];
        const v4u uw = *(const v4u*)(U8 + (size_t)e * 1024 + lane * 16);
        const v4u vw = *(const v4u*)(V8 + (size_t)e * 1024 + lane * 16);
        float s = 0.f;
#pragma unroll
        for (int j = 0; j < 4; ++j) { const f32x2 a = __builtin_amdgcn_cvt_pk_f32_fp8((int)uw[j], false), c = __builtin_amdgcn_cvt_pk_f32_fp8((int)uw[j], true);
            s += a[0] * x[4 * j] + a[1] * x[4 * j + 1] + c[0] * x[4 * j + 2] + c[1] * x[4 * j + 3]; }
        s = wave_sum(s);
        const float coef = g * gelu_tanh_f(s * rstd * isu[e]) * isv[e];
#pragma unroll
        for (int j = 0; j < 4; ++j) { const f32x2 a = __builtin_amdgcn_cvt_pk_f32_fp8((int)vw[j], false), c = __builtin_amdgcn_cvt_pk_f32_fp8((int)vw[j], true);
            acc[4 * j] = fmaf(coef, a[0], acc[4 * j]); acc[4 * j + 1] = fmaf(coef, a[1], acc[4 * j + 1]); acc[4 * j + 2] = fmaf(coef, c[0], acc[4 * j + 2]); acc[4 * j + 3] = fmaf(coef, c[1], acc[4 * j + 3]); }
    }
    float ss = 0.f;
#pragma unroll
    for (int j = 0; j < 16; ++j) { acc[j] += x[j]; ss += acc[j] * acc[j]; }
    ss = wave_sum(ss);
#pragma unroll
    for (int j = 0; j < 4; ++j) { f32x4 o = {acc[4 * j], acc[4 * j + 1], acc[4 * j + 2], acc[4 * j + 3]}; *(f32x4*)(h + (size_t)t * 1024 + lane * 16 + 4 * j) = o; }
    v4u o0, o1; o0.x = pk2(acc[0], acc[1]); o0.y = pk2(acc[2], acc[3]); o0.z = pk2(acc[4], acc[5]); o0.w = pk2(acc[6], acc[7]);
    o1.x = pk2(acc[8], acc[9]); o1.y = pk2(acc[10], acc[11]); o1.z = pk2(acc[12], acc[13]); o1.w = pk2(acc[14], acc[15]);
    *(v4u*)(hb + (size_t)t * 1024 + lane * 16) = o0; *(v4u*)(hb + (size_t)t * 1024 + lane * 16 + 8) = o1;
    if (lane == 0) ssp_out[t] = ss;
}
__device__ __forceinline__ void phase_gather(float* h, const float* ssp_in, int np, const unsigned char* U8, const unsigned char* V8, const float* isu, const float* isv,
                                             const int* eid, const float* gate, bf16* hb, float* ssp_out, int gw, int NGW, int lane) {
    for (int t = gw; t < T; t += NGW) gather_token(h, ssp_in, np, U8, V8, isu, isv, eid, gate, hb, ssp_out, t, lane);
}

enum Phase { PH_PREP = 0, PH_QKV0 = 1, PH_SBATT = 2, PH_OPROJ0 = 3, PH_PQ0 = 4, PH_TOPK0 = 5, PH_GATH0 = 6, PH_QKV1 = 7, PH_SWATT = 8, PH_OPROJ1 = 9, PH_PQ1 = 10, PH_TOPK1 = 11, PH_GATH1 = 12, PH_N = 13 };

__global__ void __launch_bounds__(NWAVES * 64, 2) mega(Args a) {
    extern __shared__ __attribute__((aligned(16))) unsigned char lds_raw[];
    LAS unsigned char* lds = (LAS unsigned char*)lds_raw;
    volatile LAS unsigned* MISC = (volatile LAS unsigned*)(lds + MISC_OFF);
    LAS float* rs = (LAS float*)(lds + RS_OFF);
    const int tid = threadIdx.x, lane = tid & 63, wave = __builtin_amdgcn_readfirstlane(tid >> 6);
    const int G = gridDim.x; const int bx = blockIdx.x; const int vcu = (G % 8 == 0) ? (bx % 8) * (G / 8) + bx / 8 : bx;
    const int gw = vcu * NWAVES + wave, NGW = G * NWAVES;
    unsigned char* ws = a.ws;
    gu32* ctl = (gu32*)(ws + WS_CTL);
    for (int u = tid; u < 64; u += NWAVES * 64) ((LAS unsigned*)(lds + MISC_OFF))[u] = 0u;
    __syncthreads();
    XcdBarrier bar = xcd_barrier_post((unsigned*)(ctl + CW_BAR) + a.li * XCD_BAR_WORDS, MISC + 8);
    bool first = true;
#define PHASE_ON(k) ((a.mask >> (k)) & 1u)
#define SEAM() do { if (!first) xcd_barrier(bar); first = false; } while (0)

    bf16* HB = (bf16*)(ws + WS_HB); bf16* QB = (bf16*)(ws + WS_QB); bf16* AO = (bf16*)(ws + WS_AO); bf16* QP = (bf16*)(ws + WS_QP);
    float* SSP0 = (float*)(ws + WS_SSP); float* SSP1 = SSP0 + 16 * T; float* SSP2 = SSP1 + 16 * T; float* SSP3 = SSP2 + 16 * T;

    if (PHASE_ON(PH_PREP)) { SEAM(); phase_prep(a, lds, gw, NGW, wave, lane); }

    if (PHASE_ON(PH_QKV0)) { SEAM();
        pg8::Gemm g{HB, (const bf16*)(ws + WS_WQKV0), T, 3072, 1024}; pg8::StaticOrder So; So.init(T, 3072, G, bx);
        fill_rs(rs, So, SSP0, 1, tid);
        pg8::EpiScaleBf16 E{QB, 1024, 1024, (size_t)(WS_KB - WS_QB) / 2, C2, rs};
        pg8::gemm_phase<pg8::EpiScaleBf16, pg8::StaticOrder, true, true>(lds, g, So, E);
    }
    if (PHASE_ON(PH_SBATT)) { SEAM(); phase_sbatt(QB, (const bf16*)(ws + WS_KB), (const bf16*)(ws + WS_VB), AO, lds, vcu, G, wave, lane); }
    if (PHASE_ON(PH_OPROJ0)) { SEAM();
        pg8::Gemm g{AO, (const bf16*)(ws + WS_WO0), T, 1024, 1024}; pg8::StaticOrder So; So.init(T, 1024, G, bx);
        pg8::EpiResid E{a.in[0], a.out, HB, SSP1, T};
        pg8::gemm_phase<pg8::EpiResid, pg8::StaticOrder, true, true>(lds, g, So, E);
    }
    if (PHASE_ON(PH_PQ0)) { SEAM();
        pg8::Gemm g{HB, (const bf16*)(ws + WS_WPQ0), T, 2048, 1024}; pg8::StaticOrder So; So.init(T, 2048, G, bx);
        fill_rs(rs, So, SSP1, 16, tid);
        pg8::EpiScaleBf16 E{QP, 2048, 0, 0, 1.f, rs};
        pg8::gemm_phase<pg8::EpiScaleBf16, pg8::StaticOrder, true, true>(lds, g, So, E);
    }
    if (PHASE_ON(PH_TOPK0)) { SEAM(); phase_topk(QP, (const bf16*)(ws + WS_SUBK), (int*)(ws + WS_EID), (float*)(ws + WS_GATE), vcu, G, wave, lane); }
    if (PHASE_ON(PH_GATH0)) { SEAM(); phase_gather(a.out, SSP1, 16, ws + WS_U8, ws + WS_V8, (const float*)(ws + WS_ISU), (const float*)(ws + WS_ISV), (const int*)(ws + WS_EID), (const float*)(ws + WS_GATE), HB, SSP2, gw, NGW, lane); }
    if (PHASE_ON(PH_QKV1)) { SEAM();
        pg8::Gemm g{HB, (const bf16*)(ws + WS_WQKV1), T, 1536, 1024}; pg8::StaticOrder So; So.init(T, 1536, G, bx);
        fill_rs(rs, So, SSP2, 1, tid);
        pg8::EpiScaleBf16 E{QB, 1536, 0, 0, 1.f, rs};
        pg8::gemm_phase<pg8::EpiScaleBf16, pg8::StaticOrder, true, true>(lds, g, So, E);
    }
    if (PHASE_ON(PH_SWATT)) { SEAM(); phase_swatt(QB, a.in[6], a.in[7], a.in[8], AO, lds, vcu, G, wave, lane); }
    if (PHASE_ON(PH_OPROJ1)) { SEAM();
        pg8::Gemm g{AO, (const bf16*)(ws + WS_WO1), T, 1024, 1024}; pg8::StaticOrder So; So.init(T, 1024, G, bx);
        pg8::EpiResid E{a.out, a.out, HB, SSP3, T};
        pg8::gemm_phase<pg8::EpiResid, pg8::StaticOrder, true, true>(lds, g, So, E);
    }
    if (PHASE_ON(PH_PQ1)) { SEAM();
        pg8::Gemm g{HB, (const bf16*)(ws + WS_WPQ1), T, 2048, 1024}; pg8::StaticOrder So; So.init(T, 2048, G, bx);
        fill_rs(rs, So, SSP3, 16, tid);
        pg8::EpiScaleBf16 E{QP, 2048, 0, 0, 1.f, rs};
        pg8::gemm_phase<pg8::EpiScaleBf16, pg8::StaticOrder, true, true>(lds, g, So, E);
    }
    if (PHASE_ON(PH_TOPK1)) { SEAM(); phase_topk(QP, (const bf16*)(ws + WS_SUBK) + (size_t)8 * 2 * 128 * 128, (int*)(ws + WS_EID), (float*)(ws + WS_GATE), vcu, G, wave, lane); }
    if (PHASE_ON(PH_GATH1)) { SEAM(); phase_gather(a.out, SSP3, 16, ws + WS_U8 + (size_t)16384 * 1024, ws + WS_V8 + (size_t)16384 * 1024, (const float*)(ws + WS_ISU) + 16384, (const float*)(ws + WS_ISV) + 16384, (const int*)(ws + WS_EID), (const float*)(ws + WS_GATE), HB, SSP0, gw, NGW, lane); }
#undef PHASE_ON
#undef SEAM
}

static void launch_mega(const Args& a0, unsigned mask, int li, int grid, hipStream_t stream) {
    Args a = a0; a.mask = mask; a.li = li;
    void* params[] = {&a};
    hipError_t e = hipLaunchCooperativeKernel((const void*)mega, dim3(grid), dim3(NWAVES * 64), params, LDS_BYTES, stream);
    if (e != hipSuccess) fprintf(stderr, "kernel_launch: cooperative launch failed: %s (grid %d)\n", hipGetErrorString(e), grid);
}

extern "C" void kernel_launch(void* const* d_in, const int* in_sizes, int n_in, void* d_out, int out_size, void* d_ws, size_t ws_size, hipStream_t stream) {
    static int grid = 0;
    if (grid == 0) {
        if (n_in != 15 || out_size != T * D || ws_size < WS_END) { fprintf(stderr, "kernel_launch: unexpected shapes (n_in %d out %d ws %zu)\n", n_in, out_size, ws_size); grid = -1; return; }
        int dev = 0, cus = 0, per_cu = 0;
        if (hipGetDevice(&dev) != hipSuccess || hipDeviceGetAttribute(&cus, hipDeviceAttributeMultiprocessorCount, dev) != hipSuccess) { grid = -1; return; }
        if (hipFuncSetAttribute((const void*)mega, hipFuncAttributeMaxDynamicSharedMemorySize, LDS_BYTES) != hipSuccess) { fprintf(stderr, "kernel_launch: hipFuncSetAttribute failed\n"); grid = -1; return; }
        if (hipOccupancyMaxActiveBlocksPerMultiprocessor(&per_cu, (const void*)mega, NWAVES * 64, LDS_BYTES) != hipSuccess || per_cu < 1) { fprintf(stderr, "kernel_launch: occupancy query says %d blocks per CU\n", per_cu); per_cu = 1; }
        (void)hipGetLastError();
        grid = cus;
        if (grid != 256) fprintf(stderr, "kernel_launch: note: %d CUs (tuned for 256)\n", grid);
    }
    if (grid < 0) return;
    (void)hipMemsetAsync((char*)d_ws + WS_CTL, 0, CTL_ZERO_BYTES, stream);
    Args a{};
    for (int i = 0; i < 15; ++i) a.in[i] = (const float*)d_in[i];
    a.out = (float*)d_out; a.ws = (unsigned char*)d_ws;
    unsigned char* ws = (unsigned char*)d_ws;
    bf16* QB = (bf16*)(ws + WS_QB); bf16* KB = (bf16*)(ws + WS_KB); bf16* VB = (bf16*)(ws + WS_VB); bf16* AO = (bf16*)(ws + WS_AO); bf16* QP = (bf16*)(ws + WS_QP); bf16* HB = (bf16*)(ws + WS_HB);
    float* SSP0 = (float*)(ws + WS_SSP); float* SSP1 = SSP0 + 16 * T; float* SSP2 = SSP1 + 16 * T;  float* SSP3 = SSP2 + 16 * T;
    int* EID = (int*)(ws + WS_EID); float* GATE = (float*)(ws + WS_GATE);
    const unsigned char* U8 = ws + WS_U8; const unsigned char* V8 = ws + WS_V8; const float* ISU = (const float*)(ws + WS_ISU); const float* ISV = (const float*)(ws + WS_ISV);
    const bf16* SUBK = (const bf16*)(ws + WS_SUBK);
#define M(k) (1u << (k))
    launch_mega(a, (1u << PH_N) - 1u, 0, grid, stream);
#undef M
}
```

```cpp
#include <hip/hip_runtime.h>
#include <cstdint>
#include <cstdio>

constexpr int D = 1024, NB = 4, S = 4096, T = NB * S;
constexpr float LOG2E = 1.4426950408889634f;
constexpr float C2 = 0.125f * LOG2E;

constexpr size_t MiB = 1u << 20;
constexpr size_t WS_CTL = 0, CTL_ZERO_BYTES = 1 * MiB;
constexpr size_t WS_WQKV0 = 2 * MiB, WS_WO0 = 8 * MiB, WS_WQKV1 = 10 * MiB, WS_WO1 = 13 * MiB, WS_WPQ0 = 15 * MiB, WS_WPQ1 = 19 * MiB;
constexpr size_t WS_SUBK = 23 * MiB;
constexpr size_t WS_ISU = 24 * MiB;
constexpr size_t WS_ISV = WS_ISU + 2 * 16384 * 4;
constexpr size_t WS_SSP = 25 * MiB;
constexpr size_t WS_U8 = 32 * MiB, WS_V8 = 64 * MiB;
constexpr size_t WS_HB = 96 * MiB;
constexpr size_t WS_QB = 128 * MiB, WS_KB = 160 * MiB, WS_VB = 192 * MiB;
constexpr size_t WS_AO = 224 * MiB;
constexpr size_t WS_QP = 256 * MiB;
constexpr size_t WS_EID = 320 * MiB, WS_GATE = 328 * MiB;
constexpr size_t WS_HP = 336 * MiB;
constexpr size_t WS_COEF = 400 * MiB;
constexpr size_t WS_END = 408 * MiB;
namespace pg8 {
#define PG8_LAS __attribute__((address_space(3)))
typedef unsigned short bf16_t;
typedef short bf16x8 __attribute__((ext_vector_type(8)));
typedef float f32x4 __attribute__((ext_vector_type(4)));
typedef unsigned u32x4 __attribute__((ext_vector_type(4)));
constexpr int BM = 256, BK = 64, HALF = 128, HTB = HALF * BK * 2  , STAGE_BYTES = 8 * HTB, NXCD = 8, WGM = 8;

__host__ __device__ __forceinline__ int lds_byte(int r, int c) { const int st = (r >> 4) * 2 + (c >> 5), rr = r & 15, cc = c & 31, ob = rr * 64 + cc * 2; return st * 1024 + (ob ^ (((ob >> 9) & 1) << 5)); }
__host__ __device__ __forceinline__ void stage_rc(int b, int& R, int& C) { const int st = b / 1024, sb = b % 1024, swz = sb ^ (((sb >> 9) & 1) << 5); R = (st >> 1) * 16 + swz / 64; C = (st & 1) * 32 + (swz % 64) / 2; }
__host__ __device__ __forceinline__ int perm32(int rho) { const int n = rho >> 4, i = rho & 15; return 8 * (i >> 2) + 4 * n + (i & 3); }

struct Unit { int pm, pn; };
struct Gemm { const bf16_t* A; const bf16_t* Bt; int M, N, K; };

struct StaticOrder {
    int nM, nN, nwg, G, c;
    __host__ __device__ void init(int M, int N, int G_, int c_) { nM = M / BM; nN = N / BM; nwg = nM * nN; G = G_; c = c_; }
    __host__ __device__ bool next(int i, Unit& u) const {
        const long L = (long)i * G + c; if (L >= nwg) return false;
        int wgid = (int)L; { const int q = nwg / NXCD, r = nwg % NXCD, xcd = wgid % NXCD, off = wgid / NXCD; wgid = (xcd < r ? xcd * (q + 1) : r * (q + 1) + (xcd - r) * q) + off; }
        const int nig = WGM * nN, gid = wgid / nig, fm = gid * WGM, gsz = (nM - fm) < WGM ? (nM - fm) : WGM;
        u.pm = fm + ((wgid % nig) % gsz); u.pn = (wgid % nig) / gsz; return true;
    }
    __device__ __forceinline__ void a_ready(const Unit&) const {}
    __device__ __forceinline__ void done(const Unit&) const {}
};


__device__ __forceinline__ unsigned cvt_pk_bf16(float lo, float hi) { unsigned r; asm volatile("v_cvt_pk_bf16_f32 %0, %1, %2" : "=v"(r) : "v"(lo), "v"(hi)); return r; }

struct EpiScaleBf16 {
    static constexpr bool PERM = true, AFTER_DRAIN = false;
    bf16_t* O; int ldc; int split_cols; size_t split_stride; float scale0; const PG8_LAS float* rs;
    __device__ __forceinline__ void operator()(const f32x4 (&acc)[2][2][4][2], const Unit& u, int ui, int wr, int wc, int fr, int fq) const {
        const int row0 = u.pm * BM + wr * 64 + fr; int colt = u.pn * BM; bf16_t* base = O;
        float sc = 1.f; if (split_cols) { const int t = colt / split_cols; base += (size_t)t * split_stride; colt -= t * split_cols; if (t == 0) sc = scale0; }
        const int col0 = colt + wc * 32 + 8 * fq;
        const PG8_LAS float* rsu = rs + (ui & 3) * 256 + wr * 64 + fr;
#pragma unroll
        for (int ai = 0; ai < 2; ++ai)
#pragma unroll
            for (int m = 0; m < 4; ++m) { bf16_t* rowp = base + (size_t)(row0 + ai * HALF + m * 16) * ldc + col0; const float s = rsu[ai * HALF + m * 16] * sc;
#pragma unroll
                for (int bj = 0; bj < 2; ++bj) { const f32x4 v0 = acc[ai][bj][m][0] * s, v1 = acc[ai][bj][m][1] * s;
                    u32x4 w; w.x = cvt_pk_bf16(v0[0], v0[1]); w.y = cvt_pk_bf16(v0[2], v0[3]); w.z = cvt_pk_bf16(v1[0], v1[1]); w.w = cvt_pk_bf16(v1[2], v1[3]);
                    *(u32x4*)(rowp + bj * HALF) = w; } }
    }
};
struct EpiResid {
    static constexpr bool PERM = true, AFTER_DRAIN = false;
    const float* resid; float* out; bf16_t* hb; float* ssp; int nrows;
    __device__ __forceinline__ void operator()(const f32x4 (&acc)[2][2][4][2], const Unit& u, int ui, int wr, int wc, int fr, int fq) const {
        const int col0 = u.pn * BM + wc * 32 + 8 * fq;
#pragma unroll
        for (int ai = 0; ai < 2; ++ai)
#pragma unroll
            for (int m = 0; m < 4; ++m) { const int row = u.pm * BM + ai * HALF + wr * 64 + m * 16 + fr; const size_t off = (size_t)row * 1024 + col0; float ss = 0.f;
#pragma unroll
                for (int bj = 0; bj < 2; ++bj) { const f32x4 r0 = *(const f32x4*)(resid + off + bj * HALF), r1 = *(const f32x4*)(resid + off + bj * HALF + 4);
                    const f32x4 v0 = acc[ai][bj][m][0] + r0, v1 = acc[ai][bj][m][1] + r1;
                    *(f32x4*)(out + off + bj * HALF) = v0; *(f32x4*)(out + off + bj * HALF + 4) = v1;
                    ss += (v0[0] * v0[0] + v0[1] * v0[1]) + (v0[2] * v0[2] + v0[3] * v0[3]) + (v1[0] * v1[0] + v1[1] * v1[1]) + (v1[2] * v1[2] + v1[3] * v1[3]);
                    u32x4 w; w.x = cvt_pk_bf16(v0[0], v0[1]); w.y = cvt_pk_bf16(v0[2], v0[3]); w.z = cvt_pk_bf16(v1[0], v1[1]); w.w = cvt_pk_bf16(v1[2], v1[3]);
                    *(u32x4*)(hb + off + bj * HALF) = w; }
                ss += __shfl_xor(ss, 16); ss += __shfl_xor(ss, 32);
                if (fq == 0) ssp[(size_t)(u.pn * 4 + wc) * nrows + row] = ss;
                asm volatile("" ::: "memory"); }
    }
};
template <class Epi, class Sched, bool ALIGN_EPI = false, bool SP2 = false>
__device__ __forceinline__ void gemm_phase(PG8_LAS unsigned char* lds, const Gemm g, const Sched& S, const Epi& E) {
    const int tid = threadIdx.x, wid = __builtin_amdgcn_readfirstlane(tid >> 6), lane = tid & 63, wr = wid >> 2, wc = wid & 3, fr = lane & 15, fq = lane >> 4;
    const int K = g.K, nt = K / BK;
    unsigned voffA[2], voffB[2];
#pragma unroll
    for (int i = 0; i < 2; ++i) { int R, C; stage_rc(tid * 16 + i * 8192, R, C); const int Rb = Epi::PERM ? ((R & ~31) + perm32(R & 31)) : R;
        voffA[i] = (unsigned)(R * K + C) * 2u; voffB[i] = (unsigned)(Rb * K + C) * 2u; }
    const size_t kstep = (size_t)(BK * 2);
    const size_t hstep = (size_t)HALF * K * 2;
    const size_t tstep = 2 * hstep;
    const unsigned ldsw = (unsigned)wid * 1024u;
    const int aoff = lds_byte(wr * 64 + fr, fq * 8), boff = lds_byte(wc * 32 + fr, fq * 8);
#define PG8_SA(b, h) (((b) * 2 + (h)) * HTB)
#define PG8_SB(b, h) ((4 + (b) * 2 + (h)) * HTB)
#define PG8_STAGE(bufoff, gbase, voff) do { _Pragma("unroll") for (int _i = 0; _i < 2; ++_i) \
        __builtin_amdgcn_global_load_lds((const unsigned*)((const char*)(gbase) + (voff)[_i]), (PG8_LAS unsigned*)(lds + (bufoff) + ldsw + _i * 8192), 16, 0, 0); } while (0)
#define PG8_LDA(dst, b, h) do { _Pragma("unroll") for (int m = 0; m < 4; ++m) _Pragma("unroll") for (int k = 0; k < 2; ++k) dst[m][k] = *(const PG8_LAS bf16x8*)(lds + PG8_SA(b, h) + aoff + m * 2048 + k * 1024); } while (0)
#define PG8_LDB(dst, b, h) do { _Pragma("unroll") for (int n = 0; n < 2; ++n) _Pragma("unroll") for (int k = 0; k < 2; ++k) dst[n][k] = *(const PG8_LAS bf16x8*)(lds + PG8_SB(b, h) + boff + n * 2048 + k * 1024); } while (0)
#define PG8_MMA(ai, bj, At, Bt) do { __builtin_amdgcn_s_setprio(1); _Pragma("unroll") for (int m = 0; m < 4; ++m) _Pragma("unroll") for (int n = 0; n < 2; ++n) _Pragma("unroll") for (int k = 0; k < 2; ++k) \
        acc[ai][bj][m][n] = __builtin_amdgcn_mfma_f32_16x16x32_bf16(Bt[n][k], At[m][k], acc[ai][bj][m][n], 0, 0, 0); __builtin_amdgcn_s_setprio(0); } while (0)
#define PG8_WAIT_V(n) asm volatile("s_waitcnt vmcnt(" #n ")" ::: "memory")
#define PG8_WAIT_L(n) asm volatile("s_waitcnt lgkmcnt(" #n ")" ::: "memory")
#define PG8_BAR __builtin_amdgcn_s_barrier()
#define PG8_SCHED __builtin_amdgcn_sched_barrier(0)
    Unit cur, nxt; int ui = 0;
    if (!S.next(0, cur)) return;
    f32x4 acc[2][2][4][2];
#pragma unroll
    for (int a = 0; a < 2; ++a)
#pragma unroll
        for (int b = 0; b < 2; ++b)
#pragma unroll
            for (int m = 0; m < 4; ++m)
#pragma unroll
                for (int n = 0; n < 2; ++n) acc[a][b][m][n] = (f32x4){0.f, 0.f, 0.f, 0.f};
    bf16x8 At[4][2], B0[2][2], B1[2][2];
    const char* cA = (const char*)g.A + (size_t)cur.pm * tstep; const char* cB = (const char*)g.Bt + (size_t)cur.pn * tstep;
    S.a_ready(cur);
    if constexpr (SP2) {
        PG8_STAGE(PG8_SB(0, 0), cB, voffB); PG8_STAGE(PG8_SB(0, 1), cB + hstep, voffB); PG8_STAGE(PG8_SA(0, 0), cA, voffA); PG8_STAGE(PG8_SA(0, 1), cA + hstep, voffA);
        if (wr == 1) PG8_BAR;
        PG8_WAIT_V(2); PG8_BAR;
        PG8_STAGE(PG8_SB(1, 0), cB + kstep, voffB); PG8_STAGE(PG8_SA(1, 0), cA + kstep, voffA); PG8_STAGE(PG8_SB(1, 1), cB + hstep + kstep, voffB);
        PG8_WAIT_V(6); PG8_BAR;
    } else {
        PG8_STAGE(PG8_SB(0, 0), cB, voffB); PG8_STAGE(PG8_SA(0, 0), cA, voffA); PG8_STAGE(PG8_SB(0, 1), cB + hstep, voffB); PG8_STAGE(PG8_SA(0, 1), cA + hstep, voffA);
        if (wr == 1) PG8_BAR;
        PG8_WAIT_V(4); PG8_BAR;
        PG8_STAGE(PG8_SB(1, 0), cB + kstep, voffB); PG8_STAGE(PG8_SA(1, 0), cA + kstep, voffA); PG8_STAGE(PG8_SB(1, 1), cB + hstep + kstep, voffB);
        PG8_WAIT_V(6); PG8_BAR;
    }
    for (;;) {
        const bool has_next = S.next(ui + 1, nxt);
        const char* nA = has_next ? (const char*)g.A + (size_t)nxt.pm * tstep : cA; const char* nB = has_next ? (const char*)g.Bt + (size_t)nxt.pn * tstep : cB;
        for (int t = 0; t < nt; t += 2) {
            const bool last = (t == nt - 2);
            const char* a1 = cA + (size_t)(t + 1) * kstep;
            const char* a2 = last ? nA : cA + (size_t)(t + 2) * kstep; const char* b2 = last ? nB : cB + (size_t)(t + 2) * kstep;
            const char* a3 = a2 + kstep; const char* b3 = b2 + kstep;
            if (last && has_next) S.a_ready(nxt);
            if constexpr (SP2) {
            PG8_LDB(B0, 0, 0); PG8_LDB(B1, 0, 1); PG8_SCHED; PG8_LDA(At, 0, 0); PG8_STAGE(PG8_SA(1, 1), a1 + hstep, voffA);
            PG8_WAIT_V(8); PG8_WAIT_L(0); PG8_BAR; PG8_MMA(0, 0, At, B0); PG8_MMA(0, 1, At, B1); PG8_BAR; PG8_SCHED;
            PG8_LDA(At, 0, 1); PG8_STAGE(PG8_SB(0, 0), b2, voffB); PG8_STAGE(PG8_SB(0, 1), b2 + hstep, voffB); PG8_STAGE(PG8_SA(0, 0), a2, voffA);
            PG8_WAIT_V(8); PG8_WAIT_L(0); PG8_BAR; PG8_MMA(1, 0, At, B0); PG8_MMA(1, 1, At, B1); PG8_BAR; PG8_SCHED;
            PG8_LDB(B0, 1, 0); PG8_LDB(B1, 1, 1); PG8_SCHED; PG8_LDA(At, 1, 0); PG8_STAGE(PG8_SA(0, 1), a2 + hstep, voffA);
            PG8_WAIT_V(8); PG8_WAIT_L(0); PG8_BAR; PG8_MMA(0, 0, At, B0); PG8_MMA(0, 1, At, B1); PG8_BAR; PG8_SCHED;
            PG8_LDA(At, 1, 1); PG8_STAGE(PG8_SB(1, 0), b3, voffB); PG8_STAGE(PG8_SB(1, 1), b3 + hstep, voffB); PG8_STAGE(PG8_SA(1, 0), a3, voffA);
            PG8_WAIT_V(8); PG8_WAIT_L(0); PG8_BAR; PG8_MMA(1, 0, At, B0); PG8_MMA(1, 1, At, B1); PG8_BAR; PG8_SCHED;
            } else {
            PG8_LDB(B0, 0, 0); PG8_SCHED; PG8_LDA(At, 0, 0); PG8_STAGE(PG8_SA(1, 1), a1 + hstep, voffA);
            PG8_WAIT_L(8); PG8_BAR; PG8_WAIT_L(0); PG8_MMA(0, 0, At, B0); PG8_BAR; PG8_SCHED;
            PG8_LDB(B1, 0, 1); PG8_STAGE(PG8_SB(0, 0), b2, voffB);
            PG8_BAR; PG8_WAIT_L(0); PG8_MMA(0, 1, At, B1); PG8_BAR;
            PG8_LDA(At, 0, 1); PG8_STAGE(PG8_SA(0, 0), a2, voffA);
            PG8_BAR; PG8_WAIT_L(0); PG8_MMA(1, 0, At, B0); PG8_BAR; PG8_SCHED;
            PG8_STAGE(PG8_SB(0, 1), b2 + hstep, voffB);
            PG8_WAIT_V(6); PG8_BAR; PG8_MMA(1, 1, At, B1); PG8_BAR;
            PG8_LDB(B0, 1, 0); PG8_SCHED; PG8_LDA(At, 1, 0); PG8_STAGE(PG8_SA(0, 1), a2 + hstep, voffA);
            PG8_WAIT_L(8); PG8_BAR; PG8_WAIT_L(0); PG8_MMA(0, 0, At, B0); PG8_BAR; PG8_SCHED;
            PG8_LDB(B1, 1, 1); PG8_STAGE(PG8_SB(1, 0), b3, voffB);
            PG8_BAR; PG8_WAIT_L(0); PG8_MMA(0, 1, At, B1); PG8_BAR;
            PG8_LDA(At, 1, 1); PG8_STAGE(PG8_SA(1, 0), a3, voffA);
            PG8_BAR; PG8_WAIT_L(0); PG8_MMA(1, 0, At, B0); PG8_BAR; PG8_SCHED;
            PG8_STAGE(PG8_SB(1, 1), b3 + hstep, voffB);
            PG8_WAIT_V(6); PG8_BAR; PG8_MMA(1, 1, At, B1); PG8_BAR;
            }
        }
        if constexpr (ALIGN_EPI) { if (wr == 0) PG8_BAR; }
        if constexpr (!Epi::AFTER_DRAIN) { E(acc, cur, ui, wr, wc, fr, fq); S.done(cur); }
        if (!has_next) break;
#pragma unroll
        for (int a = 0; a < 2; ++a)
#pragma unroll
            for (int b = 0; b < 2; ++b)
#pragma unroll
                for (int m = 0; m < 4; ++m)
#pragma unroll
                    for (int n = 0; n < 2; ++n) acc[a][b][m][n] = (f32x4){0.f, 0.f, 0.f, 0.f};
        cur = nxt; cA = nA; cB = nB; ++ui;
        if constexpr (ALIGN_EPI) { if (wr == 1) PG8_BAR; }
    }
    PG8_WAIT_V(0);
    if constexpr (!ALIGN_EPI) { if (wr == 0) PG8_BAR; }
    PG8_BAR;
    if constexpr (Epi::AFTER_DRAIN) { E.fused(acc, cur, wr, wc, fr, fq, lds, wid, lane); S.done(cur); }
#undef PG8_SA
#undef PG8_SB
#undef PG8_STAGE
#undef PG8_LDA
#undef PG8_LDB
#undef PG8_MMA
#undef PG8_WAIT_V
#undef PG8_WAIT_L
#undef PG8_BAR
#undef PG8_SCHED
}
}

#define GAS __attribute__((address_space(1)))
#define LAS __attribute__((address_space(3)))
typedef unsigned short bf16;
typedef unsigned v4u __attribute__((ext_vector_type(4)));
typedef float f32x4 __attribute__((ext_vector_type(4)));
typedef float f32x2 __attribute__((ext_vector_type(2)));
typedef float f32x16 __attribute__((ext_vector_type(16)));
typedef short bf16x8 __attribute__((ext_vector_type(8)));
typedef GAS unsigned gu32;
#define RLX_AGENT __ATOMIC_RELAXED, __HIP_MEMORY_SCOPE_AGENT
#define LDS_WAIT() asm volatile("s_waitcnt lgkmcnt(0)" ::: "memory")
#define VM_WAIT() asm volatile("s_waitcnt vmcnt(0)" ::: "memory")
__device__ __forceinline__ unsigned f2bf(float f) { unsigned u = __builtin_bit_cast(unsigned, f); return (u + 0x7fffu + ((u >> 16) & 1u)) >> 16; }
__device__ __forceinline__ unsigned pk2(float lo, float hi) { return f2bf(lo) | (f2bf(hi) << 16); }
__device__ __forceinline__ float bf2f(unsigned short b) { return __builtin_bit_cast(float, (unsigned)b << 16); }
__device__ __forceinline__ float bflo(unsigned w) { return __builtin_bit_cast(float, w << 16); }
__device__ __forceinline__ float bfhi(unsigned w) { return __builtin_bit_cast(float, w & 0xffff0000u); }
__device__ __forceinline__ float wave_sum(float v) {
#pragma unroll
    for (int o = 1; o < 64; o <<= 1) v += __shfl_xor(v, o);
    return v;
}
__device__ __forceinline__ float wave_max(float v) {
#pragma unroll
    for (int o = 1; o < 64; o <<= 1) v = fmaxf(v, __shfl_xor(v, o));
    return v;
}

#define XB_TMO      128
#define XB_XCNT(j)  (256  + 64 * (j))
#define XB_XSUB(j)  (1280 + 64 * (j))
#define XB_XGEN(j)  (2304 + 64 * (j))
#define XB_TOP      3328
#define XB_TOPGEN   3392
#define XCD_BAR_WORDS 3456
#define XB_SPIN_CAP (1u << 18)

__device__ __forceinline__ unsigned xb_ld(unsigned* p)              { return __hip_atomic_load(p, __ATOMIC_RELAXED, __HIP_MEMORY_SCOPE_AGENT); }
__device__ __forceinline__ unsigned xb_add(unsigned* p, unsigned v) { return __hip_atomic_fetch_add(p, v, __ATOMIC_RELAXED, __HIP_MEMORY_SCOPE_AGENT); }
__device__ __forceinline__ unsigned xb_xcc_id() { return (unsigned)__builtin_amdgcn_s_getreg((3 << 11) | 20) & 0xFu; }
#define XB_SPIN(cond, bar) do { unsigned _sp = 0; while (cond) { __builtin_amdgcn_s_sleep(1); \
    if ((++_sp & 255u) == 0u) { if (xb_ld(&(bar)[XB_TMO])) break; if (_sp > XB_SPIN_CAP) { atomicAdd(&(bar)[XB_TMO], 1u); break; } } } } while (0)

struct XcdBarrier {
    unsigned* bar; unsigned x;
    volatile LAS unsigned* st;
};

__device__ __forceinline__ XcdBarrier xcd_barrier_post(unsigned* bar, volatile LAS unsigned* st) {
    XcdBarrier b; b.bar = bar; b.x = xb_xcc_id(); b.st = st;
    if (threadIdx.x == 0) (void)xb_add(&bar[XB_XCNT(b.x)], 1u);
    return b;
}
__device__ __forceinline__ void xcd_barrier_complete(unsigned* bar, unsigned x, unsigned& nloc, unsigned& nx) {
    const unsigned G = gridDim.x * gridDim.y * gridDim.z;
    unsigned sum, cnt, mine, sp = 0u;
    for (;;) {
        sum = 0u; cnt = 0u; mine = 0u;
#pragma unroll
        for (unsigned j = 0; j < 16; ++j) { const unsigned c = xb_ld(&bar[XB_XCNT(j)]); sum += c; cnt += (c > 0u) ? 1u : 0u; mine = (j == x) ? c : mine; }
        if (sum == G) break;
        __builtin_amdgcn_s_sleep(1);
        if ((++sp & 255u) == 0u) { if (xb_ld(&bar[XB_TMO])) break; if (sp > XB_SPIN_CAP) { atomicAdd(&bar[XB_TMO], 1u); break; } }
    }
    nloc = mine > 0u ? mine : 1u; nx = cnt > 0u ? cnt : 1u;
}

__device__ __forceinline__ void xcd_barrier(const XcdBarrier& b) {
    asm volatile("s_waitcnt vmcnt(0)" ::: "memory");
    __syncthreads();
    if (threadIdx.x == 0) {
        unsigned* bar = b.bar;
        __builtin_amdgcn_s_waitcnt(0);
        unsigned nloc = b.st[0], nx = b.st[1];
        if (nloc == 0u) { xcd_barrier_complete(bar, b.x, nloc, nx); b.st[0] = nloc; b.st[1] = nx; }
        const unsigned old = xb_add(&bar[XB_XSUB(b.x)], 1u);
        const unsigned gen = old / nloc;
        if (old + 1u == (gen + 1u) * nloc) {
            __builtin_amdgcn_fence(__ATOMIC_RELEASE, "agent");
            asm volatile("s_waitcnt vmcnt(0)" ::: "memory");
            const unsigned og = xb_add(&bar[XB_TOP], 1u);
            const unsigned tg = og / nx;
            if (og + 1u == (tg + 1u) * nx) xb_add(&bar[XB_TOPGEN], 1u);
            else XB_SPIN(xb_ld(&bar[XB_TOPGEN]) == tg, bar);
            __builtin_amdgcn_fence(__ATOMIC_ACQUIRE, "agent");
            xb_add(&bar[XB_XGEN(b.x)], 1u);
            asm volatile("s_waitcnt vmcnt(0)" ::: "memory");
        } else {
            XB_SPIN(xb_ld(&bar[XB_XGEN(b.x)]) == gen, bar);
            __builtin_amdgcn_fence(__ATOMIC_ACQUIRE, "agent");
            asm volatile("s_waitcnt vmcnt(0)" ::: "memory");
        }
    }
    __syncthreads();
}

constexpr int NWAVES = 8;
constexpr int RING_BYTES = 131072;
constexpr int RS_OFF = RING_BYTES;
constexpr int MISC_OFF = RS_OFF + 4096;
constexpr int LDS_BYTES = 147456;
constexpr int CW_BAR = 4096;

struct Args { const float* in[15]; float* out; unsigned char* ws; unsigned mask; int li; };

__device__ __forceinline__ void p0_transpose_item(const float* W, const float* gain, int K, int N, bf16* WT, LAS float* scr, int item, int lane) {
    const int nblk = N / 32, kb = item / nblk, nb = item % nblk, k0 = 64 * kb, n0 = 32 * nb;
#pragma unroll 8
    for (int i = 0; i < 32; ++i) { const int kk = 2 * i + (lane >> 5); float w = W[(size_t)(k0 + kk) * N + n0 + (lane & 31)]; if (gain) w *= gain[k0 + kk]; scr[kk * 33 + (lane & 31)] = w; }
    LDS_WAIT(); asm volatile("" ::: "memory");
    const int c = lane & 7;
#pragma unroll
    for (int j = 0; j < 4; ++j) { const int n = (lane >> 3) + 8 * j; const LAS float* s = scr + (8 * c) * 33 + n;
        v4u o; o.x = pk2(s[0 * 33], s[1 * 33]); o.y = pk2(s[2 * 33], s[3 * 33]); o.z = pk2(s[4 * 33], s[5 * 33]); o.w = pk2(s[6 * 33], s[7 * 33]);
        *(v4u*)(WT + (size_t)(n0 + n) * K + k0 + 8 * c) = o; }
    LDS_WAIT(); asm volatile("" ::: "memory");
}
__device__ __forceinline__ void conv_row_fp8(const float* src, const float* gain, unsigned char* dst, float* inv_scale, int lane) {
    f32x4 v[4]; float am = 0.f;
#pragma unroll
    for (int j = 0; j < 4; ++j) { v[j] = *(const f32x4*)(src + lane * 16 + 4 * j); if (gain) v[j] = v[j] * *(const f32x4*)(gain + lane * 16 + 4 * j);
        am = fmaxf(am, fmaxf(fmaxf(fabsf(v[j][0]), fabsf(v[j][1])), fmaxf(fabsf(v[j][2]), fabsf(v[j][3])))); }
    am = wave_max(am);
    const float sc = am > 0.f ? 224.f / am : 1.f;
    v4u o;
#pragma unroll
    for (int j = 0; j < 4; ++j) { int w = __builtin_amdgcn_cvt_pk_fp8_f32(v[j][0] * sc, v[j][1] * sc, 0, false); w = __builtin_amdgcn_cvt_pk_fp8_f32(v[j][2] * sc, v[j][3] * sc, w, true); o[j] = (unsigned)w; }
    *(v4u*)(dst + lane * 16) = o;
    if (lane == 0) *inv_scale = am > 0.f ? am * (1.f / 224.f) : 1.f;
}
__device__ __forceinline__ void phase_prep(const Args& a, LAS unsigned char* lds, int gw, int NGW, int wave, int lane) {
    LAS float* scr = (LAS float*)(lds + wave * 16384);
    unsigned char* ws = a.ws;
    constexpr int I0 = 16 * (3072 / 32), I1 = 16 * (1024 / 32), I2 = 16 * (1536 / 32), I3 = I1, I4 = 16 * (2048 / 32), I5 = I4;
    constexpr int NIT = I0 + I1 + I2 + I3 + I4 + I5;
    for (int it = gw; it < NIT; it += NGW) {
        int r = it;
        if (r < I0) { p0_transpose_item(a.in[2], a.in[1], 1024, 3072, (bf16*)(ws + WS_WQKV0), scr, r, lane); continue; } r -= I0;
        if (r < I1) { p0_transpose_item(a.in[3], nullptr, 1024, 1024, (bf16*)(ws + WS_WO0), scr, r, lane); continue; } r -= I1;
        if (r < I2) { p0_transpose_item(a.in[5], a.in[4], 1024, 1536, (bf16*)(ws + WS_WQKV1), scr, r, lane); continue; } r -= I2;
        if (r < I3) { p0_transpose_item(a.in[9], nullptr, 1024, 1024, (bf16*)(ws + WS_WO1), scr, r, lane); continue; } r -= I3;
        if (r < I4) { p0_transpose_item(a.in[11], a.in[10], 1024, 2048, (bf16*)(ws + WS_WPQ0), scr, r, lane); continue; } r -= I4;
        p0_transpose_item(a.in[11] + (size_t)1024 * 2048, a.in[10] + 1024, 1024, 2048, (bf16*)(ws + WS_WPQ1), scr, r, lane);
    }
    for (int it = gw; it < 1024; it += NGW) {
        const float* s = a.in[12] + (size_t)it * 512 + lane * 8; const f32x4 a0 = *(const f32x4*)s, a1 = *(const f32x4*)(s + 4);
        v4u o; o.x = pk2(a0[0], a0[1]); o.y = pk2(a0[2], a0[3]); o.z = pk2(a1[0], a1[1]); o.w = pk2(a1[2], a1[3]);
        *(v4u*)((bf16*)(ws + WS_SUBK) + (size_t)it * 512 + lane * 8) = o;
    }
    for (int r = gw; r < 65536; r += NGW) {
        const int tb = r >> 15, row = r & 32767;
        const float* src = (tb ? a.in[14] : a.in[13]) + (size_t)row * 1024;
        const float* gain = tb ? nullptr : a.in[10] + (row >> 14) * 1024;
        conv_row_fp8(src, gain, ws + (tb ? WS_V8 : WS_U8) + (size_t)row * 1024, (float*)(ws + (tb ? WS_ISV : WS_ISU)) + row, lane);
    }
    for (int t = gw; t < T; t += NGW) {
        const float* xr = a.in[0] + (size_t)t * 1024 + lane * 16; f32x4 v[4]; float ss = 0.f;
#pragma unroll
        for (int j = 0; j < 4; ++j) { v[j] = *(const f32x4*)(xr + 4 * j); ss += (v[j][0] * v[j][0] + v[j][1] * v[j][1]) + (v[j][2] * v[j][2] + v[j][3] * v[j][3]); }
        ss = wave_sum(ss);
        v4u o0, o1; o0.x = pk2(v[0][0], v[0][1]); o0.y = pk2(v[0][2], v[0][3]); o0.z = pk2(v[1][0], v[1][1]); o0.w = pk2(v[1][2], v[1][3]);
        o1.x = pk2(v[2][0], v[2][1]); o1.y = pk2(v[2][2], v[2][3]); o1.z = pk2(v[3][0], v[3][1]); o1.w = pk2(v[3][2], v[3][3]);
        bf16* hb = (bf16*)(ws + WS_HB) + (size_t)t * 1024 + lane * 16;
        *(v4u*)hb = o0; *(v4u*)(hb + 8) = o1;
        if (lane == 0) ((float*)(ws + WS_SSP))[t] = ss;
    }
}
template <class Sched> __device__ __forceinline__ void fill_rs(LAS float* rs, const Sched& So, const float* ssp, int np, int tid) {
    pg8::Unit u;
    for (int ui = 0; ui < 4 && So.next(ui, u); ++ui) {
        if (tid < 256) { const int row = u.pm * 256 + tid; float s = 0.f; for (int p = 0; p < np; ++p) s += ssp[(size_t)p * T + row]; rs[ui * 256 + tid] = rsqrtf(s * (1.f / 1024.f) + 1e-6f); }
    }
    __syncthreads();
}

namespace nv {
__device__ __forceinline__ float softplus(float z) { return fmaxf(z, 0.f) + log1pf(expf(-fabsf(z))); }
__device__ __forceinline__ float gelu_tanh(float x) { const float k = 0.7978845608028654f; return 0.5f * x * (1.f + tanhf(k * (x + 0.044715f * x * x * x))); }

__global__ void __launch_bounds__(256) k_sb_attn_b(const bf16* __restrict__ Q, const bf16* __restrict__ K, const bf16* __restrict__ V, bf16* __restrict__ O) {
    __shared__ float Ks[64][65];
    __shared__ float Vs[64][65];
    __shared__ float qs[4][64];
    const int tid = threadIdx.x, w = tid >> 6, lane = tid & 63;
    const int nblk = S / 4;
    const int bh = blockIdx.x / nblk, t0 = (blockIdx.x % nblk) * 4;
    const int b = bh / 16, h = bh % 16;
    const int t = t0 + w;
    const size_t rowb = (size_t)b * S;
    qs[w][lane] = bf2f(Q[(rowb + t) * 1024 + h * 64 + lane]);
    float acc = 0.f, carry = 0.f;
    const int ntile = (t0 + 3) / 64 + 1;
    for (int tile = ntile - 1; tile >= 0; --tile) {
        const int s0 = tile * 64;
        __syncthreads();
#pragma unroll
        for (int i = 0; i < 16; ++i) {
            const int idx = tid + 256 * i, r = idx >> 6, d = idx & 63;
            const size_t g = (rowb + s0 + r) * 1024 + h * 64 + d;
            Ks[r][d] = bf2f(K[g]); Vs[r][d] = bf2f(V[g]);
        }
        __syncthreads();
        float z = 0.f;
#pragma unroll 16
        for (int d = 0; d < 64; ++d) z = fmaf(qs[w][d], Ks[lane][d], z);
        z *= 0.6931471805599453f;
        const int s = s0 + lane;
        const bool valid = s < t;
        const float sp = softplus(z);
        const float L = valid ? -sp : 0.f;
        float x = L;
#pragma unroll
        for (int off = 1; off < 64; off <<= 1) { const float y = __shfl_down(x, off); if (lane + off < 64) x += y; }
        const float excl = x - L;
        const float total = __shfl(x, 0);
        const float log_a = (z - sp) + carry + excl;
        const float a = valid ? expf(log_a) : 0.f;
        carry += total;
#pragma unroll 16
        for (int j = 0; j < 64; ++j) acc = fmaf(__shfl(a, j), Vs[j][lane], acc);
    }
    O[(rowb + t) * 1024 + h * 64 + lane] = (bf16)f2bf(acc);
}

__global__ void __launch_bounds__(256) k_sw_attn_b(const bf16* __restrict__ qkv, const float* __restrict__ qg, const float* __restrict__ kg,
                                                   const float* __restrict__ sinks, bf16* __restrict__ O) {
    __shared__ float sc[4][128];
    const int tid = threadIdx.x, w = tid >> 6, lane = tid & 63;
    const int gw = blockIdx.x * 4 + w;
    const int h = gw & 15, bt = gw >> 4, t = bt % S, b = bt / S;
    const int kvh = h >> 2;
    const size_t rowb = (size_t)b * S;
    float q = bf2f(qkv[(rowb + t) * 1536 + h * 64 + lane]);
    { const float ss = wave_sum(q * q); q = q * rsqrtf(ss * (1.f / 64.f) + 1e-6f) * qg[lane]; }
    const float kgl = kg[lane];
    const float slope = exp2f(-8.f * (float)(h + 1) / 16.f);
    const int slo = (t - 127) > 0 ? (t - 127) : 0;
    const int nk = t - slo + 1;
    for (int i = 0; i < nk; ++i) {
        const int s = slo + i;
        float kd = bf2f(qkv[(rowb + s) * 1536 + 1024 + kvh * 64 + lane]);
        const float ss = wave_sum(kd * kd);
        kd = kd * rsqrtf(ss * (1.f / 64.f) + 1e-6f) * kgl;
        const float dot = wave_sum(q * kd);
        if (lane == 0) sc[w][i] = dot * 0.125f - slope * (float)(t - s);
    }
    __syncthreads();
    const float sink = sinks[h];
    float m = sink;
    for (int i = lane; i < nk; i += 64) m = fmaxf(m, sc[w][i]);
    m = wave_max(m);
    float den = 0.f;
    for (int i = lane; i < nk; i += 64) { const float p = expf(sc[w][i] - m); sc[w][i] = p; den += p; }
    den = wave_sum(den) + expf(sink - m);
    __syncthreads();
    const float inv = 1.f / den;
    float acc = 0.f;
    for (int i = 0; i < nk; ++i) acc = fmaf(sc[w][i] * inv, bf2f(qkv[(rowb + slo + i) * 1536 + 1280 + kvh * 64 + lane]), acc);
    O[(rowb + t) * 1024 + h * 64 + lane] = (bf16)f2bf(acc);
}

__global__ void __launch_bounds__(256) k_peer_topk_b(const bf16* __restrict__ qp, const bf16* __restrict__ subk, int* __restrict__ eid, float* __restrict__ gate) {
    __shared__ float qs[4][256];
    const int tid = threadIdx.x, w = tid >> 6, lane = tid & 63;
    const int gw = blockIdx.x * 4 + w;
    const int h = gw & 7, t = gw >> 3;
#pragma unroll
    for (int i = 0; i < 4; ++i) qs[w][lane + 64 * i] = bf2f(qp[(size_t)t * 2048 + h * 256 + lane + 64 * i]);
    __syncthreads();
    float ts[2]; int tii[2];
#pragma unroll
    for (int p = 0; p < 2; ++p) {
        const bf16* k0 = subk + ((size_t)(h * 2 + p) * 128 + lane) * 128;
        const bf16* k1 = k0 + 64 * 128;
        float v0 = 0.f, v1 = 0.f;
        for (int c = 0; c < 128; ++c) { const float qq = qs[w][p * 128 + c]; v0 = fmaf(qq, bf2f(k0[c]), v0); v1 = fmaf(qq, bf2f(k1[c]), v1); }
        float mys = 0.f; int myi = 0;
        for (int r = 0; r < 16; ++r) {
            float bv; int bi;
            if (v0 >= v1) { bv = v0; bi = lane; } else { bv = v1; bi = lane + 64; }
#pragma unroll
            for (int off = 1; off < 64; off <<= 1) {
                const float ov = __shfl_xor(bv, off); const int oi = __shfl_xor(bi, off);
                if (ov > bv || (ov == bv && oi < bi)) { bv = ov; bi = oi; }
            }
            if (lane == r) { mys = bv; myi = bi; }
            if (bi == lane) v0 = -INFINITY;
            if (bi == lane + 64) v1 = -INFINITY;
        }
        ts[p] = mys; tii[p] = myi;
    }
    float cv[4];
    {
        const float s0 = __shfl(ts[0], lane >> 2);
#pragma unroll
        for (int c = 0; c < 4; ++c) cv[c] = s0 + __shfl(ts[1], (lane & 3) * 4 + c);
    }
    float cs = 0.f; int cf = 0;
    for (int r = 0; r < 16; ++r) {
        float bv = cv[0]; int bi = lane * 4;
#pragma unroll
        for (int c = 1; c < 4; ++c) if (cv[c] > bv) { bv = cv[c]; bi = lane * 4 + c; }
#pragma unroll
        for (int off = 1; off < 64; off <<= 1) {
            const float ov = __shfl_xor(bv, off); const int oi = __shfl_xor(bi, off);
            if (ov > bv || (ov == bv && oi < bi)) { bv = ov; bi = oi; }
        }
        if (lane == r) { cs = bv; cf = bi; }
#pragma unroll
        for (int c = 0; c < 4; ++c) if (bi == lane * 4 + c) cv[c] = -INFINITY;
    }
    const float mval = wave_max(lane < 16 ? cs : -INFINITY);
    const float ex = lane < 16 ? expf(cs - mval) : 0.f;
    const float den = wave_sum(ex);
    const int i1 = __shfl(tii[0], (cf >> 4) & 15), i2 = __shfl(tii[1], cf & 15);
    if (lane < 16) {
        eid[(size_t)t * 128 + h * 16 + lane] = i1 * 128 + i2;
        gate[(size_t)t * 128 + h * 16 + lane] = ex / den;
    }
}

__global__ void __launch_bounds__(256) k_peer_gather_b(float* h, const float* __restrict__ ssp_in, int np, const unsigned char* __restrict__ U8, const unsigned char* __restrict__ V8,
                                                       const float* __restrict__ isu, const float* __restrict__ isv, const int* __restrict__ eid, const float* __restrict__ gate,
                                                       bf16* __restrict__ hb, float* __restrict__ ssp_out) {
    const int t = blockIdx.x * 4 + (threadIdx.x >> 6), lane = threadIdx.x & 63;
    float x[16], acc[16];
#pragma unroll
    for (int j = 0; j < 4; ++j) { const f32x4 v = *(const f32x4*)(h + (size_t)t * 1024 + lane * 16 + 4 * j); x[4 * j] = v[0]; x[4 * j + 1] = v[1]; x[4 * j + 2] = v[2]; x[4 * j + 3] = v[3]; }
#pragma unroll
    for (int j = 0; j < 16; ++j) acc[j] = 0.f;
    float ssum = 0.f; for (int p = 0; p < np; ++p) ssum += ssp_in[(size_t)p * T + t];
    const float rstd = rsqrtf(ssum * (1.f / 1024.f) + 1e-6f);
    for (int k = 0; k < 128; ++k) {
        const int e = eid[(size_t)t * 128 + k];
        const float g = gate[(size_t)t * 128 + k];
        const v4u uw = *(const v4u*)(U8 + (size_t)e * 1024 + lane * 16);
        float s = 0.f;
#pragma unroll
        for (int j = 0; j < 4; ++j) { const f32x2 a = __builtin_amdgcn_cvt_pk_f32_fp8((int)uw[j], false), c = __builtin_amdgcn_cvt_pk_f32_fp8((int)uw[j], true);
            s += a[0] * x[4 * j] + a[1] * x[4 * j + 1] + c[0] * x[4 * j + 2] + c[1] * x[4 * j + 3]; }
        s = wave_sum(s);
        const float coef = g * gelu_tanh(s * rstd * isu[e]) * isv[e];
        const v4u vw = *(const v4u*)(V8 + (size_t)e * 1024 + lane * 16);
#pragma unroll
        for (int j = 0; j < 4; ++j) { const f32x2 a = __builtin_amdgcn_cvt_pk_f32_fp8((int)vw[j], false), c = __builtin_amdgcn_cvt_pk_f32_fp8((int)vw[j], true);
            acc[4 * j] = fmaf(coef, a[0], acc[4 * j]); acc[4 * j + 1] = fmaf(coef, a[1], acc[4 * j + 1]); acc[4 * j + 2] = fmaf(coef, c[0], acc[4 * j + 2]); acc[4 * j + 3] = fmaf(coef, c[1], acc[4 * j + 3]); }
    }
    float ss = 0.f;
#pragma unroll
    for (int j = 0; j < 16; ++j) { acc[j] += x[j]; ss += acc[j] * acc[j]; }
    ss = wave_sum(ss);
#pragma unroll
    for (int j = 0; j < 4; ++j) { f32x4 o = {acc[4 * j], acc[4 * j + 1], acc[4 * j + 2], acc[4 * j + 3]}; *(f32x4*)(h + (size_t)t * 1024 + lane * 16 + 4 * j) = o; }
    v4u o0, o1; o0.x = pk2(acc[0], acc[1]); o0.y = pk2(acc[2], acc[3]); o0.z = pk2(acc[4], acc[5]); o0.w = pk2(acc[6], acc[7]);
    o1.x = pk2(acc[8], acc[9]); o1.y = pk2(acc[10], acc[11]); o1.z = pk2(acc[12], acc[13]); o1.w = pk2(acc[14], acc[15]);
    *(v4u*)(hb + (size_t)t * 1024 + lane * 16) = o0; *(v4u*)(hb + (size_t)t * 1024 + lane * 16 + 8) = o1;
    if (lane == 0) ssp_out[t] = ss;
}
}

typedef short v4i16_t __attribute__((ext_vector_type(4)));
__device__ __forceinline__ int crow(int r, int hi) { return (r & 3) + 8 * (r >> 2) + 4 * hi; }
__device__ __forceinline__ unsigned cvtpk(float lo, float hi) { typedef __bf16 bf16x2_t __attribute__((ext_vector_type(2))); f32x2 v = {lo, hi}; bf16x2_t b = __builtin_convertvector(v, bf16x2_t); return __builtin_bit_cast(unsigned, b); }
__device__ __forceinline__ bf16x8 mk8(unsigned a, unsigned b, unsigned c, unsigned d) { v4u w = {a, b, c, d}; return __builtin_bit_cast(bf16x8, w); }
__device__ __forceinline__ bf16x8 vfrag(LAS const unsigned char* p) {
    const v4i16_t lo = __builtin_amdgcn_ds_read_tr16_b64_v4i16((LAS v4i16_t*)p), hi = __builtin_amdgcn_ds_read_tr16_b64_v4i16((LAS v4i16_t*)(p + 512));
    return (bf16x8){lo[0], lo[1], lo[2], lo[3], hi[0], hi[1], hi[2], hi[3]};
}
__device__ __forceinline__ void vtile_load(v4u (&vv)[8], const bf16* vp0, int pitch, int lane) {
    const bf16* vp = vp0 + (size_t)(lane >> 3) * pitch + (lane & 7) * 8;
#pragma unroll
    for (int i = 0; i < 8; ++i) vv[i] = *(const v4u*)(vp + (size_t)i * 8 * pitch);
}
__device__ __forceinline__ void vtile_store(const v4u (&vv)[8], LAS unsigned char* wl, int lane) {
    const int c = lane & 7;
#pragma unroll
    for (int i = 0; i < 8; ++i) { const int kv = 8 * i + (lane >> 3); *(LAS v4u*)(wl + (c >> 2) * 4096 + (kv >> 4) * 1024 + (kv & 15) * 64 + (c & 3) * 16) = vv[i]; }
}
__device__ __forceinline__ void otile_store(const f32x16& o0, const f32x16& o1, LAS unsigned char* stg, bf16* Orow0, int pitch, int lane) {
    const int r32 = lane & 31, hi = lane >> 5;
    LAS unsigned short* s16 = (LAS unsigned short*)stg;
#pragma unroll
    for (int r = 0; r < 16; ++r) { const int orow = crow(r, hi); s16[orow * 64 + r32] = (unsigned short)f2bf(o0[r]); s16[orow * 64 + 32 + r32] = (unsigned short)f2bf(o1[r]); }
#pragma unroll
    for (int i = 0; i < 4; ++i) { const int row = i * 8 + (lane >> 3), ch = lane & 7; const v4u v = *(LAS const v4u*)(stg + row * 128 + ch * 16); *(v4u*)(Orow0 + (size_t)row * pitch + ch * 8) = v; }
}
#define MFMA32(A, B, C) __builtin_amdgcn_mfma_f32_32x32x16_bf16((A), (B), (C), 0, 0, 0)

__device__ __forceinline__ void sb_unit(const bf16* Q, const bf16* K, const bf16* V, bf16* O, int b, int h, int t0, LAS unsigned char* wl, int lane,
                                        const bf16x8 tri0, const bf16x8 tri1, const bf16x8 ones) {
    const int r32 = lane & 31, hi = lane >> 5;
    const size_t rowb = (size_t)b * S;
    const bf16* qp = Q + (rowb + t0 + r32) * 1024 + h * 64 + hi * 8;
    bf16x8 qf[4];
#pragma unroll
    for (int d0 = 0; d0 < 4; ++d0) qf[d0] = *(const bf16x8*)(qp + d0 * 16);
    f32x16 o0 = {}, o1 = {};
    float carry = 0.f;
    const int tdiag = t0 >> 6;
    LAS const unsigned char* vb = wl + ((lane >> 4) & 1) * 32 + (lane & 3) * 8 + (4 * hi + ((lane & 15) >> 2)) * 64;
    for (int tile = tdiag; tile >= 0; --tile) {
        const int s0 = tile * 64;
        const bf16* kp = K + (rowb + s0 + r32) * 1024 + h * 64 + hi * 8;
        bf16x8 kf[8];
#pragma unroll
        for (int d0 = 0; d0 < 4; ++d0) { kf[2 * d0] = *(const bf16x8*)(kp + d0 * 16); kf[2 * d0 + 1] = *(const bf16x8*)(kp + 32 * 1024 + d0 * 16); }
        v4u vv[8];
        vtile_load(vv, V + (rowb + s0) * 1024 + h * 64, 1024, lane);
        f32x16 p0 = {}, p1 = {};
#pragma unroll
        for (int d0 = 0; d0 < 4; ++d0) { p0 = MFMA32(kf[2 * d0], qf[d0], p0); p1 = MFMA32(kf[2 * d0 + 1], qf[d0], p1); }
        vtile_store(vv, wl, lane);
        const int lim = t0 + r32 - s0;
        unsigned lw[16]; float sumL = 0.f;
#pragma unroll
        for (int r = 0; r < 16; r += 2) {
            float La[2], Lb[2];
#pragma unroll
            for (int q = 0; q < 2; ++q) {
                { const float zc = fminf(p0[r + q], 126.f); const float sp = __builtin_amdgcn_logf(1.f + __builtin_amdgcn_exp2f(zc)); const bool ok = crow(r + q, hi) < lim;
                  La[q] = ok ? -sp : 0.f; p0[r + q] = ok ? zc - sp : -INFINITY; }
                { const float zc = fminf(p1[r + q], 126.f); const float sp = __builtin_amdgcn_logf(1.f + __builtin_amdgcn_exp2f(zc)); const bool ok = crow(r + q, hi) + 32 < lim;
                  Lb[q] = ok ? -sp : 0.f; p1[r + q] = ok ? zc - sp : -INFINITY; }
            }
            sumL += (La[0] + La[1]) + (Lb[0] + Lb[1]);
            lw[r >> 1] = cvtpk(La[0], La[1]); lw[8 + (r >> 1)] = cvtpk(Lb[0], Lb[1]);
        }
        f32x16 cinit;
#pragma unroll
        for (int r = 0; r < 16; ++r) cinit[r] = carry;
        const bf16x8 x00 = mk8(lw[0], lw[1], lw[2], lw[3]), x01 = mk8(lw[4], lw[5], lw[6], lw[7]), x10 = mk8(lw[8], lw[9], lw[10], lw[11]), x11 = mk8(lw[12], lw[13], lw[14], lw[15]);
        f32x16 y0 = MFMA32(tri0, x00, cinit); y0 = MFMA32(tri1, x01, y0); y0 = MFMA32(ones, x10, y0); y0 = MFMA32(ones, x11, y0);
        f32x16 y1 = MFMA32(tri0, x10, cinit); y1 = MFMA32(tri1, x11, y1);
        unsigned aw[16];
#pragma unroll
        for (int r = 0; r < 16; r += 2) {
            const float a0 = __builtin_amdgcn_exp2f(p0[r] + y0[r]), a1 = __builtin_amdgcn_exp2f(p0[r + 1] + y0[r + 1]);
            const float c0 = __builtin_amdgcn_exp2f(p1[r] + y1[r]), c1 = __builtin_amdgcn_exp2f(p1[r + 1] + y1[r + 1]);
            aw[r >> 1] = cvtpk(a0, a1); aw[8 + (r >> 1)] = cvtpk(c0, c1);
        }
#pragma unroll
        for (int ks = 0; ks < 4; ++ks) {
            const bf16x8 pa = mk8(aw[4 * ks], aw[4 * ks + 1], aw[4 * ks + 2], aw[4 * ks + 3]);
            o0 = MFMA32(pa, vfrag(vb + ks * 1024), o0);
            o1 = MFMA32(pa, vfrag(vb + 4096 + ks * 1024), o1);
        }
        { const auto rr = __builtin_amdgcn_permlane32_swap(__float_as_uint(sumL), __float_as_uint(sumL), false, false); carry += __uint_as_float(rr[0]) + __uint_as_float(rr[1]); }
        if (__all(carry < -160.f)) break;
    }
    otile_store(o0, o1, wl + 8192, O + (rowb + t0) * 1024 + h * 64, 1024, lane);
}
__device__ __forceinline__ void phase_sbatt(const bf16* Q, const bf16* K, const bf16* V, bf16* O, LAS unsigned char* lds, int vcu, int G, int wave, int lane) {
    const int r32 = lane & 31, hi = lane >> 5;
    unsigned t0w[4], t1w[4];
#pragma unroll
    for (int j = 0; j < 8; ++j) {
        const int kv0 = 8 * (j >> 2) + 4 * hi + (j & 3);
        const unsigned b0 = (kv0 > r32) ? 0x3F80u : 0u, b1 = (kv0 + 16 > r32) ? 0x3F80u : 0u;
        if (j & 1) { t0w[j >> 1] |= b0 << 16; t1w[j >> 1] |= b1 << 16; } else { t0w[j >> 1] = b0; t1w[j >> 1] = b1; }
    }
    const bf16x8 tri0 = mk8(t0w[0], t0w[1], t0w[2], t0w[3]), tri1 = mk8(t1w[0], t1w[1], t1w[2], t1w[3]), ones = mk8(0x3F803F80u, 0x3F803F80u, 0x3F803F80u, 0x3F803F80u);
    LAS unsigned char* wl = lds + wave * 12288;
    const int nunits = NB * 16 * (S / 32);
    for (int it = 0; ; ++it) {
        const int u = (it * G + vcu) * NWAVES + wave;
        if (u >= nunits) break;
        const int bh = u >> 7, qb = u & 127;
        sb_unit(Q, K, V, O, bh >> 4, bh & 15, qb * 32, wl, lane, tri0, tri1, ones);
    }
}

__device__ __forceinline__ void sw_unit(const bf16* QKV, const float* qg, const float* kg, float sink2, float slope2, bf16* O, int b, int h, int t0, LAS unsigned char* wl, int lane) {
    const int r32 = lane & 31, hi = lane >> 5, kvh = h >> 2;
    const size_t rowb = (size_t)b * S;
    LAS float* wsf = (LAS float*)(wl + 12288);
    bf16x8 qf[4];
    {
        const bf16* qp = QKV + (rowb + t0 + r32) * 1536 + h * 64 + hi * 8;
        v4u raw[4]; float ss = 0.f;
#pragma unroll
        for (int d0 = 0; d0 < 4; ++d0) { raw[d0] = *(const v4u*)(qp + d0 * 16);
#pragma unroll
            for (int w = 0; w < 4; ++w) { const float a = bflo(raw[d0][w]), c = bfhi(raw[d0][w]); ss += a * a + c * c; } }
        { const auto rr = __builtin_amdgcn_permlane32_swap(__float_as_uint(ss), __float_as_uint(ss), false, false); ss = __uint_as_float(rr[0]) + __uint_as_float(rr[1]); }
        const float rq = rsqrtf(ss * (1.f / 64.f) + 1e-6f) * C2;
#pragma unroll
        for (int d0 = 0; d0 < 4; ++d0) { const f32x4 g0 = *(const f32x4*)(qg + d0 * 16 + hi * 8), g1 = *(const f32x4*)(qg + d0 * 16 + hi * 8 + 4);
            qf[d0] = mk8(cvtpk(bflo(raw[d0][0]) * rq * g0[0], bfhi(raw[d0][0]) * rq * g0[1]), cvtpk(bflo(raw[d0][1]) * rq * g0[2], bfhi(raw[d0][1]) * rq * g0[3]),
                         cvtpk(bflo(raw[d0][2]) * rq * g1[0], bfhi(raw[d0][2]) * rq * g1[1]), cvtpk(bflo(raw[d0][3]) * rq * g1[2], bfhi(raw[d0][3]) * rq * g1[3])); }
    }
    float m = sink2, l = 1.f;
    f32x16 o0 = {}, o1 = {};
    LAS const unsigned char* vb = wl + ((lane >> 4) & 1) * 32 + (lane & 3) * 8 + (4 * hi + ((lane & 15) >> 2)) * 64;
    const int thi = t0 >> 6, tlo = (t0 >= 127) ? ((t0 - 127) >> 6) : 0;
    for (int tile = thi; tile >= tlo; --tile) {
        const int s0 = tile * 64;
        bf16x8 kf[8];
#pragma unroll
        for (int half = 0; half < 2; ++half) {
            const bf16* kp = QKV + (rowb + s0 + 32 * half + r32) * 1536 + 1024 + kvh * 64 + hi * 8;
            v4u raw[4]; float ss = 0.f;
#pragma unroll
            for (int d0 = 0; d0 < 4; ++d0) { raw[d0] = *(const v4u*)(kp + d0 * 16);
#pragma unroll
                for (int w = 0; w < 4; ++w) { const float a = bflo(raw[d0][w]), c = bfhi(raw[d0][w]); ss += a * a + c * c; } }
            { const auto rr = __builtin_amdgcn_permlane32_swap(__float_as_uint(ss), __float_as_uint(ss), false, false); ss = __uint_as_float(rr[0]) + __uint_as_float(rr[1]); }
            const float rk = rsqrtf(ss * (1.f / 64.f) + 1e-6f);
#pragma unroll
            for (int d0 = 0; d0 < 4; ++d0) { const f32x4 g0 = *(const f32x4*)(kg + d0 * 16 + hi * 8), g1 = *(const f32x4*)(kg + d0 * 16 + hi * 8 + 4);
                kf[2 * d0 + half] = mk8(cvtpk(bflo(raw[d0][0]) * rk * g0[0], bfhi(raw[d0][0]) * rk * g0[1]), cvtpk(bflo(raw[d0][1]) * rk * g0[2], bfhi(raw[d0][1]) * rk * g0[3]),
                                        cvtpk(bflo(raw[d0][2]) * rk * g1[0], bfhi(raw[d0][2]) * rk * g1[1]), cvtpk(bflo(raw[d0][3]) * rk * g1[2], bfhi(raw[d0][3]) * rk * g1[3])); }
        }
        v4u vv[8];
        vtile_load(vv, QKV + (rowb + s0) * 1536 + 1280 + kvh * 64, 1536, lane);
        f32x16 p0 = {}, p1 = {};
#pragma unroll
        for (int d0 = 0; d0 < 4; ++d0) { p0 = MFMA32(kf[2 * d0], qf[d0], p0); p1 = MFMA32(kf[2 * d0 + 1], qf[d0], p1); }
        vtile_store(vv, wl, lane);
        const int dq = t0 + r32 - s0;
        float rmax = -INFINITY;
#pragma unroll
        for (int r = 0; r < 16; ++r) {
            { const int dist = dq - crow(r, hi); const bool ok = dist >= 0 && dist < 128; p0[r] = ok ? p0[r] - slope2 * (float)dist : -INFINITY; rmax = fmaxf(rmax, p0[r]); }
            { const int dist = dq - crow(r, hi) - 32; const bool ok = dist >= 0 && dist < 128; p1[r] = ok ? p1[r] - slope2 * (float)dist : -INFINITY; rmax = fmaxf(rmax, p1[r]); }
        }
        { const auto rr = __builtin_amdgcn_permlane32_swap(__float_as_uint(rmax), __float_as_uint(rmax), false, false); rmax = fmaxf(__uint_as_float(rr[0]), __uint_as_float(rr[1])); }
        const float mn = fmaxf(m, rmax);
        const float alpha = __builtin_amdgcn_exp2f(m - mn);
        m = mn;
        float rsum = 0.f; unsigned aw[16];
#pragma unroll
        for (int r = 0; r < 16; r += 2) {
            const float a0 = __builtin_amdgcn_exp2f(p0[r] - mn), a1 = __builtin_amdgcn_exp2f(p0[r + 1] - mn), c0 = __builtin_amdgcn_exp2f(p1[r] - mn), c1 = __builtin_amdgcn_exp2f(p1[r + 1] - mn);
            rsum += (a0 + a1) + (c0 + c1);
            aw[r >> 1] = cvtpk(a0, a1); aw[8 + (r >> 1)] = cvtpk(c0, c1);
        }
        { const auto rr = __builtin_amdgcn_permlane32_swap(__float_as_uint(rsum), __float_as_uint(rsum), false, false); rsum = __uint_as_float(rr[0]) + __uint_as_float(rr[1]); }
        l = l * alpha + rsum;
        if (hi == 0) wsf[r32] = alpha;
#pragma unroll
        for (int r = 0; r < 16; ++r) { const float f = wsf[crow(r, hi)]; o0[r] *= f; o1[r] *= f; }
#pragma unroll
        for (int ks = 0; ks < 4; ++ks) {
            const bf16x8 pa = mk8(aw[4 * ks], aw[4 * ks + 1], aw[4 * ks + 2], aw[4 * ks + 3]);
            o0 = MFMA32(pa, vfrag(vb + ks * 1024), o0);
            o1 = MFMA32(pa, vfrag(vb + 4096 + ks * 1024), o1);
        }
    }
    if (hi == 0) wsf[32 + r32] = 1.f / l;
#pragma unroll
    for (int r = 0; r < 16; ++r) { const float f = wsf[32 + crow(r, hi)]; o0[r] *= f; o1[r] *= f; }
    otile_store(o0, o1, wl + 8192, O + (rowb + t0) * 1024 + h * 64, 1024, lane);
}
__device__ __forceinline__ void phase_swatt(const bf16* QKV, const float* qg, const float* kg, const float* sinks, bf16* O, LAS unsigned char* lds, int vcu, int G, int wave, int lane) {
    LAS unsigned char* wl = lds + wave * 12544;
    const int nunits = NB * 16 * (S / 32);
    for (int it = 0; ; ++it) {
        const int u = (it * G + vcu) * NWAVES + wave;
        if (u >= nunits) break;
        const int bh = u >> 7, qb = u & 127, h = bh & 15;
        sw_unit(QKV, qg, kg, sinks[h] * LOG2E, exp2f(-0.5f * (float)(h + 1)) * LOG2E, O, bh >> 4, h, qb * 32, wl, lane);
    }
}

__device__ __forceinline__ void ce_desc(float& a, float& b) { float mx, mn; asm("v_max_f32_e32 %0, %1, %2" : "=v"(mx) : "v"(a), "v"(b)); asm("v_min_f32_e32 %0, %1, %2" : "=v"(mn) : "v"(a), "v"(b)); a = mx; b = mn; }
__device__ __forceinline__ float maxf_raw(float a, float b) { float mx; asm("v_max_f32_e32 %0, %1, %2" : "=v"(mx) : "v"(a), "v"(b)); return mx; }
__device__ __forceinline__ void sort16_desc(float (&v)[16]) {
#pragma unroll
    for (int k = 2; k <= 16; k <<= 1)
#pragma unroll
        for (int j = k >> 1; j > 0; j >>= 1)
#pragma unroll
            for (int i = 0; i < 16; ++i) { const int l = i ^ j; if (l > i) { if ((i & k) == 0) ce_desc(v[i], v[l]); else ce_desc(v[l], v[i]); } }
}
__device__ __forceinline__ void merge16_desc(float (&a)[16], const float (&b)[16]) {
#pragma unroll
    for (int i = 0; i < 16; ++i) a[i] = maxf_raw(a[i], b[15 - i]);
#pragma unroll
    for (int j = 8; j > 0; j >>= 1)
#pragma unroll
        for (int i = 0; i < 16; ++i) { const int l = i ^ j; if (l > i) ce_desc(a[i], a[l]); }
}
__device__ __forceinline__ void top16_of_4x16(float (&g0)[16], float (&g1)[16], float (&g2)[16], float (&g3)[16]) {
    sort16_desc(g0); sort16_desc(g1); sort16_desc(g2); sort16_desc(g3);
    merge16_desc(g0, g1); merge16_desc(g2, g3); merge16_desc(g0, g2);
}
__device__ __forceinline__ float setcode(float v, unsigned clear_mask, unsigned code) { return __uint_as_float((__float_as_uint(v) & clear_mask) | code); }

__device__ __forceinline__ void topk_unit(const bf16* QP, const bf16* SUBK, int* EID, float* GATE, int tt, int h, int lane) {
    const int r32 = lane & 31, hi = lane >> 5;
    float L[2][16];
#pragma unroll
    for (int p = 0; p < 2; ++p) {
        const bf16* qp = QP + (size_t)(tt * 32 + r32) * 2048 + h * 256 + p * 128 + hi * 8;
        bf16x8 qf[8];
#pragma unroll
        for (int ks = 0; ks < 8; ++ks) qf[ks] = *(const bf16x8*)(qp + ks * 16);
        const bf16* kp = SUBK + ((size_t)(h * 2 + p) * 128 + r32) * 128 + hi * 8;
        float g[4][16];
#pragma unroll
        for (int mt = 0; mt < 4; ++mt) {
            f32x16 acc = {};
#pragma unroll
            for (int ks = 0; ks < 8; ++ks) acc = MFMA32(*(const bf16x8*)(kp + (size_t)mt * 32 * 128 + ks * 16), qf[ks], acc);
#pragma unroll
            for (int r = 0; r < 16; ++r) g[mt][r] = setcode(acc[r], 0xFFFFFF80u, (unsigned)(32 * mt + (r & 3) + 8 * (r >> 2)));
            asm volatile("" ::: "memory");
        }
        top16_of_4x16(g[0], g[1], g[2], g[3]);
        float other[16];
#pragma unroll
        for (int i = 0; i < 16; ++i) {
            g[0][i] = __uint_as_float(__float_as_uint(g[0][i]) | (unsigned)(hi << 2));
            const auto rr = __builtin_amdgcn_permlane32_swap(__float_as_uint(g[0][i]), __float_as_uint(g[0][i]), false, false);
            other[i] = __uint_as_float(hi ? rr[0] : rr[1]);
        }
        merge16_desc(g[0], other);
#pragma unroll
        for (int i = 0; i < 16; ++i) L[p][i] = g[0][i];
    }
    unsigned TA[4], TB[4];
#pragma unroll
    for (int k = 0; k < 16; ++k) {
        const unsigned ca = (__float_as_uint(L[0][k]) & 0x7Fu) << (8 * (k & 3)), cb = (__float_as_uint(L[1][k]) & 0x7Fu) << (8 * (k & 3));
        if ((k & 3) == 0) { TA[k >> 2] = ca; TB[k >> 2] = cb; } else { TA[k >> 2] |= ca; TB[k >> 2] |= cb; }
    }
    float c[4][16];
    {
        int n = 0;
#pragma unroll
        for (int i = 0; i < 16; ++i)
#pragma unroll
            for (int j = 0; j < 16; ++j)
                if ((i + 1) * (j + 1) <= 16) { c[n >> 4][n & 15] = setcode(L[0][i] + L[1][j], 0xFFFFFF00u, (unsigned)(i * 16 + j)); ++n; }
#pragma unroll
        for (int k = 50; k < 64; ++k) c[k >> 4][k & 15] = -INFINITY;
    }
    top16_of_4x16(c[0], c[1], c[2], c[3]);
    float ex[16]; float den = 0.f;
#pragma unroll
    for (int r = 0; r < 16; ++r) { ex[r] = __builtin_amdgcn_exp2f((c[0][r] - c[0][0]) * LOG2E); den += ex[r]; }
    const float inv = 1.f / den;
    unsigned eidv[16];
#pragma unroll
    for (int r = 0; r < 16; ++r) {
        const unsigned code = __float_as_uint(c[0][r]) & 0xFFu, i = code >> 4, j = code & 15u;
        const unsigned sa = (i & 7u) | 0x0C0C0C00u, sb = (j & 7u) | 0x0C0C0C00u;
        const unsigned ia = (i & 8u) ? __builtin_amdgcn_perm(TA[3], TA[2], sa) : __builtin_amdgcn_perm(TA[1], TA[0], sa);
        const unsigned ib = (j & 8u) ? __builtin_amdgcn_perm(TB[3], TB[2], sb) : __builtin_amdgcn_perm(TB[1], TB[0], sb);
        eidv[r] = ia * 128u + ib;
        ex[r] *= inv;
    }
    if (hi == 0) {
        const size_t off = (size_t)(tt * 32 + r32) * 128 + h * 16;
#pragma unroll
        for (int q = 0; q < 4; ++q) {
            v4u e4 = {eidv[4 * q], eidv[4 * q + 1], eidv[4 * q + 2], eidv[4 * q + 3]}; *(v4u*)(EID + off + 4 * q) = e4;
            f32x4 g4 = {ex[4 * q], ex[4 * q + 1], ex[4 * q + 2], ex[4 * q + 3]}; *(f32x4*)(GATE + off + 4 * q) = g4;
        }
    }
}
__device__ __forceinline__ void phase_topk(const bf16* QP, const bf16* SUBK, int* EID, float* GATE, int vcu, int G, int wave, int lane) {
    const int nunits = (T / 32) * 8;
    for (int it = 0; ; ++it) {
        const int u = (it * G + vcu) * NWAVES + wave;
        if (u >= nunits) break;
        topk_unit(QP, SUBK, EID, GATE, u >> 3, u & 7, lane);
    }
}

__device__ __forceinline__ float gelu_tanh_f(float x) { const float u = 0.7978845608028654f * (x + 0.044715f * x * x * x); const float e = __builtin_amdgcn_exp2f(u * (2.f * LOG2E)); return x * (1.f - __builtin_amdgcn_rcpf(e + 1.f)); }
__device__ __forceinline__ void gather_token(float* h, const float* ssp_in, int np, const unsigned char* U8, const unsigned char* V8, const float* isu, const float* isv,
                                             const int* eid, const float* gate, bf16* hb, float* ssp_out, int t, int lane) {
    float x[16], acc[16];
#pragma unroll
    for (int j = 0; j < 4; ++j) { const f32x4 v = *(const f32x4*)(h + (size_t)t * 1024 + lane * 16 + 4 * j); x[4 * j] = v[0]; x[4 * j + 1] = v[1]; x[4 * j + 2] = v[2]; x[4 * j + 3] = v[3]; }
#pragma unroll
    for (int j = 0; j < 16; ++j) acc[j] = 0.f;
    float ssum = 0.f; for (int p = 0; p < np; ++p) ssum += ssp_in[(size_t)p * T + t];
    const float rstd = rsqrtf(ssum * (1.f / 1024.f) + 1e-6f);
    for (int k = 0; k < 128; ++k) {
        const int e = eid[(size_t)t * 128 + k];
        const float g = gate[(size_t)t * 128 + k];
        const v4u uw = *(const v4u*)(U8 + (size_t)e * 1024 + lane * 16);
        const v4u vw = *(const v4u*)(V8 + (size_t)e * 1024 + lane * 16);
        float s = 0.f;
#pragma unroll
        for (int j = 0; j < 4; ++j) { const f32x2 a = __builtin_amdgcn_cvt_pk_f32_fp8((int)uw[j], false), c = __builtin_amdgcn_cvt_pk_f32_fp8((int)uw[j], true);
            s += a[0] * x[4 * j] + a[1] * x[4 * j + 1] + c[0] * x[4 * j + 2] + c[1] * x[4 * j + 3]; }
        s = wave_sum(s);
        const float coef = g * gelu_tanh_f(s * rstd * isu[e]) * isv[e];
#pragma unroll
        for (int j = 0; j < 4; ++j) { const f32x2 a = __builtin_amdgcn_cvt_pk_f32_fp8((int)vw[j], false), c = __builtin_amdgcn_cvt_pk_f32_fp8((int)vw[j], true);
            acc[4 * j] = fmaf(coef, a[0], acc[4 * j]); acc[4 * j + 1] = fmaf(coef, a[1], acc[4 * j + 1]); acc[4 * j + 2] = fmaf(coef, c[0], acc[4 * j + 2]); acc[4 * j + 3] = fmaf(coef, c[1], acc[4 * j + 3]); }
    }
    float ss = 0.f;
#pragma unroll
    for (int j = 0; j < 16; ++j) { acc[j] += x[j]; ss += acc[j] * acc[j]; }
    ss = wave_sum(ss);
#pragma unroll
    for (int j = 0; j < 4; ++j) { f32x4 o = {acc[4 * j], acc[4 * j + 1], acc[4 * j + 2], acc[4 * j + 3]}; *(f32x4*)(h + (size_t)t * 1024 + lane * 16 + 4 * j) = o; }
    v4u o0, o1; o0.x = pk2(acc[0], acc[1]); o0.y = pk2(acc[2], acc[3]); o0.z = pk2(acc[4], acc[5]); o0.w = pk2(acc[6], acc[7]);
    o1.x = pk2(acc[8], acc[9]); o1.y = pk2(acc[10], acc[11]); o1.z = pk2(acc[12], acc[13]); o1.w = pk2(acc[14], acc[15]);
    *(v4u*)(hb + (size_t)t * 1024 + lane * 16) = o0; *(v4u*)(hb + (size_t)t * 1024 + lane * 16 + 8) = o1;
    if (lane == 0) ssp_out[t] = ss;
}
__device__ __forceinline__ void phase_gather(float* h, const float* ssp_in, int np, const unsigned char* U8, const unsigned char* V8, const float* isu, const float* isv,
                                             const int* eid, const float* gate, bf16* hb, float* ssp_out, int gw, int NGW, int lane) {
    for (int t = gw; t < T; t += NGW) gather_token(h, ssp_in, np, U8, V8, isu, isv, eid, gate, hb, ssp_out, t, lane);
}

#define DPP_ADD(s, CTRL) do { (s) += __builtin_bit_cast(float, __builtin_amdgcn_update_dpp(0, __builtin_bit_cast(int, (s)), (CTRL), 0xF, 0xF, true)); } while (0)
#define DPP_XOR1 0xB1
#define DPP_XOR2 0x4E
#define DPP_HALF_MIRROR 0x141
#define DPP_ROW_MIRROR 0x140
#define DPP_ROW_ROR8 0x128

__device__ __forceinline__ void phase_peer_u(const float* h, const int* eid, const unsigned char* U8, float* hp, int sl, int m, int nmem, int wave, int lane) {
    const int r = lane >> 3, c = lane & 7;
    const int nw = nmem * NWAVES;
    const unsigned char* tab = U8 + 128 * sl + 16 * c;
    for (int t = m * NWAVES + wave; t < T; t += nw) {
        f32x4 xv[4]; v4u ev[4];
#pragma unroll
        for (int q = 0; q < 4; ++q) { ev[q] = *(const v4u*)(eid + (size_t)t * 128 + 16 * r + 4 * q); xv[q] = *(const f32x4*)(h + (size_t)t * 1024 + 128 * sl + 16 * c + 4 * q); }
        v4u row[16];
#pragma unroll
        for (int j = 0; j < 16; ++j) row[j] = *(const v4u*)(tab + (size_t)ev[j >> 2][j & 3] * 1024);
        float p[16];
#pragma unroll
        for (int j = 0; j < 16; ++j) {
            float s = 0.f;
#pragma unroll
            for (int w = 0; w < 4; ++w) { const f32x2 lo = __builtin_amdgcn_cvt_pk_f32_fp8((int)row[j][w], false), hi = __builtin_amdgcn_cvt_pk_f32_fp8((int)row[j][w], true);
                s = fmaf(lo[0], xv[w][0], s); s = fmaf(lo[1], xv[w][1], s); s = fmaf(hi[0], xv[w][2], s); s = fmaf(hi[1], xv[w][3], s); }
            DPP_ADD(s, DPP_XOR1); DPP_ADD(s, DPP_XOR2); DPP_ADD(s, DPP_HALF_MIRROR);
            p[j] = s;
        }
        if (c == 0) {
            float* o = hp + ((size_t)sl * T + t) * 128 + 16 * r;
#pragma unroll
            for (int q = 0; q < 4; ++q) { f32x4 v = {p[4 * q], p[4 * q + 1], p[4 * q + 2], p[4 * q + 3]}; *(f32x4*)(o + 4 * q) = v; }
        }
    }
}
__device__ __forceinline__ void phase_peer_coef(const float* hp, const float* ssp_in, int np, const int* eid, const float* gate, const float* isu, const float* isv, float* coef, int gw, int NGW, int lane) {
    for (int t = gw; t < T; t += NGW) {
        float ssum = 0.f; for (int p = 0; p < np; ++p) ssum += ssp_in[(size_t)p * T + t];
        const float rstd = rsqrtf(ssum * (1.f / 1024.f) + 1e-6f);
#pragma unroll
        for (int half = 0; half < 2; ++half) {
            const int k = lane + 64 * half; float s = 0.f;
#pragma unroll
            for (int s8 = 0; s8 < 8; ++s8) s += hp[((size_t)s8 * T + t) * 128 + k];
            const int e = eid[(size_t)t * 128 + k];
            coef[(size_t)t * 128 + k] = gate[(size_t)t * 128 + k] * gelu_tanh_f(s * rstd * isu[e]) * isv[e];
        }
    }
}
__device__ __forceinline__ void phase_peer_v(float* h, const int* eid, const float* coef, const unsigned char* V8, bf16* hb, float* ssp_out, int sl, int m, int nmem, int wave, int lane) {
    const int r = lane >> 3, c = lane & 7;
    const int nw = nmem * NWAVES;
    const unsigned char* tab = V8 + 128 * sl + 16 * c;
    for (int t = m * NWAVES + wave; t < T; t += nw) {
        v4u ev[4]; f32x4 cv[4];
#pragma unroll
        for (int q = 0; q < 4; ++q) { ev[q] = *(const v4u*)(eid + (size_t)t * 128 + 16 * r + 4 * q); cv[q] = *(const f32x4*)(coef + (size_t)t * 128 + 16 * r + 4 * q); }
        v4u row[16];
#pragma unroll
        for (int j = 0; j < 16; ++j) row[j] = *(const v4u*)(tab + (size_t)ev[j >> 2][j & 3] * 1024);
        float* hrow = h + (size_t)t * 1024 + 128 * sl + 16 * c + 2 * r;
        const f32x2 hold = *(const f32x2*)hrow;
        float acc[16];
#pragma unroll
        for (int i = 0; i < 16; ++i) acc[i] = 0.f;
#pragma unroll
        for (int j = 0; j < 16; ++j) {
            const float cj = cv[j >> 2][j & 3];
#pragma unroll
            for (int w = 0; w < 4; ++w) { const f32x2 lo = __builtin_amdgcn_cvt_pk_f32_fp8((int)row[j][w], false), hi = __builtin_amdgcn_cvt_pk_f32_fp8((int)row[j][w], true);
                acc[4 * w] = fmaf(cj, lo[0], acc[4 * w]); acc[4 * w + 1] = fmaf(cj, lo[1], acc[4 * w + 1]); acc[4 * w + 2] = fmaf(cj, hi[0], acc[4 * w + 2]); acc[4 * w + 3] = fmaf(cj, hi[1], acc[4 * w + 3]); }
        }
        float a8[8], a4[4], a2[2];
#pragma unroll
        for (int i = 0; i < 8; ++i) { const auto rr = __builtin_amdgcn_permlane32_swap(__float_as_uint(acc[i]), __float_as_uint(acc[i + 8]), false, false); a8[i] = __uint_as_float(rr[0]) + __uint_as_float(rr[1]); }
#pragma unroll
        for (int i = 0; i < 4; ++i) { const auto rr = __builtin_amdgcn_permlane16_swap(__float_as_uint(a8[i]), __float_as_uint(a8[i + 4]), false, false); a4[i] = __uint_as_float(rr[0]) + __uint_as_float(rr[1]); }
        const bool b3 = (lane & 8) != 0;
#pragma unroll
        for (int i = 0; i < 2; ++i) { const float keep = b3 ? a4[i + 2] : a4[i]; float send = b3 ? a4[i] : a4[i + 2];
            a2[i] = keep + __builtin_bit_cast(float, __builtin_amdgcn_update_dpp(0, __builtin_bit_cast(int, send), DPP_ROW_ROR8, 0xF, 0xF, true)); }
        const float n0 = hold[0] + a2[0], n1 = hold[1] + a2[1];
        f32x2 o = {n0, n1}; *(f32x2*)hrow = o;
        *(unsigned*)(hb + (size_t)t * 1024 + 128 * sl + 16 * c + 2 * r) = pk2(n0, n1);
        const float ss = wave_sum(n0 * n0 + n1 * n1);
        if (lane == 0) ssp_out[(size_t)sl * T + t] = ss;
    }
}

enum Phase { PH_PREP = 0, PH_QKV0 = 1, PH_SBATT = 2, PH_OPROJ0 = 3, PH_PQ0 = 4, PH_TOPK0 = 5, PH_GATH0 = 6, PH_QKV1 = 7, PH_SWATT = 8, PH_OPROJ1 = 9, PH_PQ1 = 10, PH_TOPK1 = 11, PH_GATH1 = 12, PH_N = 13 };

__global__ void __launch_bounds__(NWAVES * 64, 2) mega(Args a) {
    extern __shared__ __attribute__((aligned(16))) unsigned char lds_raw[];
    LAS unsigned char* lds = (LAS unsigned char*)lds_raw;
    volatile LAS unsigned* MISC = (volatile LAS unsigned*)(lds + MISC_OFF);
    LAS float* rs = (LAS float*)(lds + RS_OFF);
    const int tid = threadIdx.x, lane = tid & 63, wave = __builtin_amdgcn_readfirstlane(tid >> 6);
    const int G = gridDim.x; const int bx = blockIdx.x; const int vcu = (G % 8 == 0) ? (bx % 8) * (G / 8) + bx / 8 : bx;
    const int gw = vcu * NWAVES + wave, NGW = G * NWAVES;
    unsigned char* ws = a.ws;
    gu32* ctl = (gu32*)(ws + WS_CTL);
    for (int u = tid; u < 64; u += NWAVES * 64) ((LAS unsigned*)(lds + MISC_OFF))[u] = 0u;
    __syncthreads();
    XcdBarrier bar = xcd_barrier_post((unsigned*)(ctl + CW_BAR) + a.li * XCD_BAR_WORDS, MISC + 8);
    bool first = true;
#define PHASE_ON(k) ((a.mask >> (k)) & 1u)
#define SEAM() do { if (!first) xcd_barrier(bar); first = false; } while (0)

    bf16* HB = (bf16*)(ws + WS_HB); bf16* QB = (bf16*)(ws + WS_QB); bf16* AO = (bf16*)(ws + WS_AO); bf16* QP = (bf16*)(ws + WS_QP);
    float* SSP0 = (float*)(ws + WS_SSP); float* SSP1 = SSP0 + 16 * T; float* SSP2 = SSP1 + 16 * T; float* SSP3 = SSP2 + 16 * T;

    if (PHASE_ON(PH_PREP)) { SEAM(); phase_prep(a, lds, gw, NGW, wave, lane); }

    if (PHASE_ON(PH_QKV0)) { SEAM();
        pg8::Gemm g{HB, (const bf16*)(ws + WS_WQKV0), T, 3072, 1024}; pg8::StaticOrder So; So.init(T, 3072, G, bx);
        fill_rs(rs, So, SSP0, 1, tid);
        pg8::EpiScaleBf16 E{QB, 1024, 1024, (size_t)(WS_KB - WS_QB) / 2, C2, rs};
        pg8::gemm_phase<pg8::EpiScaleBf16, pg8::StaticOrder, true, true>(lds, g, So, E);
    }
    if (PHASE_ON(PH_SBATT)) { SEAM(); phase_sbatt(QB, (const bf16*)(ws + WS_KB), (const bf16*)(ws + WS_VB), AO, lds, vcu, G, wave, lane); }
    if (PHASE_ON(PH_OPROJ0)) { SEAM();
        pg8::Gemm g{AO, (const bf16*)(ws + WS_WO0), T, 1024, 1024}; pg8::StaticOrder So; So.init(T, 1024, G, bx);
        pg8::EpiResid E{a.in[0], a.out, HB, SSP1, T};
        pg8::gemm_phase<pg8::EpiResid, pg8::StaticOrder, true, true>(lds, g, So, E);
    }
    if (PHASE_ON(PH_PQ0)) { SEAM();
        pg8::Gemm g{HB, (const bf16*)(ws + WS_WPQ0), T, 2048, 1024}; pg8::StaticOrder So; So.init(T, 2048, G, bx);
        fill_rs(rs, So, SSP1, 16, tid);
        pg8::EpiScaleBf16 E{QP, 2048, 0, 0, 1.f, rs};
        pg8::gemm_phase<pg8::EpiScaleBf16, pg8::StaticOrder, true, true>(lds, g, So, E);
    }
    if (PHASE_ON(PH_TOPK0)) { SEAM(); phase_topk(QP, (const bf16*)(ws + WS_SUBK), (int*)(ws + WS_EID), (float*)(ws + WS_GATE), vcu, G, wave, lane); }
    const int sl = bx & 7, smem = bx >> 3, nmem = (G - 1 - sl) / 8 + 1;
    float* HP = (float*)(ws + WS_HP); float* COEF = (float*)(ws + WS_COEF); const int* EIDp = (const int*)(ws + WS_EID); const float* GATEp = (const float*)(ws + WS_GATE);
    if (PHASE_ON(PH_GATH0)) { SEAM();
        phase_peer_u(a.out, EIDp, ws + WS_U8, HP, sl, smem, nmem, wave, lane); xcd_barrier(bar);
        phase_peer_coef(HP, SSP1, 16, EIDp, GATEp, (const float*)(ws + WS_ISU), (const float*)(ws + WS_ISV), COEF, gw, NGW, lane); xcd_barrier(bar);
        phase_peer_v(a.out, EIDp, COEF, ws + WS_V8, HB, SSP2, sl, smem, nmem, wave, lane);
    }
    if (PHASE_ON(PH_QKV1)) { SEAM();
        pg8::Gemm g{HB, (const bf16*)(ws + WS_WQKV1), T, 1536, 1024}; pg8::StaticOrder So; So.init(T, 1536, G, bx);
        fill_rs(rs, So, SSP2, 8, tid);
        pg8::EpiScaleBf16 E{QB, 1536, 0, 0, 1.f, rs};
        pg8::gemm_phase<pg8::EpiScaleBf16, pg8::StaticOrder, true, true>(lds, g, So, E);
    }
    if (PHASE_ON(PH_SWATT)) { SEAM(); phase_swatt(QB, a.in[6], a.in[7], a.in[8], AO, lds, vcu, G, wave, lane); }
    if (PHASE_ON(PH_OPROJ1)) { SEAM();
        pg8::Gemm g{AO, (const bf16*)(ws + WS_WO1), T, 1024, 1024}; pg8::StaticOrder So; So.init(T, 1024, G, bx);
        pg8::EpiResid E{a.out, a.out, HB, SSP3, T};
        pg8::gemm_phase<pg8::EpiResid, pg8::StaticOrder, true, true>(lds, g, So, E);
    }
    if (PHASE_ON(PH_PQ1)) { SEAM();
        pg8::Gemm g{HB, (const bf16*)(ws + WS_WPQ1), T, 2048, 1024}; pg8::StaticOrder So; So.init(T, 2048, G, bx);
        fill_rs(rs, So, SSP3, 16, tid);
        pg8::EpiScaleBf16 E{QP, 2048, 0, 0, 1.f, rs};
        pg8::gemm_phase<pg8::EpiScaleBf16, pg8::StaticOrder, true, true>(lds, g, So, E);
    }
    if (PHASE_ON(PH_TOPK1)) { SEAM(); phase_topk(QP, (const bf16*)(ws + WS_SUBK) + (size_t)8 * 2 * 128 * 128, (int*)(ws + WS_EID), (float*)(ws + WS_GATE), vcu, G, wave, lane); }
    if (PHASE_ON(PH_GATH1)) { SEAM();
        phase_peer_u(a.out, EIDp, ws + WS_U8 + (size_t)16384 * 1024, HP, sl, smem, nmem, wave, lane); xcd_barrier(bar);
        phase_peer_coef(HP, SSP3, 16, EIDp, GATEp, (const float*)(ws + WS_ISU) + 16384, (const float*)(ws + WS_ISV) + 16384, COEF, gw, NGW, lane); xcd_barrier(bar);
        phase_peer_v(a.out, EIDp, COEF, ws + WS_V8 + (size_t)16384 * 1024, HB, SSP0, sl, smem, nmem, wave, lane);
    }
#undef PHASE_ON
#undef SEAM
}

static void launch_mega(const Args& a0, unsigned mask, int li, int grid, hipStream_t stream) {
    Args a = a0; a.mask = mask; a.li = li;
    void* params[] = {&a};
    hipError_t e = hipLaunchCooperativeKernel((const void*)mega, dim3(grid), dim3(NWAVES * 64), params, LDS_BYTES, stream);
    if (e != hipSuccess) fprintf(stderr, "kernel_launch: cooperative launch failed: %s (grid %d)\n", hipGetErrorString(e), grid);
}

extern "C" void kernel_launch(void* const* d_in, const int* in_sizes, int n_in, void* d_out, int out_size, void* d_ws, size_t ws_size, hipStream_t stream) {
    static int grid = 0;
    if (grid == 0) {
        if (n_in != 15 || out_size != T * D || ws_size < WS_END) { fprintf(stderr, "kernel_launch: unexpected shapes (n_in %d out %d ws %zu)\n", n_in, out_size, ws_size); grid = -1; return; }
        int dev = 0, cus = 0, per_cu = 0;
        if (hipGetDevice(&dev) != hipSuccess || hipDeviceGetAttribute(&cus, hipDeviceAttributeMultiprocessorCount, dev) != hipSuccess) { grid = -1; return; }
        if (hipFuncSetAttribute((const void*)mega, hipFuncAttributeMaxDynamicSharedMemorySize, LDS_BYTES) != hipSuccess) { fprintf(stderr, "kernel_launch: hipFuncSetAttribute failed\n"); grid = -1; return; }
        if (hipOccupancyMaxActiveBlocksPerMultiprocessor(&per_cu, (const void*)mega, NWAVES * 64, LDS_BYTES) != hipSuccess || per_cu < 1) { fprintf(stderr, "kernel_launch: occupancy query says %d blocks per CU\n", per_cu); per_cu = 1; }
        (void)hipGetLastError();
        grid = cus;
        if (grid != 256) fprintf(stderr, "kernel_launch: note: %d CUs (tuned for 256)\n", grid);
    }
    if (grid < 0) return;
    (void)hipMemsetAsync((char*)d_ws + WS_CTL, 0, CTL_ZERO_BYTES, stream);
    Args a{};
    for (int i = 0; i < 15; ++i) a.in[i] = (const float*)d_in[i];
    a.out = (float*)d_out; a.ws = (unsigned char*)d_ws;
    unsigned char* ws = (unsigned char*)d_ws;
    bf16* QB = (bf16*)(ws + WS_QB); bf16* KB = (bf16*)(ws + WS_KB); bf16* VB = (bf16*)(ws + WS_VB); bf16* AO = (bf16*)(ws + WS_AO); bf16* QP = (bf16*)(ws + WS_QP); bf16* HB = (bf16*)(ws + WS_HB);
    float* SSP0 = (float*)(ws + WS_SSP); float* SSP1 = SSP0 + 16 * T; float* SSP2 = SSP1 + 16 * T;  float* SSP3 = SSP2 + 16 * T;
    int* EID = (int*)(ws + WS_EID); float* GATE = (float*)(ws + WS_GATE);
    const unsigned char* U8 = ws + WS_U8; const unsigned char* V8 = ws + WS_V8; const float* ISU = (const float*)(ws + WS_ISU); const float* ISV = (const float*)(ws + WS_ISV);
    const bf16* SUBK = (const bf16*)(ws + WS_SUBK);
#define M(k) (1u << (k))
    launch_mega(a, (1u << PH_N) - 1u, 0, grid, stream);
#undef M
}
```

```cpp
#include <hip/hip_runtime.h>
#include <cstdint>
#include <cstdio>

constexpr int D = 1024, NB = 4, S = 4096, T = NB * S;
constexpr float LOG2E = 1.4426950408889634f;
constexpr float C2 = 0.125f * LOG2E;

constexpr size_t MiB = 1u << 20;
constexpr size_t WS_CTL = 0, CTL_ZERO_BYTES = 1 * MiB;
constexpr size_t WS_WQKV0 = 2 * MiB, WS_WO0 = 8 * MiB, WS_WQKV1 = 10 * MiB, WS_WO1 = 13 * MiB, WS_WPQ0 = 15 * MiB, WS_WPQ1 = 19 * MiB;
constexpr size_t WS_SUBK = 23 * MiB;
constexpr size_t WS_ISU = 24 * MiB;
constexpr size_t WS_ISV = WS_ISU + 2 * 16384 * 4;
constexpr size_t WS_SSP = 25 * MiB;
constexpr size_t WS_U8 = 32 * MiB, WS_V8 = 64 * MiB;
constexpr size_t WS_HB = 96 * MiB;
constexpr size_t WS_QB = 128 * MiB, WS_KB = 160 * MiB, WS_VB = 192 * MiB;
constexpr size_t WS_AO = 224 * MiB;
constexpr size_t WS_QP = 256 * MiB;
constexpr size_t WS_EID = 320 * MiB, WS_GATE = 328 * MiB;
constexpr size_t WS_HP = 336 * MiB;
constexpr size_t WS_COEF = 400 * MiB;
constexpr size_t WS_END = 408 * MiB;
namespace pg8 {
#define PG8_LAS __attribute__((address_space(3)))
typedef unsigned short bf16_t;
typedef short bf16x8 __attribute__((ext_vector_type(8)));
typedef float f32x4 __attribute__((ext_vector_type(4)));
typedef unsigned u32x4 __attribute__((ext_vector_type(4)));
constexpr int BM = 256, BK = 64, HALF = 128, HTB = HALF * BK * 2  , STAGE_BYTES = 8 * HTB, NXCD = 8, WGM = 8;

__host__ __device__ __forceinline__ int lds_byte(int r, int c) { const int st = (r >> 4) * 2 + (c >> 5), rr = r & 15, cc = c & 31, ob = rr * 64 + cc * 2; return st * 1024 + (ob ^ (((ob >> 9) & 1) << 5)); }
__host__ __device__ __forceinline__ void stage_rc(int b, int& R, int& C) { const int st = b / 1024, sb = b % 1024, swz = sb ^ (((sb >> 9) & 1) << 5); R = (st >> 1) * 16 + swz / 64; C = (st & 1) * 32 + (swz % 64) / 2; }
__host__ __device__ __forceinline__ int perm32(int rho) { const int n = rho >> 4, i = rho & 15; return 8 * (i >> 2) + 4 * n + (i & 3); }

struct Unit { int pm, pn; };
struct Gemm { const bf16_t* A; const bf16_t* Bt; int M, N, K; };

struct StaticOrder {
    int nM, nN, nwg, G, c;
    __host__ __device__ void init(int M, int N, int G_, int c_) { nM = M / BM; nN = N / BM; nwg = nM * nN; G = G_; c = c_; }
    __host__ __device__ bool next(int i, Unit& u) const {
        const long L = (long)i * G + c; if (L >= nwg) return false;
        int wgid = (int)L; { const int q = nwg / NXCD, r = nwg % NXCD, xcd = wgid % NXCD, off = wgid / NXCD; wgid = (xcd < r ? xcd * (q + 1) : r * (q + 1) + (xcd - r) * q) + off; }
        const int nig = WGM * nN, gid = wgid / nig, fm = gid * WGM, gsz = (nM - fm) < WGM ? (nM - fm) : WGM;
        u.pm = fm + ((wgid % nig) % gsz); u.pn = (wgid % nig) / gsz; return true;
    }
    __device__ __forceinline__ void a_ready(const Unit&) const {}
    __device__ __forceinline__ void done(const Unit&) const {}
};


__device__ __forceinline__ unsigned cvt_pk_bf16(float lo, float hi) { unsigned r; asm volatile("v_cvt_pk_bf16_f32 %0, %1, %2" : "=v"(r) : "v"(lo), "v"(hi)); return r; }

struct EpiScaleBf16 {
    static constexpr bool PERM = true, AFTER_DRAIN = false;
    bf16_t* O; int ldc; int split_cols; size_t split_stride; float scale0; const PG8_LAS float* rs;
    __device__ __forceinline__ void operator()(const f32x4 (&acc)[2][2][4][2], const Unit& u, int ui, int wr, int wc, int fr, int fq) const {
        const int row0 = u.pm * BM + wr * 64 + fr; int colt = u.pn * BM; bf16_t* base = O;
        float sc = 1.f; if (split_cols) { const int t = colt / split_cols; base += (size_t)t * split_stride; colt -= t * split_cols; if (t == 0) sc = scale0; }
        const int col0 = colt + wc * 32 + 8 * fq;
        const PG8_LAS float* rsu = rs + (ui & 3) * 256 + wr * 64 + fr;
#pragma unroll
        for (int ai = 0; ai < 2; ++ai)
#pragma unroll
            for (int m = 0; m < 4; ++m) { bf16_t* rowp = base + (size_t)(row0 + ai * HALF + m * 16) * ldc + col0; const float s = rsu[ai * HALF + m * 16] * sc;
#pragma unroll
                for (int bj = 0; bj < 2; ++bj) { const f32x4 v0 = acc[ai][bj][m][0] * s, v1 = acc[ai][bj][m][1] * s;
                    u32x4 w; w.x = cvt_pk_bf16(v0[0], v0[1]); w.y = cvt_pk_bf16(v0[2], v0[3]); w.z = cvt_pk_bf16(v1[0], v1[1]); w.w = cvt_pk_bf16(v1[2], v1[3]);
                    *(u32x4*)(rowp + bj * HALF) = w; } }
    }
};
struct EpiResid {
    static constexpr bool PERM = true, AFTER_DRAIN = false;
    const float* resid; float* out; bf16_t* hb; float* ssp; int nrows;
    __device__ __forceinline__ void operator()(const f32x4 (&acc)[2][2][4][2], const Unit& u, int ui, int wr, int wc, int fr, int fq) const {
        const int col0 = u.pn * BM + wc * 32 + 8 * fq;
#pragma unroll
        for (int ai = 0; ai < 2; ++ai)
#pragma unroll
            for (int m = 0; m < 4; ++m) { const int row = u.pm * BM + ai * HALF + wr * 64 + m * 16 + fr; const size_t off = (size_t)row * 1024 + col0; float ss = 0.f;
#pragma unroll
                for (int bj = 0; bj < 2; ++bj) { const f32x4 r0 = *(const f32x4*)(resid + off + bj * HALF), r1 = *(const f32x4*)(resid + off + bj * HALF + 4);
                    const f32x4 v0 = acc[ai][bj][m][0] + r0, v1 = acc[ai][bj][m][1] + r1;
                    *(f32x4*)(out + off + bj * HALF) = v0; *(f32x4*)(out + off + bj * HALF + 4) = v1;
                    ss += (v0[0] * v0[0] + v0[1] * v0[1]) + (v0[2] * v0[2] + v0[3] * v0[3]) + (v1[0] * v1[0] + v1[1] * v1[1]) + (v1[2] * v1[2] + v1[3] * v1[3]);
                    u32x4 w; w.x = cvt_pk_bf16(v0[0], v0[1]); w.y = cvt_pk_bf16(v0[2], v0[3]); w.z = cvt_pk_bf16(v1[0], v1[1]); w.w = cvt_pk_bf16(v1[2], v1[3]);
                    *(u32x4*)(hb + off + bj * HALF) = w; }
                ss += __shfl_xor(ss, 16); ss += __shfl_xor(ss, 32);
                if (fq == 0) ssp[(size_t)(u.pn * 4 + wc) * nrows + row] = ss;
                asm volatile("" ::: "memory"); }
    }
};
template <class Epi, class Sched, bool ALIGN_EPI = false, bool SP2 = false>
__device__ __forceinline__ void gemm_phase(PG8_LAS unsigned char* lds, const Gemm g, const Sched& S, const Epi& E) {
    const int tid = threadIdx.x, wid = __builtin_amdgcn_readfirstlane(tid >> 6), lane = tid & 63, wr = wid >> 2, wc = wid & 3, fr = lane & 15, fq = lane >> 4;
    const int K = g.K, nt = K / BK;
    unsigned voffA[2], voffB[2];
#pragma unroll
    for (int i = 0; i < 2; ++i) { int R, C; stage_rc(tid * 16 + i * 8192, R, C); const int Rb = Epi::PERM ? ((R & ~31) + perm32(R & 31)) : R;
        voffA[i] = (unsigned)(R * K + C) * 2u; voffB[i] = (unsigned)(Rb * K + C) * 2u; }
    const size_t kstep = (size_t)(BK * 2);
    const size_t hstep = (size_t)HALF * K * 2;
    const size_t tstep = 2 * hstep;
    const unsigned ldsw = (unsigned)wid * 1024u;
    const int aoff = lds_byte(wr * 64 + fr, fq * 8), boff = lds_byte(wc * 32 + fr, fq * 8);
#define PG8_SA(b, h) (((b) * 2 + (h)) * HTB)
#define PG8_SB(b, h) ((4 + (b) * 2 + (h)) * HTB)
#define PG8_STAGE(bufoff, gbase, voff) do { _Pragma("unroll") for (int _i = 0; _i < 2; ++_i) \
        __builtin_amdgcn_global_load_lds((const unsigned*)((const char*)(gbase) + (voff)[_i]), (PG8_LAS unsigned*)(lds + (bufoff) + ldsw + _i * 8192), 16, 0, 0); } while (0)
#define PG8_LDA(dst, b, h) do { _Pragma("unroll") for (int m = 0; m < 4; ++m) _Pragma("unroll") for (int k = 0; k < 2; ++k) dst[m][k] = *(const PG8_LAS bf16x8*)(lds + PG8_SA(b, h) + aoff + m * 2048 + k * 1024); } while (0)
#define PG8_LDB(dst, b, h) do { _Pragma("unroll") for (int n = 0; n < 2; ++n) _Pragma("unroll") for (int k = 0; k < 2; ++k) dst[n][k] = *(const PG8_LAS bf16x8*)(lds + PG8_SB(b, h) + boff + n * 2048 + k * 1024); } while (0)
#define PG8_MMA(ai, bj, At, Bt) do { __builtin_amdgcn_s_setprio(1); _Pragma("unroll") for (int m = 0; m < 4; ++m) _Pragma("unroll") for (int n = 0; n < 2; ++n) _Pragma("unroll") for (int k = 0; k < 2; ++k) \
        acc[ai][bj][m][n] = __builtin_amdgcn_mfma_f32_16x16x32_bf16(Bt[n][k], At[m][k], acc[ai][bj][m][n], 0, 0, 0); __builtin_amdgcn_s_setprio(0); } while (0)
#define PG8_WAIT_V(n) asm volatile("s_waitcnt vmcnt(" #n ")" ::: "memory")
#define PG8_WAIT_L(n) asm volatile("s_waitcnt lgkmcnt(" #n ")" ::: "memory")
#define PG8_BAR __builtin_amdgcn_s_barrier()
#define PG8_SCHED __builtin_amdgcn_sched_barrier(0)
    Unit cur, nxt; int ui = 0;
    if (!S.next(0, cur)) return;
    f32x4 acc[2][2][4][2];
#pragma unroll
    for (int a = 0; a < 2; ++a)
#pragma unroll
        for (int b = 0; b < 2; ++b)
#pragma unroll
            for (int m = 0; m < 4; ++m)
#pragma unroll
                for (int n = 0; n < 2; ++n) acc[a][b][m][n] = (f32x4){0.f, 0.f, 0.f, 0.f};
    bf16x8 At[4][2], B0[2][2], B1[2][2];
    const char* cA = (const char*)g.A + (size_t)cur.pm * tstep; const char* cB = (const char*)g.Bt + (size_t)cur.pn * tstep;
    S.a_ready(cur);
    if constexpr (SP2) {
        PG8_STAGE(PG8_SB(0, 0), cB, voffB); PG8_STAGE(PG8_SB(0, 1), cB + hstep, voffB); PG8_STAGE(PG8_SA(0, 0), cA, voffA); PG8_STAGE(PG8_SA(0, 1), cA + hstep, voffA);
        if (wr == 1) PG8_BAR;
        PG8_WAIT_V(2); PG8_BAR;
        PG8_STAGE(PG8_SB(1, 0), cB + kstep, voffB); PG8_STAGE(PG8_SA(1, 0), cA + kstep, voffA); PG8_STAGE(PG8_SB(1, 1), cB + hstep + kstep, voffB);
        PG8_WAIT_V(6); PG8_BAR;
    } else {
        PG8_STAGE(PG8_SB(0, 0), cB, voffB); PG8_STAGE(PG8_SA(0, 0), cA, voffA); PG8_STAGE(PG8_SB(0, 1), cB + hstep, voffB); PG8_STAGE(PG8_SA(0, 1), cA + hstep, voffA);
        if (wr == 1) PG8_BAR;
        PG8_WAIT_V(4); PG8_BAR;
        PG8_STAGE(PG8_SB(1, 0), cB + kstep, voffB); PG8_STAGE(PG8_SA(1, 0), cA + kstep, voffA); PG8_STAGE(PG8_SB(1, 1), cB + hstep + kstep, voffB);
        PG8_WAIT_V(6); PG8_BAR;
    }
    for (;;) {
        const bool has_next = S.next(ui + 1, nxt);
        const char* nA = has_next ? (const char*)g.A + (size_t)nxt.pm * tstep : cA; const char* nB = has_next ? (const char*)g.Bt + (size_t)nxt.pn * tstep : cB;
        for (int t = 0; t < nt; t += 2) {
            const bool last = (t == nt - 2);
            const char* a1 = cA + (size_t)(t + 1) * kstep;
            const char* a2 = last ? nA : cA + (size_t)(t + 2) * kstep; const char* b2 = last ? nB : cB + (size_t)(t + 2) * kstep;
            const char* a3 = a2 + kstep; const char* b3 = b2 + kstep;
            if (last && has_next) S.a_ready(nxt);
            if constexpr (SP2) {
            PG8_LDB(B0, 0, 0); PG8_LDB(B1, 0, 1); PG8_SCHED; PG8_LDA(At, 0, 0); PG8_STAGE(PG8_SA(1, 1), a1 + hstep, voffA);
            PG8_WAIT_V(8); PG8_WAIT_L(0); PG8_BAR; PG8_MMA(0, 0, At, B0); PG8_MMA(0, 1, At, B1); PG8_BAR; PG8_SCHED;
            PG8_LDA(At, 0, 1); PG8_STAGE(PG8_SB(0, 0), b2, voffB); PG8_STAGE(PG8_SB(0, 1), b2 + hstep, voffB); PG8_STAGE(PG8_SA(0, 0), a2, voffA);
            PG8_WAIT_V(8); PG8_WAIT_L(0); PG8_BAR; PG8_MMA(1, 0, At, B0); PG8_MMA(1, 1, At, B1); PG8_BAR; PG8_SCHED;
            PG8_LDB(B0, 1, 0); PG8_LDB(B1, 1, 1); PG8_SCHED; PG8_LDA(At, 1, 0); PG8_STAGE(PG8_SA(0, 1), a2 + hstep, voffA);
            PG8_WAIT_V(8); PG8_WAIT_L(0); PG8_BAR; PG8_MMA(0, 0, At, B0); PG8_MMA(0, 1, At, B1); PG8_BAR; PG8_SCHED;
            PG8_LDA(At, 1, 1); PG8_STAGE(PG8_SB(1, 0), b3, voffB); PG8_STAGE(PG8_SB(1, 1), b3 + hstep, voffB); PG8_STAGE(PG8_SA(1, 0), a3, voffA);
            PG8_WAIT_V(8); PG8_WAIT_L(0); PG8_BAR; PG8_MMA(1, 0, At, B0); PG8_MMA(1, 1, At, B1); PG8_BAR; PG8_SCHED;
            } else {
            PG8_LDB(B0, 0, 0); PG8_SCHED; PG8_LDA(At, 0, 0); PG8_STAGE(PG8_SA(1, 1), a1 + hstep, voffA);
            PG8_WAIT_L(8); PG8_BAR; PG8_WAIT_L(0); PG8_MMA(0, 0, At, B0); PG8_BAR; PG8_SCHED;
            PG8_LDB(B1, 0, 1); PG8_STAGE(PG8_SB(0, 0), b2, voffB);
            PG8_BAR; PG8_WAIT_L(0); PG8_MMA(0, 1, At, B1); PG8_BAR;
            PG8_LDA(At, 0, 1); PG8_STAGE(PG8_SA(0, 0), a2, voffA);
            PG8_BAR; PG8_WAIT_L(0); PG8_MMA(1, 0, At, B0); PG8_BAR; PG8_SCHED;
            PG8_STAGE(PG8_SB(0, 1), b2 + hstep, voffB);
            PG8_WAIT_V(6); PG8_BAR; PG8_MMA(1, 1, At, B1); PG8_BAR;
            PG8_LDB(B0, 1, 0); PG8_SCHED; PG8_LDA(At, 1, 0); PG8_STAGE(PG8_SA(0, 1), a2 + hstep, voffA);
            PG8_WAIT_L(8); PG8_BAR; PG8_WAIT_L(0); PG8_MMA(0, 0, At, B0); PG8_BAR; PG8_SCHED;
            PG8_LDB(B1, 1, 1); PG8_STAGE(PG8_SB(1, 0), b3, voffB);
            PG8_BAR; PG8_WAIT_L(0); PG8_MMA(0, 1, At, B1); PG8_BAR;
            PG8_LDA(At, 1, 1); PG8_STAGE(PG8_SA(1, 0), a3, voffA);
            PG8_BAR; PG8_WAIT_L(0); PG8_MMA(1, 0, At, B0); PG8_BAR; PG8_SCHED;
            PG8_STAGE(PG8_SB(1, 1), b3 + hstep, voffB);
            PG8_WAIT_V(6); PG8_BAR; PG8_MMA(1, 1, At, B1); PG8_BAR;
            }
        }
        if constexpr (ALIGN_EPI) { if (wr == 0) PG8_BAR; }
        if constexpr (!Epi::AFTER_DRAIN) { E(acc, cur, ui, wr, wc, fr, fq); S.done(cur); }
        if (!has_next) break;
#pragma unroll
        for (int a = 0; a < 2; ++a)
#pragma unroll
            for (int b = 0; b < 2; ++b)
#pragma unroll
                for (int m = 0; m < 4; ++m)
#pragma unroll
                    for (int n = 0; n < 2; ++n) acc[a][b][m][n] = (f32x4){0.f, 0.f, 0.f, 0.f};
        cur = nxt; cA = nA; cB = nB; ++ui;
        if constexpr (ALIGN_EPI) { if (wr == 1) PG8_BAR; }
    }
    PG8_WAIT_V(0);
    if constexpr (!ALIGN_EPI) { if (wr == 0) PG8_BAR; }
    PG8_BAR;
    if constexpr (Epi::AFTER_DRAIN) { E.fused(acc, cur, wr, wc, fr, fq, lds, wid, lane); S.done(cur); }
#undef PG8_SA
#undef PG8_SB
#undef PG8_STAGE
#undef PG8_LDA
#undef PG8_LDB
#undef PG8_MMA
#undef PG8_WAIT_V
#undef PG8_WAIT_L
#undef PG8_BAR
#undef PG8_SCHED
}
}

#define GAS __attribute__((address_space(1)))
#define LAS __attribute__((address_space(3)))
typedef unsigned short bf16;
typedef unsigned v4u __attribute__((ext_vector_type(4)));
typedef float f32x4 __attribute__((ext_vector_type(4)));
typedef float f32x2 __attribute__((ext_vector_type(2)));
typedef float f32x16 __attribute__((ext_vector_type(16)));
typedef short bf16x8 __attribute__((ext_vector_type(8)));
typedef GAS unsigned gu32;
#define RLX_AGENT __ATOMIC_RELAXED, __HIP_MEMORY_SCOPE_AGENT
#define LDS_WAIT() asm volatile("s_waitcnt lgkmcnt(0)" ::: "memory")
#define VM_WAIT() asm volatile("s_waitcnt vmcnt(0)" ::: "memory")
__device__ __forceinline__ unsigned f2bf(float f) { unsigned u = __builtin_bit_cast(unsigned, f); return (u + 0x7fffu + ((u >> 16) & 1u)) >> 16; }
__device__ __forceinline__ unsigned pk2(float lo, float hi) { return f2bf(lo) | (f2bf(hi) << 16); }
__device__ __forceinline__ float bf2f(unsigned short b) { return __builtin_bit_cast(float, (unsigned)b << 16); }
__device__ __forceinline__ float bflo(unsigned w) { return __builtin_bit_cast(float, w << 16); }
__device__ __forceinline__ float bfhi(unsigned w) { return __builtin_bit_cast(float, w & 0xffff0000u); }
__device__ __forceinline__ float wave_sum(float v) {
#pragma unroll
    for (int o = 1; o < 64; o <<= 1) v += __shfl_xor(v, o);
    return v;
}
__device__ __forceinline__ float wave_max(float v) {
#pragma unroll
    for (int o = 1; o < 64; o <<= 1) v = fmaxf(v, __shfl_xor(v, o));
    return v;
}

#define XB_TMO      128
#define XB_XCNT(j)  (256  + 64 * (j))
#define XB_XSUB(j)  (1280 + 64 * (j))
#define XB_XGEN(j)  (2304 + 64 * (j))
#define XB_TOP      3328
#define XB_TOPGEN   3392
#define XCD_BAR_WORDS 3456
#define XB_SPIN_CAP (1u << 18)

__device__ __forceinline__ unsigned xb_ld(unsigned* p)              { return __hip_atomic_load(p, __ATOMIC_RELAXED, __HIP_MEMORY_SCOPE_AGENT); }
__device__ __forceinline__ unsigned xb_add(unsigned* p, unsigned v) { return __hip_atomic_fetch_add(p, v, __ATOMIC_RELAXED, __HIP_MEMORY_SCOPE_AGENT); }
__device__ __forceinline__ unsigned xb_xcc_id() { return (unsigned)__builtin_amdgcn_s_getreg((3 << 11) | 20) & 0xFu; }
#define XB_SPIN(cond, bar) do { unsigned _sp = 0; while (cond) { __builtin_amdgcn_s_sleep(1); \
    if ((++_sp & 255u) == 0u) { if (xb_ld(&(bar)[XB_TMO])) break; if (_sp > XB_SPIN_CAP) { atomicAdd(&(bar)[XB_TMO], 1u); break; } } } } while (0)

struct XcdBarrier {
    unsigned* bar; unsigned x;
    volatile LAS unsigned* st;
};

__device__ __forceinline__ XcdBarrier xcd_barrier_post(unsigned* bar, volatile LAS unsigned* st) {
    XcdBarrier b; b.bar = bar; b.x = xb_xcc_id(); b.st = st;
    if (threadIdx.x == 0) (void)xb_add(&bar[XB_XCNT(b.x)], 1u);
    return b;
}
__device__ __forceinline__ void xcd_barrier_complete(unsigned* bar, unsigned x, unsigned& nloc, unsigned& nx) {
    const unsigned G = gridDim.x * gridDim.y * gridDim.z;
    unsigned sum, cnt, mine, sp = 0u;
    for (;;) {
        sum = 0u; cnt = 0u; mine = 0u;
#pragma unroll
        for (unsigned j = 0; j < 16; ++j) { const unsigned c = xb_ld(&bar[XB_XCNT(j)]); sum += c; cnt += (c > 0u) ? 1u : 0u; mine = (j == x) ? c : mine; }
        if (sum == G) break;
        __builtin_amdgcn_s_sleep(1);
        if ((++sp & 255u) == 0u) { if (xb_ld(&bar[XB_TMO])) break; if (sp > XB_SPIN_CAP) { atomicAdd(&bar[XB_TMO], 1u); break; } }
    }
    nloc = mine > 0u ? mine : 1u; nx = cnt > 0u ? cnt : 1u;
}

__device__ __forceinline__ void xcd_barrier(const XcdBarrier& b) {
    asm volatile("s_waitcnt vmcnt(0)" ::: "memory");
    __syncthreads();
    if (threadIdx.x == 0) {
        unsigned* bar = b.bar;
        __builtin_amdgcn_s_waitcnt(0);
        unsigned nloc = b.st[0], nx = b.st[1];
        if (nloc == 0u) { xcd_barrier_complete(bar, b.x, nloc, nx); b.st[0] = nloc; b.st[1] = nx; }
        const unsigned old = xb_add(&bar[XB_XSUB(b.x)], 1u);
        const unsigned gen = old / nloc;
        if (old + 1u == (gen + 1u) * nloc) {
            __builtin_amdgcn_fence(__ATOMIC_RELEASE, "agent");
            asm volatile("s_waitcnt vmcnt(0)" ::: "memory");
            const unsigned og = xb_add(&bar[XB_TOP], 1u);
            const unsigned tg = og / nx;
            if (og + 1u == (tg + 1u) * nx) xb_add(&bar[XB_TOPGEN], 1u);
            else XB_SPIN(xb_ld(&bar[XB_TOPGEN]) == tg, bar);
            __builtin_amdgcn_fence(__ATOMIC_ACQUIRE, "agent");
            xb_add(&bar[XB_XGEN(b.x)], 1u);
            asm volatile("s_waitcnt vmcnt(0)" ::: "memory");
        } else {
            XB_SPIN(xb_ld(&bar[XB_XGEN(b.x)]) == gen, bar);
            __builtin_amdgcn_fence(__ATOMIC_ACQUIRE, "agent");
            asm volatile("s_waitcnt vmcnt(0)" ::: "memory");
        }
    }
    __syncthreads();
}

constexpr int NWAVES = 8;
constexpr int RING_BYTES = 131072;
constexpr int RS_OFF = RING_BYTES;
constexpr int MISC_OFF = RS_OFF + 4096;
constexpr int LDS_BYTES = 147456;
constexpr int CW_BAR = 4096;

struct Args { const float* in[15]; float* out; unsigned char* ws; unsigned mask; int li; unsigned rep; int pad; };

__device__ __forceinline__ void p0_transpose_item(const float* W, const float* gain, int K, int N, bf16* WT, LAS float* scr, int item, int lane) {
    const int nblk = N / 32, kb = item / nblk, nb = item % nblk, k0 = 64 * kb, n0 = 32 * nb;
#pragma unroll 8
    for (int i = 0; i < 32; ++i) { const int kk = 2 * i + (lane >> 5); float w = W[(size_t)(k0 + kk) * N + n0 + (lane & 31)]; if (gain) w *= gain[k0 + kk]; scr[kk * 33 + (lane & 31)] = w; }
    LDS_WAIT(); asm volatile("" ::: "memory");
    const int c = lane & 7;
#pragma unroll
    for (int j = 0; j < 4; ++j) { const int n = (lane >> 3) + 8 * j; const LAS float* s = scr + (8 * c) * 33 + n;
        v4u o; o.x = pk2(s[0 * 33], s[1 * 33]); o.y = pk2(s[2 * 33], s[3 * 33]); o.z = pk2(s[4 * 33], s[5 * 33]); o.w = pk2(s[6 * 33], s[7 * 33]);
        *(v4u*)(WT + (size_t)(n0 + n) * K + k0 + 8 * c) = o; }
    LDS_WAIT(); asm volatile("" ::: "memory");
}
template <int NR> __device__ __forceinline__ void conv_rows_fp8(const float* src, const float* gain, unsigned char* dst, float* inv_scale, int lane) {
    f32x4 v[NR][4]; float am[NR];
#pragma unroll
    for (int i = 0; i < NR; ++i)
#pragma unroll
        for (int j = 0; j < 4; ++j) v[i][j] = *(const f32x4*)(src + (size_t)i * 1024 + lane * 16 + 4 * j);
#pragma unroll
    for (int i = 0; i < NR; ++i) { am[i] = 0.f;
#pragma unroll
        for (int j = 0; j < 4; ++j) { if (gain) v[i][j] = v[i][j] * *(const f32x4*)(gain + lane * 16 + 4 * j);
            am[i] = fmaxf(am[i], fmaxf(fmaxf(fabsf(v[i][j][0]), fabsf(v[i][j][1])), fmaxf(fabsf(v[i][j][2]), fabsf(v[i][j][3])))); } }
#pragma unroll
    for (int o = 1; o < 64; o <<= 1)
#pragma unroll
        for (int i = 0; i < NR; ++i) am[i] = fmaxf(am[i], __shfl_xor(am[i], o));
#pragma unroll
    for (int i = 0; i < NR; ++i) {
        const float sc = am[i] > 0.f ? 224.f / am[i] : 1.f;
        v4u o;
#pragma unroll
        for (int j = 0; j < 4; ++j) { int w = __builtin_amdgcn_cvt_pk_fp8_f32(v[i][j][0] * sc, v[i][j][1] * sc, 0, false); w = __builtin_amdgcn_cvt_pk_fp8_f32(v[i][j][2] * sc, v[i][j][3] * sc, w, true); o[j] = (unsigned)w; }
        *(v4u*)(dst + (size_t)i * 1024 + lane * 16) = o;
        if (lane == 0) inv_scale[i] = am[i] > 0.f ? am[i] * (1.f / 224.f) : 1.f;
    }
}
__device__ __forceinline__ void phase_prep(const Args& a, LAS unsigned char* lds, int gw, int NGW, int wave, int lane) {
    LAS float* scr = (LAS float*)(lds + wave * 16384);
    unsigned char* ws = a.ws;
    constexpr int I0 = 16 * (3072 / 32), I1 = 16 * (1024 / 32), I2 = 16 * (1536 / 32), I3 = I1, I4 = 16 * (2048 / 32), I5 = I4;
    constexpr int NIT = I0 + I1 + I2 + I3 + I4 + I5;
    for (int it = gw; it < NIT; it += NGW) {
        int r = it;
        if (r < I0) { p0_transpose_item(a.in[2], a.in[1], 1024, 3072, (bf16*)(ws + WS_WQKV0), scr, r, lane); continue; } r -= I0;
        if (r < I1) { p0_transpose_item(a.in[3], nullptr, 1024, 1024, (bf16*)(ws + WS_WO0), scr, r, lane); continue; } r -= I1;
        if (r < I2) { p0_transpose_item(a.in[5], a.in[4], 1024, 1536, (bf16*)(ws + WS_WQKV1), scr, r, lane); continue; } r -= I2;
        if (r < I3) { p0_transpose_item(a.in[9], nullptr, 1024, 1024, (bf16*)(ws + WS_WO1), scr, r, lane); continue; } r -= I3;
        if (r < I4) { p0_transpose_item(a.in[11], a.in[10], 1024, 2048, (bf16*)(ws + WS_WPQ0), scr, r, lane); continue; } r -= I4;
        p0_transpose_item(a.in[11] + (size_t)1024 * 2048, a.in[10] + 1024, 1024, 2048, (bf16*)(ws + WS_WPQ1), scr, r, lane);
    }
    for (int it = gw; it < 1024; it += NGW) {
        const float* s = a.in[12] + (size_t)it * 512 + lane * 8; const f32x4 a0 = *(const f32x4*)s, a1 = *(const f32x4*)(s + 4);
        v4u o; o.x = pk2(a0[0], a0[1]); o.y = pk2(a0[2], a0[3]); o.z = pk2(a1[0], a1[1]); o.w = pk2(a1[2], a1[3]);
        *(v4u*)((bf16*)(ws + WS_SUBK) + (size_t)it * 512 + lane * 8) = o;
    }
    for (int r4 = gw; r4 < 16384; r4 += NGW) {
        const int r = r4 * 4, tb = r >> 15, row = r & 32767;
        const float* src = (tb ? a.in[14] : a.in[13]) + (size_t)row * 1024;
        const float* gain = tb ? nullptr : a.in[10] + (row >> 14) * 1024;
        conv_rows_fp8<4>(src, gain, ws + (tb ? WS_V8 : WS_U8) + (size_t)row * 1024, (float*)(ws + (tb ? WS_ISV : WS_ISU)) + row, lane);
    }
    for (int t2 = gw; t2 < T / 2; t2 += NGW) {
        f32x4 v[2][4]; float ss[2];
#pragma unroll
        for (int i = 0; i < 2; ++i)
#pragma unroll
            for (int j = 0; j < 4; ++j) v[i][j] = *(const f32x4*)(a.in[0] + (size_t)(2 * t2 + i) * 1024 + lane * 16 + 4 * j);
#pragma unroll
        for (int i = 0; i < 2; ++i) { ss[i] = 0.f;
#pragma unroll
            for (int j = 0; j < 4; ++j) ss[i] += (v[i][j][0] * v[i][j][0] + v[i][j][1] * v[i][j][1]) + (v[i][j][2] * v[i][j][2] + v[i][j][3] * v[i][j][3]); }
#pragma unroll
        for (int o = 1; o < 64; o <<= 1) { ss[0] += __shfl_xor(ss[0], o); ss[1] += __shfl_xor(ss[1], o); }
#pragma unroll
        for (int i = 0; i < 2; ++i) {
            v4u o0, o1; o0.x = pk2(v[i][0][0], v[i][0][1]); o0.y = pk2(v[i][0][2], v[i][0][3]); o0.z = pk2(v[i][1][0], v[i][1][1]); o0.w = pk2(v[i][1][2], v[i][1][3]);
            o1.x = pk2(v[i][2][0], v[i][2][1]); o1.y = pk2(v[i][2][2], v[i][2][3]); o1.z = pk2(v[i][3][0], v[i][3][1]); o1.w = pk2(v[i][3][2], v[i][3][3]);
            bf16* hb = (bf16*)(ws + WS_HB) + (size_t)(2 * t2 + i) * 1024 + lane * 16;
            *(v4u*)hb = o0; *(v4u*)(hb + 8) = o1;
            if (lane == 0) ((float*)(ws + WS_SSP))[2 * t2 + i] = ss[i];
        }
    }
}
template <class Sched> __device__ __forceinline__ void fill_rs(LAS float* rs, const Sched& So, const float* ssp, int np, int tid) {
    pg8::Unit u;
    for (int ui = 0; ui < 4 && So.next(ui, u); ++ui) {
        if (tid < 256) { const int row = u.pm * 256 + tid; float s = 0.f; for (int p = 0; p < np; ++p) s += ssp[(size_t)p * T + row]; rs[ui * 256 + tid] = rsqrtf(s * (1.f / 1024.f) + 1e-6f); }
    }
    __syncthreads();
}

namespace nv {
__device__ __forceinline__ float softplus(float z) { return fmaxf(z, 0.f) + log1pf(expf(-fabsf(z))); }
__device__ __forceinline__ float gelu_tanh(float x) { const float k = 0.7978845608028654f; return 0.5f * x * (1.f + tanhf(k * (x + 0.044715f * x * x * x))); }

__global__ void __launch_bounds__(256) k_sb_attn_b(const bf16* __restrict__ Q, const bf16* __restrict__ K, const bf16* __restrict__ V, bf16* __restrict__ O) {
    __shared__ float Ks[64][65];
    __shared__ float Vs[64][65];
    __shared__ float qs[4][64];
    const int tid = threadIdx.x, w = tid >> 6, lane = tid & 63;
    const int nblk = S / 4;
    const int bh = blockIdx.x / nblk, t0 = (blockIdx.x % nblk) * 4;
    const int b = bh / 16, h = bh % 16;
    const int t = t0 + w;
    const size_t rowb = (size_t)b * S;
    qs[w][lane] = bf2f(Q[(rowb + t) * 1024 + h * 64 + lane]);
    float acc = 0.f, carry = 0.f;
    const int ntile = (t0 + 3) / 64 + 1;
    for (int tile = ntile - 1; tile >= 0; --tile) {
        const int s0 = tile * 64;
        __syncthreads();
#pragma unroll
        for (int i = 0; i < 16; ++i) {
            const int idx = tid + 256 * i, r = idx >> 6, d = idx & 63;
            const size_t g = (rowb + s0 + r) * 1024 + h * 64 + d;
            Ks[r][d] = bf2f(K[g]); Vs[r][d] = bf2f(V[g]);
        }
        __syncthreads();
        float z = 0.f;
#pragma unroll 16
        for (int d = 0; d < 64; ++d) z = fmaf(qs[w][d], Ks[lane][d], z);
        z *= 0.6931471805599453f;
        const int s = s0 + lane;
        const bool valid = s < t;
        const float sp = softplus(z);
        const float L = valid ? -sp : 0.f;
        float x = L;
#pragma unroll
        for (int off = 1; off < 64; off <<= 1) { const float y = __shfl_down(x, off); if (lane + off < 64) x += y; }
        const float excl = x - L;
        const float total = __shfl(x, 0);
        const float log_a = (z - sp) + carry + excl;
        const float a = valid ? expf(log_a) : 0.f;
        carry += total;
#pragma unroll 16
        for (int j = 0; j < 64; ++j) acc = fmaf(__shfl(a, j), Vs[j][lane], acc);
    }
    O[(rowb + t) * 1024 + h * 64 + lane] = (bf16)f2bf(acc);
}

__global__ void __launch_bounds__(256) k_sw_attn_b(const bf16* __restrict__ qkv, const float* __restrict__ qg, const float* __restrict__ kg,
                                                   const float* __restrict__ sinks, bf16* __restrict__ O) {
    __shared__ float sc[4][128];
    const int tid = threadIdx.x, w = tid >> 6, lane = tid & 63;
    const int gw = blockIdx.x * 4 + w;
    const int h = gw & 15, bt = gw >> 4, t = bt % S, b = bt / S;
    const int kvh = h >> 2;
    const size_t rowb = (size_t)b * S;
    float q = bf2f(qkv[(rowb + t) * 1536 + h * 64 + lane]);
    { const float ss = wave_sum(q * q); q = q * rsqrtf(ss * (1.f / 64.f) + 1e-6f) * qg[lane]; }
    const float kgl = kg[lane];
    const float slope = exp2f(-8.f * (float)(h + 1) / 16.f);
    const int slo = (t - 127) > 0 ? (t - 127) : 0;
    const int nk = t - slo + 1;
    for (int i = 0; i < nk; ++i) {
        const int s = slo + i;
        float kd = bf2f(qkv[(rowb + s) * 1536 + 1024 + kvh * 64 + lane]);
        const float ss = wave_sum(kd * kd);
        kd = kd * rsqrtf(ss * (1.f / 64.f) + 1e-6f) * kgl;
        const float dot = wave_sum(q * kd);
        if (lane == 0) sc[w][i] = dot * 0.125f - slope * (float)(t - s);
    }
    __syncthreads();
    const float sink = sinks[h];
    float m = sink;
    for (int i = lane; i < nk; i += 64) m = fmaxf(m, sc[w][i]);
    m = wave_max(m);
    float den = 0.f;
    for (int i = lane; i < nk; i += 64) { const float p = expf(sc[w][i] - m); sc[w][i] = p; den += p; }
    den = wave_sum(den) + expf(sink - m);
    __syncthreads();
    const float inv = 1.f / den;
    float acc = 0.f;
    for (int i = 0; i < nk; ++i) acc = fmaf(sc[w][i] * inv, bf2f(qkv[(rowb + slo + i) * 1536 + 1280 + kvh * 64 + lane]), acc);
    O[(rowb + t) * 1024 + h * 64 + lane] = (bf16)f2bf(acc);
}

__global__ void __launch_bounds__(256) k_peer_topk_b(const bf16* __restrict__ qp, const bf16* __restrict__ subk, int* __restrict__ eid, float* __restrict__ gate) {
    __shared__ float qs[4][256];
    const int tid = threadIdx.x, w = tid >> 6, lane = tid & 63;
    const int gw = blockIdx.x * 4 + w;
    const int h = gw & 7, t = gw >> 3;
#pragma unroll
    for (int i = 0; i < 4; ++i) qs[w][lane + 64 * i] = bf2f(qp[(size_t)t * 2048 + h * 256 + lane + 64 * i]);
    __syncthreads();
    float ts[2]; int tii[2];
#pragma unroll
    for (int p = 0; p < 2; ++p) {
        const bf16* k0 = subk + ((size_t)(h * 2 + p) * 128 + lane) * 128;
        const bf16* k1 = k0 + 64 * 128;
        float v0 = 0.f, v1 = 0.f;
        for (int c = 0; c < 128; ++c) { const float qq = qs[w][p * 128 + c]; v0 = fmaf(qq, bf2f(k0[c]), v0); v1 = fmaf(qq, bf2f(k1[c]), v1); }
        float mys = 0.f; int myi = 0;
        for (int r = 0; r < 16; ++r) {
            float bv; int bi;
            if (v0 >= v1) { bv = v0; bi = lane; } else { bv = v1; bi = lane + 64; }
#pragma unroll
            for (int off = 1; off < 64; off <<= 1) {
                const float ov = __shfl_xor(bv, off); const int oi = __shfl_xor(bi, off);
                if (ov > bv || (ov == bv && oi < bi)) { bv = ov; bi = oi; }
            }
            if (lane == r) { mys = bv; myi = bi; }
            if (bi == lane) v0 = -INFINITY;
            if (bi == lane + 64) v1 = -INFINITY;
        }
        ts[p] = mys; tii[p] = myi;
    }
    float cv[4];
    {
        const float s0 = __shfl(ts[0], lane >> 2);
#pragma unroll
        for (int c = 0; c < 4; ++c) cv[c] = s0 + __shfl(ts[1], (lane & 3) * 4 + c);
    }
    float cs = 0.f; int cf = 0;
    for (int r = 0; r < 16; ++r) {
        float bv = cv[0]; int bi = lane * 4;
#pragma unroll
        for (int c = 1; c < 4; ++c) if (cv[c] > bv) { bv = cv[c]; bi = lane * 4 + c; }
#pragma unroll
        for (int off = 1; off < 64; off <<= 1) {
            const float ov = __shfl_xor(bv, off); const int oi = __shfl_xor(bi, off);
            if (ov > bv || (ov == bv && oi < bi)) { bv = ov; bi = oi; }
        }
        if (lane == r) { cs = bv; cf = bi; }
#pragma unroll
        for (int c = 0; c < 4; ++c) if (bi == lane * 4 + c) cv[c] = -INFINITY;
    }
    const float mval = wave_max(lane < 16 ? cs : -INFINITY);
    const float ex = lane < 16 ? expf(cs - mval) : 0.f;
    const float den = wave_sum(ex);
    const int i1 = __shfl(tii[0], (cf >> 4) & 15), i2 = __shfl(tii[1], cf & 15);
    if (lane < 16) {
        eid[(size_t)t * 128 + h * 16 + lane] = i1 * 128 + i2;
        gate[(size_t)t * 128 + h * 16 + lane] = ex / den;
    }
}

__global__ void __launch_bounds__(256) k_peer_gather_b(float* h, const float* __restrict__ ssp_in, int np, const unsigned char* __restrict__ U8, const unsigned char* __restrict__ V8,
                                                       const float* __restrict__ isu, const float* __restrict__ isv, const int* __restrict__ eid, const float* __restrict__ gate,
                                                       bf16* __restrict__ hb, float* __restrict__ ssp_out) {
    const int t = blockIdx.x * 4 + (threadIdx.x >> 6), lane = threadIdx.x & 63;
    float x[16], acc[16];
#pragma unroll
    for (int j = 0; j < 4; ++j) { const f32x4 v = *(const f32x4*)(h + (size_t)t * 1024 + lane * 16 + 4 * j); x[4 * j] = v[0]; x[4 * j + 1] = v[1]; x[4 * j + 2] = v[2]; x[4 * j + 3] = v[3]; }
#pragma unroll
    for (int j = 0; j < 16; ++j) acc[j] = 0.f;
    float ssum = 0.f; for (int p = 0; p < np; ++p) ssum += ssp_in[(size_t)p * T + t];
    const float rstd = rsqrtf(ssum * (1.f / 1024.f) + 1e-6f);
    for (int k = 0; k < 128; ++k) {
        const int e = eid[(size_t)t * 128 + k];
        const float g = gate[(size_t)t * 128 + k];
        const v4u uw = *(const v4u*)(U8 + (size_t)e * 1024 + lane * 16);
        float s = 0.f;
#pragma unroll
        for (int j = 0; j < 4; ++j) { const f32x2 a = __builtin_amdgcn_cvt_pk_f32_fp8((int)uw[j], false), c = __builtin_amdgcn_cvt_pk_f32_fp8((int)uw[j], true);
            s += a[0] * x[4 * j] + a[1] * x[4 * j + 1] + c[0] * x[4 * j + 2] + c[1] * x[4 * j + 3]; }
        s = wave_sum(s);
        const float coef = g * gelu_tanh(s * rstd * isu[e]) * isv[e];
        const v4u vw = *(const v4u*)(V8 + (size_t)e * 1024 + lane * 16);
#pragma unroll
        for (int j = 0; j < 4; ++j) { const f32x2 a = __builtin_amdgcn_cvt_pk_f32_fp8((int)vw[j], false), c = __builtin_amdgcn_cvt_pk_f32_fp8((int)vw[j], true);
            acc[4 * j] = fmaf(coef, a[0], acc[4 * j]); acc[4 * j + 1] = fmaf(coef, a[1], acc[4 * j + 1]); acc[4 * j + 2] = fmaf(coef, c[0], acc[4 * j + 2]); acc[4 * j + 3] = fmaf(coef, c[1], acc[4 * j + 3]); }
    }
    float ss = 0.f;
#pragma unroll
    for (int j = 0; j < 16; ++j) { acc[j] += x[j]; ss += acc[j] * acc[j]; }
    ss = wave_sum(ss);
#pragma unroll
    for (int j = 0; j < 4; ++j) { f32x4 o = {acc[4 * j], acc[4 * j + 1], acc[4 * j + 2], acc[4 * j + 3]}; *(f32x4*)(h + (size_t)t * 1024 + lane * 16 + 4 * j) = o; }
    v4u o0, o1; o0.x = pk2(acc[0], acc[1]); o0.y = pk2(acc[2], acc[3]); o0.z = pk2(acc[4], acc[5]); o0.w = pk2(acc[6], acc[7]);
    o1.x = pk2(acc[8], acc[9]); o1.y = pk2(acc[10], acc[11]); o1.z = pk2(acc[12], acc[13]); o1.w = pk2(acc[14], acc[15]);
    *(v4u*)(hb + (size_t)t * 1024 + lane * 16) = o0; *(v4u*)(hb + (size_t)t * 1024 + lane * 16 + 8) = o1;
    if (lane == 0) ssp_out[t] = ss;
}
}

typedef short v4i16_t __attribute__((ext_vector_type(4)));
__device__ __forceinline__ int crow(int r, int hi) { return (r & 3) + 8 * (r >> 2) + 4 * hi; }
__device__ __forceinline__ unsigned cvtpk(float lo, float hi) { typedef __bf16 bf16x2_t __attribute__((ext_vector_type(2))); f32x2 v = {lo, hi}; bf16x2_t b = __builtin_convertvector(v, bf16x2_t); return __builtin_bit_cast(unsigned, b); }
__device__ __forceinline__ bf16x8 mk8(unsigned a, unsigned b, unsigned c, unsigned d) { v4u w = {a, b, c, d}; return __builtin_bit_cast(bf16x8, w); }
__device__ __forceinline__ bf16x8 vfrag(LAS const unsigned char* p) {
    const v4i16_t lo = __builtin_amdgcn_ds_read_tr16_b64_v4i16((LAS v4i16_t*)p), hi = __builtin_amdgcn_ds_read_tr16_b64_v4i16((LAS v4i16_t*)(p + 512));
    return (bf16x8){lo[0], lo[1], lo[2], lo[3], hi[0], hi[1], hi[2], hi[3]};
}
__device__ __forceinline__ void vtile_load(v4u (&vv)[8], const bf16* vp0, int pitch, int lane) {
    const bf16* vp = vp0 + (size_t)(lane >> 3) * pitch + (lane & 7) * 8;
#pragma unroll
    for (int i = 0; i < 8; ++i) vv[i] = *(const v4u*)(vp + (size_t)i * 8 * pitch);
}
__device__ __forceinline__ void vtile_store(const v4u (&vv)[8], LAS unsigned char* wl, int lane) {
    const int c = lane & 7;
#pragma unroll
    for (int i = 0; i < 8; ++i) { const int kv = 8 * i + (lane >> 3); *(LAS v4u*)(wl + (c >> 2) * 4096 + (kv >> 4) * 1024 + (kv & 15) * 64 + (c & 3) * 16) = vv[i]; }
}
__device__ __forceinline__ void otile_store(const f32x16& o0, const f32x16& o1, LAS unsigned char* stg, bf16* Orow0, int pitch, int lane) {
    const int r32 = lane & 31, hi = lane >> 5;
    LAS unsigned short* s16 = (LAS unsigned short*)stg;
#pragma unroll
    for (int r = 0; r < 16; ++r) { const int orow = crow(r, hi); s16[orow * 64 + r32] = (unsigned short)f2bf(o0[r]); s16[orow * 64 + 32 + r32] = (unsigned short)f2bf(o1[r]); }
#pragma unroll
    for (int i = 0; i < 4; ++i) { const int row = i * 8 + (lane >> 3), ch = lane & 7; const v4u v = *(LAS const v4u*)(stg + row * 128 + ch * 16); *(v4u*)(Orow0 + (size_t)row * pitch + ch * 8) = v; }
}
#define MFMA32(A, B, C) __builtin_amdgcn_mfma_f32_32x32x16_bf16((A), (B), (C), 0, 0, 0)

__device__ __forceinline__ void sb_unit(const bf16* Q, const bf16* K, const bf16* V, bf16* O, int b, int h, int t0, LAS unsigned char* wl, int lane,
                                        const bf16x8 tri0, const bf16x8 tri1, const bf16x8 ones) {
    const int r32 = lane & 31, hi = lane >> 5;
    const size_t rowb = (size_t)b * S;
    const bf16* qp = Q + (rowb + t0 + r32) * 1024 + h * 64 + hi * 8;
    bf16x8 qf[4];
#pragma unroll
    for (int d0 = 0; d0 < 4; ++d0) qf[d0] = *(const bf16x8*)(qp + d0 * 16);
    f32x16 o0 = {}, o1 = {};
    float carry = 0.f;
    const int tdiag = t0 >> 6;
    LAS const unsigned char* vb = wl + ((lane >> 4) & 1) * 32 + (lane & 3) * 8 + (4 * hi + ((lane & 15) >> 2)) * 64;
    bf16x8 kf[8]; v4u vv[8];
#define SB_LOADK(tl) do { const bf16* kp_ = K + (rowb + (tl) * 64 + r32) * 1024 + h * 64 + hi * 8; \
        _Pragma("unroll") for (int d0 = 0; d0 < 4; ++d0) { kf[2 * d0] = *(const bf16x8*)(kp_ + d0 * 16); kf[2 * d0 + 1] = *(const bf16x8*)(kp_ + 32 * 1024 + d0 * 16); } } while (0)
    SB_LOADK(tdiag); vtile_load(vv, V + (rowb + tdiag * 64) * 1024 + h * 64, 1024, lane);
    for (int tile = tdiag; tile >= 0; --tile) {
        const int s0 = tile * 64, tn = tile > 0 ? tile - 1 : 0;
        f32x16 p0 = {}, p1 = {};
#pragma unroll
        for (int d0 = 0; d0 < 4; ++d0) { p0 = MFMA32(kf[2 * d0], qf[d0], p0); p1 = MFMA32(kf[2 * d0 + 1], qf[d0], p1); }
        SB_LOADK(tn);
        vtile_store(vv, wl, lane);
        vtile_load(vv, V + (rowb + tn * 64) * 1024 + h * 64, 1024, lane);
        const int lim = t0 + r32 - s0;
        unsigned lw[16]; float sumL = 0.f;
#pragma unroll
        for (int r = 0; r < 16; r += 2) {
            float La[2], Lb[2];
#pragma unroll
            for (int q = 0; q < 2; ++q) {
                { const float zc = fminf(p0[r + q], 126.f); const float sp = __builtin_amdgcn_logf(1.f + __builtin_amdgcn_exp2f(zc)); const bool ok = crow(r + q, hi) < lim;
                  La[q] = ok ? -sp : 0.f; p0[r + q] = ok ? zc - sp : -INFINITY; }
                { const float zc = fminf(p1[r + q], 126.f); const float sp = __builtin_amdgcn_logf(1.f + __builtin_amdgcn_exp2f(zc)); const bool ok = crow(r + q, hi) + 32 < lim;
                  Lb[q] = ok ? -sp : 0.f; p1[r + q] = ok ? zc - sp : -INFINITY; }
            }
            sumL += (La[0] + La[1]) + (Lb[0] + Lb[1]);
            lw[r >> 1] = cvtpk(La[0], La[1]); lw[8 + (r >> 1)] = cvtpk(Lb[0], Lb[1]);
        }
        f32x16 cinit;
#pragma unroll
        for (int r = 0; r < 16; ++r) cinit[r] = carry;
        const bf16x8 x00 = mk8(lw[0], lw[1], lw[2], lw[3]), x01 = mk8(lw[4], lw[5], lw[6], lw[7]), x10 = mk8(lw[8], lw[9], lw[10], lw[11]), x11 = mk8(lw[12], lw[13], lw[14], lw[15]);
        f32x16 y0 = MFMA32(tri0, x00, cinit); y0 = MFMA32(tri1, x01, y0); y0 = MFMA32(ones, x10, y0); y0 = MFMA32(ones, x11, y0);
        f32x16 y1 = MFMA32(tri0, x10, cinit); y1 = MFMA32(tri1, x11, y1);
        unsigned aw[16];
#pragma unroll
        for (int r = 0; r < 16; r += 2) {
            const float a0 = __builtin_amdgcn_exp2f(p0[r] + y0[r]), a1 = __builtin_amdgcn_exp2f(p0[r + 1] + y0[r + 1]);
            const float c0 = __builtin_amdgcn_exp2f(p1[r] + y1[r]), c1 = __builtin_amdgcn_exp2f(p1[r + 1] + y1[r + 1]);
            aw[r >> 1] = cvtpk(a0, a1); aw[8 + (r >> 1)] = cvtpk(c0, c1);
        }
#pragma unroll
        for (int ks = 0; ks < 4; ++ks) {
            const bf16x8 pa = mk8(aw[4 * ks], aw[4 * ks + 1], aw[4 * ks + 2], aw[4 * ks + 3]);
            o0 = MFMA32(pa, vfrag(vb + ks * 1024), o0);
            o1 = MFMA32(pa, vfrag(vb + 4096 + ks * 1024), o1);
        }
        { const auto rr = __builtin_amdgcn_permlane32_swap(__float_as_uint(sumL), __float_as_uint(sumL), false, false); carry += __uint_as_float(rr[0]) + __uint_as_float(rr[1]); }
        if (__all(carry < -160.f)) break;
    }
#undef SB_LOADK
    otile_store(o0, o1, wl + 8192, O + (rowb + t0) * 1024 + h * 64, 1024, lane);
}
__device__ __forceinline__ void phase_sbatt(const bf16* Q, const bf16* K, const bf16* V, bf16* O, LAS unsigned char* lds, int vcu, int G, int wave, int lane) {
    const int r32 = lane & 31, hi = lane >> 5;
    unsigned t0w[4], t1w[4];
#pragma unroll
    for (int j = 0; j < 8; ++j) {
        const int kv0 = 8 * (j >> 2) + 4 * hi + (j & 3);
        const unsigned b0 = (kv0 > r32) ? 0x3F80u : 0u, b1 = (kv0 + 16 > r32) ? 0x3F80u : 0u;
        if (j & 1) { t0w[j >> 1] |= b0 << 16; t1w[j >> 1] |= b1 << 16; } else { t0w[j >> 1] = b0; t1w[j >> 1] = b1; }
    }
    const bf16x8 tri0 = mk8(t0w[0], t0w[1], t0w[2], t0w[3]), tri1 = mk8(t1w[0], t1w[1], t1w[2], t1w[3]), ones = mk8(0x3F803F80u, 0x3F803F80u, 0x3F803F80u, 0x3F803F80u);
    LAS unsigned char* wl = lds + wave * 12288;
    const int nunits = NB * 16 * (S / 32);
    for (int it = 0; ; ++it) {
        const int u = (it * G + vcu) * NWAVES + wave;
        if (u >= nunits) break;
        const int bh = u >> 7, qb = u & 127;
        sb_unit(Q, K, V, O, bh >> 4, bh & 15, qb * 32, wl, lane, tri0, tri1, ones);
    }
}

__device__ __forceinline__ void sw_unit(const bf16* QKV, const float* qg, const float* kg, float sink2, float slope2, bf16* O, int b, int h, int t0, LAS unsigned char* wl, int lane) {
    const int r32 = lane & 31, hi = lane >> 5, kvh = h >> 2;
    const size_t rowb = (size_t)b * S;
    LAS float* wsf = (LAS float*)(wl + 12288);
    bf16x8 qf[4];
    {
        const bf16* qp = QKV + (rowb + t0 + r32) * 1536 + h * 64 + hi * 8;
        v4u raw[4]; float ss = 0.f;
#pragma unroll
        for (int d0 = 0; d0 < 4; ++d0) { raw[d0] = *(const v4u*)(qp + d0 * 16);
#pragma unroll
            for (int w = 0; w < 4; ++w) { const float a = bflo(raw[d0][w]), c = bfhi(raw[d0][w]); ss += a * a + c * c; } }
        { const auto rr = __builtin_amdgcn_permlane32_swap(__float_as_uint(ss), __float_as_uint(ss), false, false); ss = __uint_as_float(rr[0]) + __uint_as_float(rr[1]); }
        const float rq = rsqrtf(ss * (1.f / 64.f) + 1e-6f) * C2;
#pragma unroll
        for (int d0 = 0; d0 < 4; ++d0) { const f32x4 g0 = *(const f32x4*)(qg + d0 * 16 + hi * 8) * *(const f32x4*)(kg + d0 * 16 + hi * 8), g1 = *(const f32x4*)(qg + d0 * 16 + hi * 8 + 4) * *(const f32x4*)(kg + d0 * 16 + hi * 8 + 4);
            qf[d0] = mk8(cvtpk(bflo(raw[d0][0]) * rq * g0[0], bfhi(raw[d0][0]) * rq * g0[1]), cvtpk(bflo(raw[d0][1]) * rq * g0[2], bfhi(raw[d0][1]) * rq * g0[3]),
                         cvtpk(bflo(raw[d0][2]) * rq * g1[0], bfhi(raw[d0][2]) * rq * g1[1]), cvtpk(bflo(raw[d0][3]) * rq * g1[2], bfhi(raw[d0][3]) * rq * g1[3])); }
    }
    float m = sink2, l = 1.f;
    f32x16 o0 = {}, o1 = {};
    LAS const unsigned char* vb = wl + ((lane >> 4) & 1) * 32 + (lane & 3) * 8 + (4 * hi + ((lane & 15) >> 2)) * 64;
    const int thi = t0 >> 6, tlo = (t0 >= 127) ? ((t0 - 127) >> 6) : 0;
    v4u kf[8], vv[8];
#define SW_LOADK(tl) do { _Pragma("unroll") for (int half = 0; half < 2; ++half) { const bf16* kp_ = QKV + (rowb + (tl) * 64 + 32 * half + r32) * 1536 + 1024 + kvh * 64 + hi * 8; \
        _Pragma("unroll") for (int d0 = 0; d0 < 4; ++d0) kf[2 * d0 + half] = *(const v4u*)(kp_ + d0 * 16); } } while (0)
    SW_LOADK(thi); vtile_load(vv, QKV + (rowb + thi * 64) * 1536 + 1280 + kvh * 64, 1536, lane);
    for (int tile = thi; tile >= tlo; --tile) {
        const int s0 = tile * 64, tn = tile > tlo ? tile - 1 : tlo;
#pragma unroll
        for (int half = 0; half < 2; ++half) {
            float ss = 0.f;
#pragma unroll
            for (int d0 = 0; d0 < 4; ++d0)
#pragma unroll
                for (int w = 0; w < 4; ++w) { const float a = bflo(kf[2 * d0 + half][w]), c = bfhi(kf[2 * d0 + half][w]); ss += a * a + c * c; }
            { const auto rr = __builtin_amdgcn_permlane32_swap(__float_as_uint(ss), __float_as_uint(ss), false, false); ss = __uint_as_float(rr[0]) + __uint_as_float(rr[1]); }
            if (hi == half) wsf[32 * half + r32] = rsqrtf(ss * (1.f / 64.f) + 1e-6f);
        }
        f32x16 p0 = {}, p1 = {};
#pragma unroll
        for (int d0 = 0; d0 < 4; ++d0) { p0 = MFMA32(__builtin_bit_cast(bf16x8, kf[2 * d0]), qf[d0], p0); p1 = MFMA32(__builtin_bit_cast(bf16x8, kf[2 * d0 + 1]), qf[d0], p1); }
        SW_LOADK(tn);
        vtile_store(vv, wl, lane);
        vtile_load(vv, QKV + (rowb + tn * 64) * 1536 + 1280 + kvh * 64, 1536, lane);
        const int dq = t0 + r32 - s0;
        float rmax = -INFINITY;
#pragma unroll
        for (int g = 0; g < 4; ++g) {
            const f32x4 rk0 = *(LAS const f32x4*)(wsf + 8 * g + 4 * hi), rk1 = *(LAS const f32x4*)(wsf + 32 + 8 * g + 4 * hi);
#pragma unroll
            for (int j = 0; j < 4; ++j) { const int r = 4 * g + j;
                { const int dist = dq - crow(r, hi); const bool ok = dist >= 0 && dist < 128; p0[r] = ok ? p0[r] * rk0[j] - slope2 * (float)dist : -INFINITY; rmax = fmaxf(rmax, p0[r]); }
                { const int dist = dq - crow(r, hi) - 32; const bool ok = dist >= 0 && dist < 128; p1[r] = ok ? p1[r] * rk1[j] - slope2 * (float)dist : -INFINITY; rmax = fmaxf(rmax, p1[r]); } }
        }
        { const auto rr = __builtin_amdgcn_permlane32_swap(__float_as_uint(rmax), __float_as_uint(rmax), false, false); rmax = fmaxf(__uint_as_float(rr[0]), __uint_as_float(rr[1])); }
        const float mn = fmaxf(m, rmax);
        const float alpha = __builtin_amdgcn_exp2f(m - mn);
        m = mn;
        float rsum = 0.f; unsigned aw[16];
#pragma unroll
        for (int r = 0; r < 16; r += 2) {
            const float a0 = __builtin_amdgcn_exp2f(p0[r] - mn), a1 = __builtin_amdgcn_exp2f(p0[r + 1] - mn), c0 = __builtin_amdgcn_exp2f(p1[r] - mn), c1 = __builtin_amdgcn_exp2f(p1[r + 1] - mn);
            rsum += (a0 + a1) + (c0 + c1);
            aw[r >> 1] = cvtpk(a0, a1); aw[8 + (r >> 1)] = cvtpk(c0, c1);
        }
        { const auto rr = __builtin_amdgcn_permlane32_swap(__float_as_uint(rsum), __float_as_uint(rsum), false, false); rsum = __uint_as_float(rr[0]) + __uint_as_float(rr[1]); }
        l = l * alpha + rsum;
        if (hi == 0) wsf[64 + r32] = alpha;
#pragma unroll
        for (int g = 0; g < 4; ++g) { const f32x4 f = *(LAS const f32x4*)(wsf + 64 + 8 * g + 4 * hi);
#pragma unroll
            for (int j = 0; j < 4; ++j) { o0[4 * g + j] *= f[j]; o1[4 * g + j] *= f[j]; } }
#pragma unroll
        for (int ks = 0; ks < 4; ++ks) {
            const bf16x8 pa = mk8(aw[4 * ks], aw[4 * ks + 1], aw[4 * ks + 2], aw[4 * ks + 3]);
            o0 = MFMA32(pa, vfrag(vb + ks * 1024), o0);
            o1 = MFMA32(pa, vfrag(vb + 4096 + ks * 1024), o1);
        }
    }
#undef SW_LOADK
    if (hi == 0) wsf[64 + r32] = 1.f / l;
#pragma unroll
    for (int g = 0; g < 4; ++g) { const f32x4 f = *(LAS const f32x4*)(wsf + 64 + 8 * g + 4 * hi);
#pragma unroll
        for (int j = 0; j < 4; ++j) { o0[4 * g + j] *= f[j]; o1[4 * g + j] *= f[j]; } }
    otile_store(o0, o1, wl + 8192, O + (rowb + t0) * 1024 + h * 64, 1024, lane);
}
__device__ __forceinline__ void phase_swatt(const bf16* QKV, const float* qg, const float* kg, const float* sinks, bf16* O, LAS unsigned char* lds, int vcu, int G, int wave, int lane) {
    LAS unsigned char* wl = lds + wave * 12800;
    const int nunits = NB * 16 * (S / 32);
    for (int it = 0; ; ++it) {
        const int u = (it * G + vcu) * NWAVES + wave;
        if (u >= nunits) break;
        const int bh = u >> 7, qb = u & 127, h = bh & 15;
        sw_unit(QKV, qg, kg, sinks[h] * LOG2E, exp2f(-0.5f * (float)(h + 1)) * LOG2E, O, bh >> 4, h, qb * 32, wl, lane);
    }
}

__device__ __forceinline__ void ce_desc(float& a, float& b) { float mx, mn; asm("v_max_f32_e32 %0, %1, %2" : "=v"(mx) : "v"(a), "v"(b)); asm("v_min_f32_e32 %0, %1, %2" : "=v"(mn) : "v"(a), "v"(b)); a = mx; b = mn; }
__device__ __forceinline__ float maxf_raw(float a, float b) { float mx; asm("v_max_f32_e32 %0, %1, %2" : "=v"(mx) : "v"(a), "v"(b)); return mx; }
__device__ __forceinline__ void sort16_desc(float (&v)[16]) {
#pragma unroll
    for (int k = 2; k <= 16; k <<= 1)
#pragma unroll
        for (int j = k >> 1; j > 0; j >>= 1)
#pragma unroll
            for (int i = 0; i < 16; ++i) { const int l = i ^ j; if (l > i) { if ((i & k) == 0) ce_desc(v[i], v[l]); else ce_desc(v[l], v[i]); } }
}
__device__ __forceinline__ void merge16_desc(float (&a)[16], const float (&b)[16]) {
#pragma unroll
    for (int i = 0; i < 16; ++i) a[i] = maxf_raw(a[i], b[15 - i]);
#pragma unroll
    for (int j = 8; j > 0; j >>= 1)
#pragma unroll
        for (int i = 0; i < 16; ++i) { const int l = i ^ j; if (l > i) ce_desc(a[i], a[l]); }
}
__device__ __forceinline__ void top16_of_4x16(float (&g0)[16], float (&g1)[16], float (&g2)[16], float (&g3)[16]) {
    sort16_desc(g0); sort16_desc(g1); sort16_desc(g2); sort16_desc(g3);
    merge16_desc(g0, g1); merge16_desc(g2, g3); merge16_desc(g0, g2);
}
__device__ __forceinline__ float setcode(float v, unsigned clear_mask, unsigned code) { return __uint_as_float((__float_as_uint(v) & clear_mask) | code); }

__device__ __forceinline__ void topk_unit(const bf16* QP, const bf16* SUBK, int* EID, float* GATE, int tt, int h, int lane) {
    const int r32 = lane & 31, hi = lane >> 5;
    float L[2][16];
#pragma unroll
    for (int p = 0; p < 2; ++p) {
        const bf16* qp = QP + (size_t)(tt * 32 + r32) * 2048 + h * 256 + p * 128 + hi * 8;
        bf16x8 qf[8];
#pragma unroll
        for (int ks = 0; ks < 8; ++ks) qf[ks] = *(const bf16x8*)(qp + ks * 16);
        const bf16* kp = SUBK + ((size_t)(h * 2 + p) * 128 + r32) * 128 + hi * 8;
        float g[4][16];
        bf16x8 afA[8], afB[8];
#define TK_LOAD(af, mt) do { _Pragma("unroll") for (int ks = 0; ks < 8; ++ks) af[ks] = *(const bf16x8*)(kp + (size_t)(mt) * 32 * 128 + ks * 16); } while (0)
#define TK_MMA(af, mt) do { f32x16 acc = {}; _Pragma("unroll") for (int ks = 0; ks < 8; ++ks) acc = MFMA32(af[ks], qf[ks], acc); \
        _Pragma("unroll") for (int r = 0; r < 16; ++r) g[mt][r] = setcode(acc[r], 0xFFFFFF80u, (unsigned)(32 * (mt) + (r & 3) + 8 * (r >> 2))); } while (0)
        TK_LOAD(afA, 0); asm volatile("" ::: "memory");
        TK_LOAD(afB, 1); asm volatile("" ::: "memory"); TK_MMA(afA, 0);
        TK_LOAD(afA, 2); asm volatile("" ::: "memory"); TK_MMA(afB, 1);
        TK_LOAD(afB, 3); asm volatile("" ::: "memory"); TK_MMA(afA, 2);
        TK_MMA(afB, 3);
#undef TK_LOAD
#undef TK_MMA
        top16_of_4x16(g[0], g[1], g[2], g[3]);
        float other[16];
#pragma unroll
        for (int i = 0; i < 16; ++i) {
            g[0][i] = __uint_as_float(__float_as_uint(g[0][i]) | (unsigned)(hi << 2));
            const auto rr = __builtin_amdgcn_permlane32_swap(__float_as_uint(g[0][i]), __float_as_uint(g[0][i]), false, false);
            other[i] = __uint_as_float(hi ? rr[0] : rr[1]);
        }
        merge16_desc(g[0], other);
#pragma unroll
        for (int i = 0; i < 16; ++i) L[p][i] = g[0][i];
    }
    unsigned TA[4], TB[4];
#pragma unroll
    for (int k = 0; k < 16; ++k) {
        const unsigned ca = (__float_as_uint(L[0][k]) & 0x7Fu) << (8 * (k & 3)), cb = (__float_as_uint(L[1][k]) & 0x7Fu) << (8 * (k & 3));
        if ((k & 3) == 0) { TA[k >> 2] = ca; TB[k >> 2] = cb; } else { TA[k >> 2] |= ca; TB[k >> 2] |= cb; }
    }
    float c[4][16];
    {
        int n = 0;
#pragma unroll
        for (int i = 0; i < 16; ++i)
#pragma unroll
            for (int j = 0; j < 16; ++j)
                if ((i + 1) * (j + 1) <= 16) { c[n >> 4][n & 15] = setcode(L[0][i] + L[1][j], 0xFFFFFF00u, (unsigned)(i * 16 + j)); ++n; }
#pragma unroll
        for (int k = 50; k < 64; ++k) c[k >> 4][k & 15] = -INFINITY;
    }
    top16_of_4x16(c[0], c[1], c[2], c[3]);
    float ex[16]; float den = 0.f;
#pragma unroll
    for (int r = 0; r < 16; ++r) { ex[r] = __builtin_amdgcn_exp2f((c[0][r] - c[0][0]) * LOG2E); den += ex[r]; }
    const float inv = 1.f / den;
    unsigned eidv[16];
#pragma unroll
    for (int r = 0; r < 16; ++r) {
        const unsigned code = __float_as_uint(c[0][r]) & 0xFFu, i = code >> 4, j = code & 15u;
        const unsigned sa = (i & 7u) | 0x0C0C0C00u, sb = (j & 7u) | 0x0C0C0C00u;
        const unsigned ia = (i & 8u) ? __builtin_amdgcn_perm(TA[3], TA[2], sa) : __builtin_amdgcn_perm(TA[1], TA[0], sa);
        const unsigned ib = (j & 8u) ? __builtin_amdgcn_perm(TB[3], TB[2], sb) : __builtin_amdgcn_perm(TB[1], TB[0], sb);
        eidv[r] = ia * 128u + ib;
        ex[r] *= inv;
    }
    if (hi == 0) {
        const size_t off = (size_t)(tt * 32 + r32) * 128 + h * 16;
#pragma unroll
        for (int q = 0; q < 4; ++q) {
            v4u e4 = {eidv[4 * q], eidv[4 * q + 1], eidv[4 * q + 2], eidv[4 * q + 3]}; *(v4u*)(EID + off + 4 * q) = e4;
            f32x4 g4 = {ex[4 * q], ex[4 * q + 1], ex[4 * q + 2], ex[4 * q + 3]}; *(f32x4*)(GATE + off + 4 * q) = g4;
        }
    }
}
__device__ __forceinline__ void phase_topk(const bf16* QP, const bf16* SUBK, int* EID, float* GATE, int vcu, int G, int wave, int lane) {
    const int nunits = (T / 32) * 8;
    for (int it = 0; ; ++it) {
        const int u = (it * G + vcu) * NWAVES + wave;
        if (u >= nunits) break;
        topk_unit(QP, SUBK, EID, GATE, u >> 3, u & 7, lane);
    }
}

__device__ __forceinline__ float gelu_tanh_f(float x) { const float u = 0.7978845608028654f * (x + 0.044715f * x * x * x); const float e = __builtin_amdgcn_exp2f(u * (2.f * LOG2E)); return x * (1.f - __builtin_amdgcn_rcpf(e + 1.f)); }
__device__ __forceinline__ void gather_token(float* h, const float* ssp_in, int np, const unsigned char* U8, const unsigned char* V8, const float* isu, const float* isv,
                                             const int* eid, const float* gate, bf16* hb, float* ssp_out, int t, int lane) {
    float x[16], acc[16];
#pragma unroll
    for (int j = 0; j < 4; ++j) { const f32x4 v = *(const f32x4*)(h + (size_t)t * 1024 + lane * 16 + 4 * j); x[4 * j] = v[0]; x[4 * j + 1] = v[1]; x[4 * j + 2] = v[2]; x[4 * j + 3] = v[3]; }
#pragma unroll
    for (int j = 0; j < 16; ++j) acc[j] = 0.f;
    float ssum = 0.f; for (int p = 0; p < np; ++p) ssum += ssp_in[(size_t)p * T + t];
    const float rstd = rsqrtf(ssum * (1.f / 1024.f) + 1e-6f);
    for (int k = 0; k < 128; ++k) {
        const int e = eid[(size_t)t * 128 + k];
        const float g = gate[(size_t)t * 128 + k];
        const v4u uw = *(const v4u*)(U8 + (size_t)e * 1024 + lane * 16);
        const v4u vw = *(const v4u*)(V8 + (size_t)e * 1024 + lane * 16);
        float s = 0.f;
#pragma unroll
        for (int j = 0; j < 4; ++j) { const f32x2 a = __builtin_amdgcn_cvt_pk_f32_fp8((int)uw[j], false), c = __builtin_amdgcn_cvt_pk_f32_fp8((int)uw[j], true);
            s += a[0] * x[4 * j] + a[1] * x[4 * j + 1] + c[0] * x[4 * j + 2] + c[1] * x[4 * j + 3]; }
        s = wave_sum(s);
        const float coef = g * gelu_tanh_f(s * rstd * isu[e]) * isv[e];
#pragma unroll
        for (int j = 0; j < 4; ++j) { const f32x2 a = __builtin_amdgcn_cvt_pk_f32_fp8((int)vw[j], false), c = __builtin_amdgcn_cvt_pk_f32_fp8((int)vw[j], true);
            acc[4 * j] = fmaf(coef, a[0], acc[4 * j]); acc[4 * j + 1] = fmaf(coef, a[1], acc[4 * j + 1]); acc[4 * j + 2] = fmaf(coef, c[0], acc[4 * j + 2]); acc[4 * j + 3] = fmaf(coef, c[1], acc[4 * j + 3]); }
    }
    float ss = 0.f;
#pragma unroll
    for (int j = 0; j < 16; ++j) { acc[j] += x[j]; ss += acc[j] * acc[j]; }
    ss = wave_sum(ss);
#pragma unroll
    for (int j = 0; j < 4; ++j) { f32x4 o = {acc[4 * j], acc[4 * j + 1], acc[4 * j + 2], acc[4 * j + 3]}; *(f32x4*)(h + (size_t)t * 1024 + lane * 16 + 4 * j) = o; }
    v4u o0, o1; o0.x = pk2(acc[0], acc[1]); o0.y = pk2(acc[2], acc[3]); o0.z = pk2(acc[4], acc[5]); o0.w = pk2(acc[6], acc[7]);
    o1.x = pk2(acc[8], acc[9]); o1.y = pk2(acc[10], acc[11]); o1.z = pk2(acc[12], acc[13]); o1.w = pk2(acc[14], acc[15]);
    *(v4u*)(hb + (size_t)t * 1024 + lane * 16) = o0; *(v4u*)(hb + (size_t)t * 1024 + lane * 16 + 8) = o1;
    if (lane == 0) ssp_out[t] = ss;
}
__device__ __forceinline__ void phase_gather(float* h, const float* ssp_in, int np, const unsigned char* U8, const unsigned char* V8, const float* isu, const float* isv,
                                             const int* eid, const float* gate, bf16* hb, float* ssp_out, int gw, int NGW, int lane) {
    for (int t = gw; t < T; t += NGW) gather_token(h, ssp_in, np, U8, V8, isu, isv, eid, gate, hb, ssp_out, t, lane);
}

#define DPP_ADD(s, CTRL) do { (s) += __builtin_bit_cast(float, __builtin_amdgcn_update_dpp(0, __builtin_bit_cast(int, (s)), (CTRL), 0xF, 0xF, true)); } while (0)
#define DPP_XOR1 0xB1
#define DPP_XOR2 0x4E
#define DPP_HALF_MIRROR 0x141
#define DPP_ROW_MIRROR 0x140
#define DPP_ROW_ROR8 0x128

__device__ __forceinline__ void peer_rows(v4u (&row)[16], const v4u (&ev)[4], const unsigned char* tab) {
#pragma unroll
    for (int j = 0; j < 16; ++j) row[j] = *(const v4u*)(tab + (size_t)ev[j >> 2][j & 3] * 1024);
}
__device__ __forceinline__ void fmac_s(float& acc, float a, float b) { asm("v_fmac_f32_e32 %0, %1, %2" : "+v"(acc) : "v"(a), "v"(b)); }
__device__ __forceinline__ float fmul_s(float a, float b) { float r; asm("v_mul_f32_e32 %0, %1, %2" : "=v"(r) : "v"(a), "v"(b)); return r; }
__device__ __forceinline__ float fadd_s(float a, float b) { float r; asm("v_add_f32_e32 %0, %1, %2" : "=v"(r) : "v"(a), "v"(b)); return r; }
#define DPP_ADD_ASM(d, s, CTRL) asm("s_nop 1\n\tv_add_f32_dpp %0, %1, %1 " CTRL " row_mask:0xf bank_mask:0xf" : "=v"(d) : "v"(s))
__device__ __forceinline__ void peer_u_token(const v4u (&row)[16], const f32x4 (&xv)[4], float* hp_t, int r, int c) {
    float p[16];
#pragma unroll
    for (int j = 0; j < 16; ++j) {
        float s[4];
#pragma unroll
        for (int w = 0; w < 4; ++w) { const f32x2 lo = __builtin_amdgcn_cvt_pk_f32_fp8((int)row[j][w], false), hi = __builtin_amdgcn_cvt_pk_f32_fp8((int)row[j][w], true);
            s[w] = fmul_s(lo[0], xv[w][0]); fmac_s(s[w], lo[1], xv[w][1]); fmac_s(s[w], hi[0], xv[w][2]); fmac_s(s[w], hi[1], xv[w][3]); }
        float t = fadd_s(fadd_s(s[0], s[1]), fadd_s(s[2], s[3])), u;
        DPP_ADD_ASM(u, t, "quad_perm:[1,0,3,2]"); DPP_ADD_ASM(t, u, "quad_perm:[2,3,0,1]"); DPP_ADD_ASM(u, t, "row_half_mirror");
        p[j] = u;
    }
    if (c == 0) {
        float* o = hp_t + 16 * r;
#pragma unroll
        for (int q = 0; q < 4; ++q) { f32x4 v = {p[4 * q], p[4 * q + 1], p[4 * q + 2], p[4 * q + 3]}; *(f32x4*)(o + 4 * q) = v; }
    }
}
__device__ __forceinline__ void glds16(const void* gsrc, unsigned lds_dst) { unsigned keep;
    asm volatile("s_mov_b32 %0, m0\n\ts_mov_b32 m0, %2\n\ts_nop 0\n\tglobal_load_lds_dwordx4 %1, off\n\ts_mov_b32 m0, %0" : "=&s"(keep) : "v"(gsrc), "s"(lds_dst) : "memory"); }
#define LDS_ADDR(p) ((unsigned)__builtin_amdgcn_readfirstlane((int)(unsigned)(uintptr_t)(p)))
#define FENCE() asm volatile("" ::: "memory")
#define PEER_SLOT(i) (wl + ((((i) >> 3) & 1) * 8192 + ((i) & 7) * 1024))
__device__ __forceinline__ void phase_peer_u(const float* h, const int* eid, const unsigned char* U8, float* hp, LAS unsigned char* wl, int sl, int m, int nmem, int wave, int lane) {
    const int r = lane >> 3, c = lane & 7;
    const int nw = nmem * NWAVES, t0 = m * NWAVES + wave;
    const unsigned char* tab = U8 + 128 * sl + 16 * c;
    const int ntok = (T - t0 + nw - 1) / nw;
    float* hp_s = hp + (size_t)sl * T * 128;
    const bool lo32 = lane < 32; const int l16 = (lane & 31) * 16;
#define TOK(i) ((i) < ntok ? t0 + (i) * nw : t0)
#define DMA_TOK(i) do { const int t_ = TOK(i); const char* src_ = lo32 ? (const char*)(eid + (size_t)t_ * 128) + l16 : (const char*)(h + (size_t)t_ * 1024 + 128 * sl) + l16; \
        glds16(src_, LDS_ADDR(PEER_SLOT(i))); } while (0)
#define RD_EV(i) do { LAS const unsigned char* s_ = PEER_SLOT(i); _Pragma("unroll") for (int q = 0; q < 4; ++q) ev[q] = *(LAS const v4u*)(s_ + 64 * r + 16 * q); } while (0)
#define RD_X(i) do { LAS const unsigned char* s_ = PEER_SLOT(i); _Pragma("unroll") for (int q = 0; q < 4; ++q) xv[q] = *(LAS const f32x4*)(s_ + 512 + 64 * c + 16 * q); } while (0)
    v4u ev[4], rA[16], rB[16]; f32x4 xv[4];
#pragma unroll
    for (int k = 0; k < 8; ++k) DMA_TOK(k);
    for (int i0 = 0; i0 < ntok; i0 += 8) {
        VM_WAIT(); FENCE();
        RD_EV(i0); peer_rows(rA, ev, tab); FENCE();
#pragma unroll
        for (int k = 0; k < 8; ++k) DMA_TOK(i0 + 8 + k);
        FENCE();
#pragma unroll
        for (int k = 0; k < 8; k += 2) {
            RD_EV(i0 + k + 1); peer_rows(rB, ev, tab); FENCE();
            RD_X(i0 + k); peer_u_token(rA, xv, hp_s + (size_t)TOK(i0 + k) * 128, r, c); FENCE();
            if (k + 2 < 8) { RD_EV(i0 + k + 2); peer_rows(rA, ev, tab); FENCE(); }
            RD_X(i0 + k + 1); peer_u_token(rB, xv, hp_s + (size_t)TOK(i0 + k + 1) * 128, r, c); FENCE();
        }
    }
    VM_WAIT();
#undef DMA_TOK
#undef RD_X
}
__device__ __forceinline__ void phase_peer_coef(const float* hp, const float* ssp_in, int np, const int* eid, const float* gate, const float* isu, const float* isv, float* coef, int gw, int NGW, int lane) {
    for (int t = gw; t < T; t += NGW) {
        float ssum = 0.f; for (int p = 0; p < np; ++p) ssum += ssp_in[(size_t)p * T + t];
        const float rstd = rsqrtf(ssum * (1.f / 1024.f) + 1e-6f);
#pragma unroll
        for (int half = 0; half < 2; ++half) {
            const int k = lane + 64 * half; float s = 0.f;
#pragma unroll
            for (int s8 = 0; s8 < 8; ++s8) s += hp[((size_t)s8 * T + t) * 128 + k];
            const int e = eid[(size_t)t * 128 + k];
            coef[(size_t)t * 128 + k] = gate[(size_t)t * 128 + k] * gelu_tanh_f(s * rstd * isu[e]) * isv[e];
        }
    }
}
__device__ __forceinline__ void peer_v_token(const v4u (&row)[16], const f32x4 (&cv)[4], const f32x2 hold, float* hdst_l, bf16* hb_l, float* ssp_t, int lane) {
    float acc[16];
#pragma unroll
    for (int i = 0; i < 16; ++i) acc[i] = 0.f;
#pragma unroll
    for (int j = 0; j < 16; ++j) {
        const float cj = cv[j >> 2][j & 3];
#pragma unroll
        for (int w = 0; w < 4; ++w) { const f32x2 lo = __builtin_amdgcn_cvt_pk_f32_fp8((int)row[j][w], false), hi = __builtin_amdgcn_cvt_pk_f32_fp8((int)row[j][w], true);
            fmac_s(acc[4 * w], cj, lo[0]); fmac_s(acc[4 * w + 1], cj, lo[1]); fmac_s(acc[4 * w + 2], cj, hi[0]); fmac_s(acc[4 * w + 3], cj, hi[1]); }
    }
    float a8[8], a4[4], a2[2];
#pragma unroll
    for (int i = 0; i < 8; ++i) { const auto rr = __builtin_amdgcn_permlane32_swap(__float_as_uint(acc[i]), __float_as_uint(acc[i + 8]), false, false); a8[i] = fadd_s(__uint_as_float(rr[0]), __uint_as_float(rr[1])); }
#pragma unroll
    for (int i = 0; i < 4; ++i) { const auto rr = __builtin_amdgcn_permlane16_swap(__float_as_uint(a8[i]), __float_as_uint(a8[i + 4]), false, false); a4[i] = fadd_s(__uint_as_float(rr[0]), __uint_as_float(rr[1])); }
    const bool b3 = (lane & 8) != 0;
#pragma unroll
    for (int i = 0; i < 2; ++i) { const float keep = b3 ? a4[i + 2] : a4[i]; float send = b3 ? a4[i] : a4[i + 2];
        a2[i] = keep + __builtin_bit_cast(float, __builtin_amdgcn_update_dpp(0, __builtin_bit_cast(int, send), DPP_ROW_ROR8, 0xF, 0xF, true)); }
    const float n0 = hold[0] + a2[0], n1 = hold[1] + a2[1];
    f32x2 o = {n0, n1}; *(f32x2*)hdst_l = o;
    *(unsigned*)hb_l = pk2(n0, n1);
    const float ss = wave_sum(n0 * n0 + n1 * n1);
    if (lane == 0) *ssp_t = ss;
}
#define PEER_SLOTV(i) (wl + ((((i) >> 2) & 1) * 8192 + ((i) & 3) * 2048))
__device__ __forceinline__ void phase_peer_v(const float* h, float* hdst, const int* eid, const float* coef, const unsigned char* V8, bf16* hb, float* ssp_out, float* scratch, LAS unsigned char* wl, int sl, int m, int nmem, int wave, int lane) {
    const int r = lane >> 3, c = lane & 7;
    const int nw = nmem * NWAVES, t0 = m * NWAVES + wave;
    const unsigned char* tab = V8 + 128 * sl + 16 * c;
    const int ntok = (T - t0 + nw - 1) / nw;
    const size_t loff = 128 * sl + 16 * c + 2 * r; float* ssp_s = ssp_out + (size_t)sl * T;
    const bool lo32 = lane < 32; const int l16 = (lane & 31) * 16;
#define DMA_TOK(i) do { const int t_ = TOK(i); const char* src_ = lo32 ? (const char*)(eid + (size_t)t_ * 128) + l16 : (const char*)(coef + (size_t)t_ * 128) + l16; \
        glds16(src_, LDS_ADDR(PEER_SLOTV(i))); \
        const char* src2_ = (const char*)(h + (size_t)t_ * 1024 + 128 * sl) + l16;                         \
        glds16(src2_, LDS_ADDR(PEER_SLOTV(i) + 1024)); } while (0)
#define RD_EVV(i) do { LAS const unsigned char* s_ = PEER_SLOTV(i); _Pragma("unroll") for (int q = 0; q < 4; ++q) ev[q] = *(LAS const v4u*)(s_ + 64 * r + 16 * q); } while (0)
#define RD_C(i) do { LAS const unsigned char* s_ = PEER_SLOTV(i); _Pragma("unroll") for (int q = 0; q < 4; ++q) cv[q] = *(LAS const f32x4*)(s_ + 512 + 64 * r + 16 * q); hold = *(LAS const f32x2*)(s_ + 1024 + (16 * c + 2 * r) * 4); } while (0)
#define V_TOK(i, R) do { const bool ok_ = (i) < ntok; const size_t o_ = (size_t)TOK(i) * 1024 + loff; \
        peer_v_token(R, cv, hold, (ok_ ? hdst : scratch) + o_, (ok_ ? hb : (bf16*)scratch) + o_, (ok_ ? ssp_s : scratch) + TOK(i), lane); } while (0)
    v4u ev[4], rA[16], rB[16]; f32x4 cv[4]; f32x2 hold;
#pragma unroll
    for (int k = 0; k < 4; ++k) DMA_TOK(k);
    for (int i0 = 0; i0 < ntok; i0 += 4) {
        VM_WAIT(); FENCE();
        RD_EVV(i0); peer_rows(rA, ev, tab); FENCE();
#pragma unroll
        for (int k = 0; k < 4; ++k) DMA_TOK(i0 + 4 + k);
        FENCE();
#pragma unroll
        for (int k = 0; k < 4; k += 2) {
            RD_EVV(i0 + k + 1); peer_rows(rB, ev, tab); FENCE();
            RD_C(i0 + k); V_TOK(i0 + k, rA); FENCE();
            if (k + 2 < 4) { RD_EVV(i0 + k + 2); peer_rows(rA, ev, tab); FENCE(); }
            RD_C(i0 + k + 1); V_TOK(i0 + k + 1, rB); FENCE();
        }
    }
    VM_WAIT();
#undef V_TOK
#undef DMA_TOK
#undef RD_EVV
#undef RD_EV
#undef RD_C
#undef TOK
#undef FENCE
}

#ifndef PROBE_REP
#define PROBE_REP 0u
#endif
enum Phase { PH_PREP = 0, PH_QKV0 = 1, PH_SBATT = 2, PH_OPROJ0 = 3, PH_PQ0 = 4, PH_TOPK0 = 5, PH_GATH0 = 6, PH_QKV1 = 7, PH_SWATT = 8, PH_OPROJ1 = 9, PH_PQ1 = 10, PH_TOPK1 = 11, PH_GATH1 = 12, PH_N = 13 };

__global__ void __launch_bounds__(NWAVES * 64, 2) mega(Args a) {
    extern __shared__ __attribute__((aligned(16))) unsigned char lds_raw[];
    LAS unsigned char* lds = (LAS unsigned char*)lds_raw;
    volatile LAS unsigned* MISC = (volatile LAS unsigned*)(lds + MISC_OFF);
    LAS float* rs = (LAS float*)(lds + RS_OFF);
    const int tid = threadIdx.x, lane = tid & 63, wave = __builtin_amdgcn_readfirstlane(tid >> 6);
    const int G = gridDim.x; const int bx = blockIdx.x; const int vcu = (G % 8 == 0) ? (bx % 8) * (G / 8) + bx / 8 : bx;
    const int gw = vcu * NWAVES + wave, NGW = G * NWAVES;
    unsigned char* ws = a.ws;
    gu32* ctl = (gu32*)(ws + WS_CTL);
    for (int u = tid; u < 64; u += NWAVES * 64) ((LAS unsigned*)(lds + MISC_OFF))[u] = 0u;
    __syncthreads();
    XcdBarrier bar = xcd_barrier_post((unsigned*)(ctl + CW_BAR) + a.li * XCD_BAR_WORDS, MISC + 8);
    bool first = true;
#define PHASE_ON(k) ((a.mask >> (k)) & 1u)
#define SEAM() do { if (!first) xcd_barrier(bar); first = false; } while (0)

    bf16* HB = (bf16*)(ws + WS_HB); bf16* QB = (bf16*)(ws + WS_QB); bf16* AO = (bf16*)(ws + WS_AO); bf16* QP = (bf16*)(ws + WS_QP);
    float* SSP0 = (float*)(ws + WS_SSP); float* SSP1 = SSP0 + 16 * T; float* SSP2 = SSP1 + 16 * T; float* SSP3 = SSP2 + 16 * T;

#define NREP(b) (1 + (int)((PROBE_REP >> (b)) & 1u))
    if (PHASE_ON(PH_PREP)) { SEAM(); for (int q = 0; q < NREP(0); ++q) phase_prep(a, lds, gw, NGW, wave, lane); }

    if (PHASE_ON(PH_QKV0)) { SEAM();
        _Pragma("unroll") for (int q = 0; q < NREP(1); ++q) {
        pg8::Gemm g{HB, (const bf16*)(ws + WS_WQKV0), T, 3072, 1024}; pg8::StaticOrder So; So.init(T, 3072, G, bx);
        fill_rs(rs, So, SSP0, 1, tid);
        pg8::EpiScaleBf16 E{QB, 1024, 1024, (size_t)(WS_KB - WS_QB) / 2, C2, rs};
        pg8::gemm_phase<pg8::EpiScaleBf16, pg8::StaticOrder, true, true>(lds, g, So, E); }
    }
    if (PHASE_ON(PH_SBATT)) { SEAM(); for (int q = 0; q < NREP(2); ++q) phase_sbatt(QB, (const bf16*)(ws + WS_KB), (const bf16*)(ws + WS_VB), AO, lds, vcu, G, wave, lane); }
    if (PHASE_ON(PH_OPROJ0)) { SEAM();
        _Pragma("unroll") for (int q = 0; q < NREP(3); ++q) {
        pg8::Gemm g{AO, (const bf16*)(ws + WS_WO0), T, 1024, 1024}; pg8::StaticOrder So; So.init(T, 1024, G, bx);
        pg8::EpiResid E{a.in[0], a.out, HB, SSP1, T};
        pg8::gemm_phase<pg8::EpiResid, pg8::StaticOrder, true, true>(lds, g, So, E); }
    }
    if (PHASE_ON(PH_PQ0)) { SEAM();
        _Pragma("unroll") for (int q = 0; q < NREP(4); ++q) {
        pg8::Gemm g{HB, (const bf16*)(ws + WS_WPQ0), T, 2048, 1024}; pg8::StaticOrder So; So.init(T, 2048, G, bx);
        fill_rs(rs, So, SSP1, 16, tid);
        pg8::EpiScaleBf16 E{QP, 2048, 0, 0, 1.f, rs};
        pg8::gemm_phase<pg8::EpiScaleBf16, pg8::StaticOrder, true, true>(lds, g, So, E);
        _Pragma("unroll") for (int q2 = 0; q2 < NREP(5); ++q2) { pg8::Unit u; for (int ui = 0; So.next(ui, u); ++ui) topk_unit(QP, (const bf16*)(ws + WS_SUBK), (int*)(ws + WS_EID), (float*)(ws + WS_GATE), u.pm * 8 + wave, u.pn, lane); } }
    }
    const int sl = bx & 7, smem = bx >> 3, nmem = (G - 1 - sl) / 8 + 1;
    float* HP = (float*)(ws + WS_HP); float* COEF = (float*)(ws + WS_COEF); const int* EIDp = (const int*)(ws + WS_EID); const float* GATEp = (const float*)(ws + WS_GATE);
    if (PHASE_ON(PH_GATH0)) { SEAM();
        _Pragma("unroll") for (int q = 0; q < NREP(6); ++q) phase_peer_u(a.out, EIDp, ws + WS_U8, HP, lds + wave * 16384, sl, smem, nmem, wave, lane);
        xcd_barrier(bar);
        _Pragma("unroll") for (int q = 0; q < NREP(13); ++q) phase_peer_coef(HP, SSP1, 16, EIDp, GATEp, (const float*)(ws + WS_ISU), (const float*)(ws + WS_ISV), COEF, gw, NGW, lane);
        xcd_barrier(bar);
        if (NREP(14) > 1) phase_peer_v(a.out, HP, EIDp, COEF, ws + WS_V8, (bf16*)QP, SSP3, HP, lds + wave * 16384, sl, smem, nmem, wave, lane);
        phase_peer_v(a.out, a.out, EIDp, COEF, ws + WS_V8, HB, SSP2, HP, lds + wave * 16384, sl, smem, nmem, wave, lane);
    }
    if (PHASE_ON(PH_QKV1)) { SEAM();
        _Pragma("unroll") for (int q = 0; q < NREP(7); ++q) {
        pg8::Gemm g{HB, (const bf16*)(ws + WS_WQKV1), T, 1536, 1024}; pg8::StaticOrder So; So.init(T, 1536, G, bx);
        fill_rs(rs, So, SSP2, 8, tid);
        pg8::EpiScaleBf16 E{QB, 1536, 0, 0, 1.f, rs};
        pg8::gemm_phase<pg8::EpiScaleBf16, pg8::StaticOrder, true, true>(lds, g, So, E); }
    }
    if (PHASE_ON(PH_SWATT)) { SEAM(); for (int q = 0; q < NREP(8); ++q) phase_swatt(QB, a.in[6], a.in[7], a.in[8], AO, lds, vcu, G, wave, lane); }
    if (PHASE_ON(PH_OPROJ1)) { SEAM();
        _Pragma("unroll") for (int q = NREP(9) - 1; q >= 0; --q) {
        pg8::Gemm g{AO, (const bf16*)(ws + WS_WO1), T, 1024, 1024}; pg8::StaticOrder So; So.init(T, 1024, G, bx);
        pg8::EpiResid E{a.out, q ? HP : a.out, q ? (bf16*)QP : HB, q ? SSP0 : SSP3, T};
        pg8::gemm_phase<pg8::EpiResid, pg8::StaticOrder, true, true>(lds, g, So, E); }
    }
    if (PHASE_ON(PH_PQ1)) { SEAM();
        _Pragma("unroll") for (int q = 0; q < NREP(10); ++q) {
        pg8::Gemm g{HB, (const bf16*)(ws + WS_WPQ1), T, 2048, 1024}; pg8::StaticOrder So; So.init(T, 2048, G, bx);
        fill_rs(rs, So, SSP3, 16, tid);
        pg8::EpiScaleBf16 E{QP, 2048, 0, 0, 1.f, rs};
        pg8::gemm_phase<pg8::EpiScaleBf16, pg8::StaticOrder, true, true>(lds, g, So, E);
        _Pragma("unroll") for (int q2 = 0; q2 < NREP(11); ++q2) { pg8::Unit u; for (int ui = 0; So.next(ui, u); ++ui) topk_unit(QP, (const bf16*)(ws + WS_SUBK) + (size_t)8 * 2 * 128 * 128, (int*)(ws + WS_EID), (float*)(ws + WS_GATE), u.pm * 8 + wave, u.pn, lane); } }
    }
    if (PHASE_ON(PH_GATH1)) { SEAM();
        _Pragma("unroll") for (int q = 0; q < NREP(12); ++q) phase_peer_u(a.out, EIDp, ws + WS_U8 + (size_t)16384 * 1024, HP, lds + wave * 16384, sl, smem, nmem, wave, lane);
        xcd_barrier(bar);
        _Pragma("unroll") for (int q = 0; q < NREP(13); ++q) phase_peer_coef(HP, SSP3, 16, EIDp, GATEp, (const float*)(ws + WS_ISU) + 16384, (const float*)(ws + WS_ISV) + 16384, COEF, gw, NGW, lane);
        xcd_barrier(bar);
        if (NREP(14) > 1) phase_peer_v(a.out, HP, EIDp, COEF, ws + WS_V8 + (size_t)16384 * 1024, (bf16*)QP, SSP0, HP, lds + wave * 16384, sl, smem, nmem, wave, lane);
        phase_peer_v(a.out, a.out, EIDp, COEF, ws + WS_V8 + (size_t)16384 * 1024, HB, SSP0, HP, lds + wave * 16384, sl, smem, nmem, wave, lane);
    }
    if (NREP(16) > 1) { for (int q = 0; q < 10; ++q) xcd_barrier(bar); }
#undef NREP
#undef PHASE_ON
#undef SEAM
}

static void launch_mega(const Args& a0, unsigned mask, int li, int grid, hipStream_t stream) {
    Args a = a0; a.mask = mask; a.li = li; a.rep = 0u; a.pad = 0;
    void* params[] = {&a};
    hipError_t e = hipLaunchCooperativeKernel((const void*)mega, dim3(grid), dim3(NWAVES * 64), params, LDS_BYTES, stream);
    if (e != hipSuccess) fprintf(stderr, "kernel_launch: cooperative launch failed: %s (grid %d)\n", hipGetErrorString(e), grid);
}

extern "C" void kernel_launch(void* const* d_in, const int* in_sizes, int n_in, void* d_out, int out_size, void* d_ws, size_t ws_size, hipStream_t stream) {
    static int grid = 0;
    if (grid == 0) {
        if (n_in != 15 || out_size != T * D || ws_size < WS_END) { fprintf(stderr, "kernel_launch: unexpected shapes (n_in %d out %d ws %zu)\n", n_in, out_size, ws_size); grid = -1; return; }
        int dev = 0, cus = 0, per_cu = 0;
        if (hipGetDevice(&dev) != hipSuccess || hipDeviceGetAttribute(&cus, hipDeviceAttributeMultiprocessorCount, dev) != hipSuccess) { grid = -1; return; }
        if (hipFuncSetAttribute((const void*)mega, hipFuncAttributeMaxDynamicSharedMemorySize, LDS_BYTES) != hipSuccess) { fprintf(stderr, "kernel_launch: hipFuncSetAttribute failed\n"); grid = -1; return; }
        if (hipOccupancyMaxActiveBlocksPerMultiprocessor(&per_cu, (const void*)mega, NWAVES * 64, LDS_BYTES) != hipSuccess || per_cu < 1) { fprintf(stderr, "kernel_launch: occupancy query says %d blocks per CU\n", per_cu); per_cu = 1; }
        (void)hipGetLastError();
        grid = cus;
        if (grid != 256) fprintf(stderr, "kernel_launch: note: %d CUs (tuned for 256)\n", grid);
    }
    if (grid < 0) return;
    (void)hipMemsetAsync((char*)d_ws + WS_CTL, 0, CTL_ZERO_BYTES, stream);
    Args a{};
    for (int i = 0; i < 15; ++i) a.in[i] = (const float*)d_in[i];
    a.out = (float*)d_out; a.ws = (unsigned char*)d_ws;
    unsigned char* ws = (unsigned char*)d_ws;
    bf16* QB = (bf16*)(ws + WS_QB); bf16* KB = (bf16*)(ws + WS_KB); bf16* VB = (bf16*)(ws + WS_VB); bf16* AO = (bf16*)(ws + WS_AO); bf16* QP = (bf16*)(ws + WS_QP); bf16* HB = (bf16*)(ws + WS_HB);
    float* SSP0 = (float*)(ws + WS_SSP); float* SSP1 = SSP0 + 16 * T; float* SSP2 = SSP1 + 16 * T;  float* SSP3 = SSP2 + 16 * T;
    int* EID = (int*)(ws + WS_EID); float* GATE = (float*)(ws + WS_GATE);
    const unsigned char* U8 = ws + WS_U8; const unsigned char* V8 = ws + WS_V8; const float* ISU = (const float*)(ws + WS_ISU); const float* ISV = (const float*)(ws + WS_ISV);
    const bf16* SUBK = (const bf16*)(ws + WS_SUBK);
#define M(k) (1u << (k))
    launch_mega(a, (1u << PH_N) - 1u, 0, grid, stream);
#undef M
}
```

```cpp
#include <hip/hip_runtime.h>
#include <cstdint>
#include <cstdio>

constexpr int D = 1024, NB = 4, S = 4096, T = NB * S;
constexpr float LOG2E = 1.4426950408889634f;
constexpr float C2 = 0.125f * LOG2E;

constexpr size_t MiB = 1u << 20;
constexpr size_t WS_CTL = 0, CTL_ZERO_BYTES = 1 * MiB;
constexpr size_t WS_WQKV0 = 2 * MiB, WS_WO0 = 8 * MiB, WS_WQKV1 = 10 * MiB, WS_WO1 = 13 * MiB, WS_WPQ0 = 15 * MiB, WS_WPQ1 = 19 * MiB;
constexpr size_t WS_SUBK = 23 * MiB;
constexpr size_t WS_ISU = 24 * MiB;
constexpr size_t WS_ISV = WS_ISU + 2 * 16384 * 4;
constexpr size_t WS_SSP = 25 * MiB;
constexpr size_t WS_U8 = 32 * MiB, WS_V8 = 64 * MiB;
constexpr size_t WS_HB = 96 * MiB;
constexpr size_t WS_QB = 128 * MiB, WS_KB = 160 * MiB, WS_VB = 192 * MiB;
constexpr size_t WS_AO = 224 * MiB;
constexpr size_t WS_QP = 256 * MiB;
constexpr size_t WS_EID = 320 * MiB, WS_GATE = 328 * MiB;
constexpr size_t WS_HP = 336 * MiB;
constexpr size_t WS_COEF = 400 * MiB;
constexpr size_t WS_END = 408 * MiB;
namespace pg8 {
#define PG8_LAS __attribute__((address_space(3)))
typedef unsigned short bf16_t;
typedef short bf16x8 __attribute__((ext_vector_type(8)));
typedef float f32x4 __attribute__((ext_vector_type(4)));
typedef unsigned u32x4 __attribute__((ext_vector_type(4)));
constexpr int BM = 256, BK = 64, HALF = 128, HTB = HALF * BK * 2  , STAGE_BYTES = 8 * HTB, NXCD = 8, WGM = 8;

__host__ __device__ __forceinline__ int lds_byte(int r, int c) { const int st = (r >> 4) * 2 + (c >> 5), rr = r & 15, cc = c & 31, ob = rr * 64 + cc * 2; return st * 1024 + (ob ^ (((ob >> 9) & 1) << 5)); }
__host__ __device__ __forceinline__ void stage_rc(int b, int& R, int& C) { const int st = b / 1024, sb = b % 1024, swz = sb ^ (((sb >> 9) & 1) << 5); R = (st >> 1) * 16 + swz / 64; C = (st & 1) * 32 + (swz % 64) / 2; }
__host__ __device__ __forceinline__ int perm32(int rho) { const int n = rho >> 4, i = rho & 15; return 8 * (i >> 2) + 4 * n + (i & 3); }

struct Unit { int pm, pn; };
struct Gemm { const bf16_t* A; const bf16_t* Bt; int M, N, K; };

struct StaticOrder {
    int nM, nN, nwg, G, c;
    __host__ __device__ void init(int M, int N, int G_, int c_) { nM = M / BM; nN = N / BM; nwg = nM * nN; G = G_; c = c_; }
    __host__ __device__ bool next(int i, Unit& u) const {
        const long L = (long)i * G + c; if (L >= nwg) return false;
        int wgid = (int)L; { const int q = nwg / NXCD, r = nwg % NXCD, xcd = wgid % NXCD, off = wgid / NXCD; wgid = (xcd < r ? xcd * (q + 1) : r * (q + 1) + (xcd - r) * q) + off; }
        const int nig = WGM * nN, gid = wgid / nig, fm = gid * WGM, gsz = (nM - fm) < WGM ? (nM - fm) : WGM;
        u.pm = fm + ((wgid % nig) % gsz); u.pn = (wgid % nig) / gsz; return true;
    }
    __device__ __forceinline__ void a_ready(const Unit&) const {}
    __device__ __forceinline__ void done(const Unit&) const {}
};


__device__ __forceinline__ unsigned cvt_pk_bf16(float lo, float hi) { unsigned r; asm volatile("v_cvt_pk_bf16_f32 %0, %1, %2" : "=v"(r) : "v"(lo), "v"(hi)); return r; }

struct EpiScaleBf16 {
    static constexpr bool PERM = true, AFTER_DRAIN = false;
    bf16_t* O; int ldc; int split_cols; size_t split_stride; float scale0; const PG8_LAS float* rs;
    __device__ __forceinline__ void operator()(const f32x4 (&acc)[2][2][4][2], const Unit& u, int ui, int wr, int wc, int fr, int fq) const {
        const int row0 = u.pm * BM + wr * 64 + fr; int colt = u.pn * BM; bf16_t* base = O;
        float sc = 1.f; if (split_cols) { const int t = colt / split_cols; base += (size_t)t * split_stride; colt -= t * split_cols; if (t == 0) sc = scale0; }
        const int col0 = colt + wc * 32 + 8 * fq;
        const PG8_LAS float* rsu = rs + (ui & 3) * 256 + wr * 64 + fr;
#pragma unroll
        for (int ai = 0; ai < 2; ++ai)
#pragma unroll
            for (int m = 0; m < 4; ++m) { bf16_t* rowp = base + (size_t)(row0 + ai * HALF + m * 16) * ldc + col0; const float s = rsu[ai * HALF + m * 16] * sc;
#pragma unroll
                for (int bj = 0; bj < 2; ++bj) { const f32x4 v0 = acc[ai][bj][m][0] * s, v1 = acc[ai][bj][m][1] * s;
                    u32x4 w; w.x = cvt_pk_bf16(v0[0], v0[1]); w.y = cvt_pk_bf16(v0[2], v0[3]); w.z = cvt_pk_bf16(v1[0], v1[1]); w.w = cvt_pk_bf16(v1[2], v1[3]);
                    *(u32x4*)(rowp + bj * HALF) = w; } }
    }
};
struct EpiResid {
    static constexpr bool PERM = true, AFTER_DRAIN = false;
    const float* resid; float* out; bf16_t* hb; float* ssp; int nrows;
    __device__ __forceinline__ void operator()(const f32x4 (&acc)[2][2][4][2], const Unit& u, int ui, int wr, int wc, int fr, int fq) const {
        const int col0 = u.pn * BM + wc * 32 + 8 * fq;
#pragma unroll
        for (int ai = 0; ai < 2; ++ai)
#pragma unroll
            for (int m = 0; m < 4; ++m) { const int row = u.pm * BM + ai * HALF + wr * 64 + m * 16 + fr; const size_t off = (size_t)row * 1024 + col0; float ss = 0.f;
#pragma unroll
                for (int bj = 0; bj < 2; ++bj) { const f32x4 r0 = *(const f32x4*)(resid + off + bj * HALF), r1 = *(const f32x4*)(resid + off + bj * HALF + 4);
                    const f32x4 v0 = acc[ai][bj][m][0] + r0, v1 = acc[ai][bj][m][1] + r1;
                    *(f32x4*)(out + off + bj * HALF) = v0; *(f32x4*)(out + off + bj * HALF + 4) = v1;
                    ss += (v0[0] * v0[0] + v0[1] * v0[1]) + (v0[2] * v0[2] + v0[3] * v0[3]) + (v1[0] * v1[0] + v1[1] * v1[1]) + (v1[2] * v1[2] + v1[3] * v1[3]);
                    u32x4 w; w.x = cvt_pk_bf16(v0[0], v0[1]); w.y = cvt_pk_bf16(v0[2], v0[3]); w.z = cvt_pk_bf16(v1[0], v1[1]); w.w = cvt_pk_bf16(v1[2], v1[3]);
                    *(u32x4*)(hb + off + bj * HALF) = w; }
                ss += __shfl_xor(ss, 16); ss += __shfl_xor(ss, 32);
                if (fq == 0) ssp[(size_t)(u.pn * 4 + wc) * nrows + row] = ss;
                asm volatile("" ::: "memory"); }
    }
};
template <class Epi, class Sched, bool ALIGN_EPI = false, bool SP2 = false>
__device__ __forceinline__ void gemm_phase(PG8_LAS unsigned char* lds, const Gemm g, const Sched& S, const Epi& E) {
    const int tid = threadIdx.x, wid = __builtin_amdgcn_readfirstlane(tid >> 6), lane = tid & 63, wr = wid >> 2, wc = wid & 3, fr = lane & 15, fq = lane >> 4;
    const int K = g.K, nt = K / BK;
    unsigned voffA[2], voffB[2];
#pragma unroll
    for (int i = 0; i < 2; ++i) { int R, C; stage_rc(tid * 16 + i * 8192, R, C); const int Rb = Epi::PERM ? ((R & ~31) + perm32(R & 31)) : R;
        voffA[i] = (unsigned)(R * K + C) * 2u; voffB[i] = (unsigned)(Rb * K + C) * 2u; }
    const size_t kstep = (size_t)(BK * 2);
    const size_t hstep = (size_t)HALF * K * 2;
    const size_t tstep = 2 * hstep;
    const unsigned ldsw = (unsigned)wid * 1024u;
    const int aoff = lds_byte(wr * 64 + fr, fq * 8), boff = lds_byte(wc * 32 + fr, fq * 8);
#define PG8_SA(b, h) (((b) * 2 + (h)) * HTB)
#define PG8_SB(b, h) ((4 + (b) * 2 + (h)) * HTB)
#define PG8_STAGE(bufoff, gbase, voff) do { _Pragma("unroll") for (int _i = 0; _i < 2; ++_i) \
        __builtin_amdgcn_global_load_lds((const unsigned*)((const char*)(gbase) + (voff)[_i]), (PG8_LAS unsigned*)(lds + (bufoff) + ldsw + _i * 8192), 16, 0, 0); } while (0)
#define PG8_LDA(dst, b, h) do { _Pragma("unroll") for (int m = 0; m < 4; ++m) _Pragma("unroll") for (int k = 0; k < 2; ++k) dst[m][k] = *(const PG8_LAS bf16x8*)(lds + PG8_SA(b, h) + aoff + m * 2048 + k * 1024); } while (0)
#define PG8_LDB(dst, b, h) do { _Pragma("unroll") for (int n = 0; n < 2; ++n) _Pragma("unroll") for (int k = 0; k < 2; ++k) dst[n][k] = *(const PG8_LAS bf16x8*)(lds + PG8_SB(b, h) + boff + n * 2048 + k * 1024); } while (0)
#define PG8_MMA(ai, bj, At, Bt) do { __builtin_amdgcn_s_setprio(1); _Pragma("unroll") for (int m = 0; m < 4; ++m) _Pragma("unroll") for (int n = 0; n < 2; ++n) _Pragma("unroll") for (int k = 0; k < 2; ++k) \
        acc[ai][bj][m][n] = __builtin_amdgcn_mfma_f32_16x16x32_bf16(Bt[n][k], At[m][k], acc[ai][bj][m][n], 0, 0, 0); __builtin_amdgcn_s_setprio(0); } while (0)
#define PG8_WAIT_V(n) asm volatile("s_waitcnt vmcnt(" #n ")" ::: "memory")
#define PG8_WAIT_L(n) asm volatile("s_waitcnt lgkmcnt(" #n ")" ::: "memory")
#define PG8_BAR __builtin_amdgcn_s_barrier()
#define PG8_SCHED __builtin_amdgcn_sched_barrier(0)
    Unit cur, nxt; int ui = 0;
    if (!S.next(0, cur)) return;
    f32x4 acc[2][2][4][2];
#pragma unroll
    for (int a = 0; a < 2; ++a)
#pragma unroll
        for (int b = 0; b < 2; ++b)
#pragma unroll
            for (int m = 0; m < 4; ++m)
#pragma unroll
                for (int n = 0; n < 2; ++n) acc[a][b][m][n] = (f32x4){0.f, 0.f, 0.f, 0.f};
    bf16x8 At[4][2], B0[2][2], B1[2][2];
    const char* cA = (const char*)g.A + (size_t)cur.pm * tstep; const char* cB = (const char*)g.Bt + (size_t)cur.pn * tstep;
    S.a_ready(cur);
    if constexpr (SP2) {
        PG8_STAGE(PG8_SB(0, 0), cB, voffB); PG8_STAGE(PG8_SB(0, 1), cB + hstep, voffB); PG8_STAGE(PG8_SA(0, 0), cA, voffA); PG8_STAGE(PG8_SA(0, 1), cA + hstep, voffA);
        if (wr == 1) PG8_BAR;
        PG8_WAIT_V(2); PG8_BAR;
        PG8_STAGE(PG8_SB(1, 0), cB + kstep, voffB); PG8_STAGE(PG8_SA(1, 0), cA + kstep, voffA); PG8_STAGE(PG8_SB(1, 1), cB + hstep + kstep, voffB);
        PG8_WAIT_V(6); PG8_BAR;
    } else {
        PG8_STAGE(PG8_SB(0, 0), cB, voffB); PG8_STAGE(PG8_SA(0, 0), cA, voffA); PG8_STAGE(PG8_SB(0, 1), cB + hstep, voffB); PG8_STAGE(PG8_SA(0, 1), cA + hstep, voffA);
        if (wr == 1) PG8_BAR;
        PG8_WAIT_V(4); PG8_BAR;
        PG8_STAGE(PG8_SB(1, 0), cB + kstep, voffB); PG8_STAGE(PG8_SA(1, 0), cA + kstep, voffA); PG8_STAGE(PG8_SB(1, 1), cB + hstep + kstep, voffB);
        PG8_WAIT_V(6); PG8_BAR;
    }
    for (;;) {
        const bool has_next = S.next(ui + 1, nxt);
        const char* nA = has_next ? (const char*)g.A + (size_t)nxt.pm * tstep : cA; const char* nB = has_next ? (const char*)g.Bt + (size_t)nxt.pn * tstep : cB;
        for (int t = 0; t < nt; t += 2) {
            const bool last = (t == nt - 2);
            const char* a1 = cA + (size_t)(t + 1) * kstep;
            const char* a2 = last ? nA : cA + (size_t)(t + 2) * kstep; const char* b2 = last ? nB : cB + (size_t)(t + 2) * kstep;
            const char* a3 = a2 + kstep; const char* b3 = b2 + kstep;
            if (last && has_next) S.a_ready(nxt);
            if constexpr (SP2) {
            PG8_LDB(B0, 0, 0); PG8_LDB(B1, 0, 1); PG8_SCHED; PG8_LDA(At, 0, 0); PG8_STAGE(PG8_SA(1, 1), a1 + hstep, voffA);
            PG8_WAIT_V(8); PG8_WAIT_L(0); PG8_BAR; PG8_MMA(0, 0, At, B0); PG8_MMA(0, 1, At, B1); PG8_BAR; PG8_SCHED;
            PG8_LDA(At, 0, 1); PG8_STAGE(PG8_SB(0, 0), b2, voffB); PG8_STAGE(PG8_SB(0, 1), b2 + hstep, voffB); PG8_STAGE(PG8_SA(0, 0), a2, voffA);
            PG8_WAIT_V(8); PG8_WAIT_L(0); PG8_BAR; PG8_MMA(1, 0, At, B0); PG8_MMA(1, 1, At, B1); PG8_BAR; PG8_SCHED;
            PG8_LDB(B0, 1, 0); PG8_LDB(B1, 1, 1); PG8_SCHED; PG8_LDA(At, 1, 0); PG8_STAGE(PG8_SA(0, 1), a2 + hstep, voffA);
            PG8_WAIT_V(8); PG8_WAIT_L(0); PG8_BAR; PG8_MMA(0, 0, At, B0); PG8_MMA(0, 1, At, B1); PG8_BAR; PG8_SCHED;
            PG8_LDA(At, 1, 1); PG8_STAGE(PG8_SB(1, 0), b3, voffB); PG8_STAGE(PG8_SB(1, 1), b3 + hstep, voffB); PG8_STAGE(PG8_SA(1, 0), a3, voffA);
            PG8_WAIT_V(8); PG8_WAIT_L(0); PG8_BAR; PG8_MMA(1, 0, At, B0); PG8_MMA(1, 1, At, B1); PG8_BAR; PG8_SCHED;
            } else {
            PG8_LDB(B0, 0, 0); PG8_SCHED; PG8_LDA(At, 0, 0); PG8_STAGE(PG8_SA(1, 1), a1 + hstep, voffA);
            PG8_WAIT_L(8); PG8_BAR; PG8_WAIT_L(0); PG8_MMA(0, 0, At, B0); PG8_BAR; PG8_SCHED;
            PG8_LDB(B1, 0, 1); PG8_STAGE(PG8_SB(0, 0), b2, voffB);
            PG8_BAR; PG8_WAIT_L(0); PG8_MMA(0, 1, At, B1); PG8_BAR;
            PG8_LDA(At, 0, 1); PG8_STAGE(PG8_SA(0, 0), a2, voffA);
            PG8_BAR; PG8_WAIT_L(0); PG8_MMA(1, 0, At, B0); PG8_BAR; PG8_SCHED;
            PG8_STAGE(PG8_SB(0, 1), b2 + hstep, voffB);
            PG8_WAIT_V(6); PG8_BAR; PG8_MMA(1, 1, At, B1); PG8_BAR;
            PG8_LDB(B0, 1, 0); PG8_SCHED; PG8_LDA(At, 1, 0); PG8_STAGE(PG8_SA(0, 1), a2 + hstep, voffA);
            PG8_WAIT_L(8); PG8_BAR; PG8_WAIT_L(0); PG8_MMA(0, 0, At, B0); PG8_BAR; PG8_SCHED;
            PG8_LDB(B1, 1, 1); PG8_STAGE(PG8_SB(1, 0), b3, voffB);
            PG8_BAR; PG8_WAIT_L(0); PG8_MMA(0, 1, At, B1); PG8_BAR;
            PG8_LDA(At, 1, 1); PG8_STAGE(PG8_SA(1, 0), a3, voffA);
            PG8_BAR; PG8_WAIT_L(0); PG8_MMA(1, 0, At, B0); PG8_BAR; PG8_SCHED;
            PG8_STAGE(PG8_SB(1, 1), b3 + hstep, voffB);
            PG8_WAIT_V(6); PG8_BAR; PG8_MMA(1, 1, At, B1); PG8_BAR;
            }
        }
        if constexpr (ALIGN_EPI) { if (wr == 0) PG8_BAR; }
        if constexpr (!Epi::AFTER_DRAIN) { E(acc, cur, ui, wr, wc, fr, fq); S.done(cur); }
        if (!has_next) break;
#pragma unroll
        for (int a = 0; a < 2; ++a)
#pragma unroll
            for (int b = 0; b < 2; ++b)
#pragma unroll
                for (int m = 0; m < 4; ++m)
#pragma unroll
                    for (int n = 0; n < 2; ++n) acc[a][b][m][n] = (f32x4){0.f, 0.f, 0.f, 0.f};
        cur = nxt; cA = nA; cB = nB; ++ui;
        if constexpr (ALIGN_EPI) { if (wr == 1) PG8_BAR; }
    }
    PG8_WAIT_V(0);
    if constexpr (!ALIGN_EPI) { if (wr == 0) PG8_BAR; }
    PG8_BAR;
    if constexpr (Epi::AFTER_DRAIN) { E.fused(acc, cur, wr, wc, fr, fq, lds, wid, lane); S.done(cur); }
#undef PG8_SA
#undef PG8_SB
#undef PG8_STAGE
#undef PG8_LDA
#undef PG8_LDB
#undef PG8_MMA
#undef PG8_WAIT_V
#undef PG8_WAIT_L
#undef PG8_BAR
#undef PG8_SCHED
}
}

#define GAS __attribute__((address_space(1)))
#define LAS __attribute__((address_space(3)))
typedef unsigned short bf16;
typedef unsigned v4u __attribute__((ext_vector_type(4)));
typedef float f32x4 __attribute__((ext_vector_type(4)));
typedef float f32x2 __attribute__((ext_vector_type(2)));
typedef float f32x16 __attribute__((ext_vector_type(16)));
typedef short bf16x8 __attribute__((ext_vector_type(8)));
typedef GAS unsigned gu32;
#define RLX_AGENT __ATOMIC_RELAXED, __HIP_MEMORY_SCOPE_AGENT
#define LDS_WAIT() asm volatile("s_waitcnt lgkmcnt(0)" ::: "memory")
#define VM_WAIT() asm volatile("s_waitcnt vmcnt(0)" ::: "memory")
__device__ __forceinline__ unsigned f2bf(float f) { unsigned u = __builtin_bit_cast(unsigned, f); return (u + 0x7fffu + ((u >> 16) & 1u)) >> 16; }
__device__ __forceinline__ unsigned pk2(float lo, float hi) { return f2bf(lo) | (f2bf(hi) << 16); }
__device__ __forceinline__ float bf2f(unsigned short b) { return __builtin_bit_cast(float, (unsigned)b << 16); }
__device__ __forceinline__ float bflo(unsigned w) { return __builtin_bit_cast(float, w << 16); }
__device__ __forceinline__ float bfhi(unsigned w) { return __builtin_bit_cast(float, w & 0xffff0000u); }
__device__ __forceinline__ float wave_sum(float v) {
#pragma unroll
    for (int o = 1; o < 64; o <<= 1) v += __shfl_xor(v, o);
    return v;
}
__device__ __forceinline__ float wave_max(float v) {
#pragma unroll
    for (int o = 1; o < 64; o <<= 1) v = fmaxf(v, __shfl_xor(v, o));
    return v;
}

#define XB_TMO      128
#define XB_XCNT(j)  (256  + 64 * (j))
#define XB_XSUB(j)  (1280 + 64 * (j))
#define XB_XGEN(j)  (2304 + 64 * (j))
#define XB_TOP      3328
#define XB_TOPGEN   3392
#define XCD_BAR_WORDS 3456
#define XB_SPIN_CAP (1u << 18)

__device__ __forceinline__ unsigned xb_ld(unsigned* p)              { return __hip_atomic_load(p, __ATOMIC_RELAXED, __HIP_MEMORY_SCOPE_AGENT); }
__device__ __forceinline__ unsigned xb_add(unsigned* p, unsigned v) { return __hip_atomic_fetch_add(p, v, __ATOMIC_RELAXED, __HIP_MEMORY_SCOPE_AGENT); }
__device__ __forceinline__ unsigned xb_xcc_id() { return (unsigned)__builtin_amdgcn_s_getreg((3 << 11) | 20) & 0xFu; }
#define XB_SPIN(cond, bar) do { unsigned _sp = 0; while (cond) { __builtin_amdgcn_s_sleep(1); \
    if ((++_sp & 255u) == 0u) { if (xb_ld(&(bar)[XB_TMO])) break; if (_sp > XB_SPIN_CAP) { atomicAdd(&(bar)[XB_TMO], 1u); break; } } } } while (0)

struct XcdBarrier {
    unsigned* bar; unsigned x;
    volatile LAS unsigned* st;
};

__device__ __forceinline__ XcdBarrier xcd_barrier_post(unsigned* bar, volatile LAS unsigned* st) {
    XcdBarrier b; b.bar = bar; b.x = xb_xcc_id(); b.st = st;
    if (threadIdx.x == 0) (void)xb_add(&bar[XB_XCNT(b.x)], 1u);
    return b;
}
__device__ __forceinline__ void xcd_barrier_complete(unsigned* bar, unsigned x, unsigned& nloc, unsigned& nx) {
    const unsigned G = gridDim.x * gridDim.y * gridDim.z;
    unsigned sum, cnt, mine, sp = 0u;
    for (;;) {
        sum = 0u; cnt = 0u; mine = 0u;
#pragma unroll
        for (unsigned j = 0; j < 16; ++j) { const unsigned c = xb_ld(&bar[XB_XCNT(j)]); sum += c; cnt += (c > 0u) ? 1u : 0u; mine = (j == x) ? c : mine; }
        if (sum == G) break;
        __builtin_amdgcn_s_sleep(1);
        if ((++sp & 255u) == 0u) { if (xb_ld(&bar[XB_TMO])) break; if (sp > XB_SPIN_CAP) { atomicAdd(&bar[XB_TMO], 1u); break; } }
    }
    nloc = mine > 0u ? mine : 1u; nx = cnt > 0u ? cnt : 1u;
}

__device__ __forceinline__ void xcd_barrier(const XcdBarrier& b) {
    asm volatile("s_waitcnt vmcnt(0)" ::: "memory");
    __syncthreads();
    if (threadIdx.x == 0) {
        unsigned* bar = b.bar;
        __builtin_amdgcn_s_waitcnt(0);
        unsigned nloc = b.st[0], nx = b.st[1];
        if (nloc == 0u) { xcd_barrier_complete(bar, b.x, nloc, nx); b.st[0] = nloc; b.st[1] = nx; }
        const unsigned old = xb_add(&bar[XB_XSUB(b.x)], 1u);
        const unsigned gen = old / nloc;
        if (old + 1u == (gen + 1u) * nloc) {
            __builtin_amdgcn_fence(__ATOMIC_RELEASE, "agent");
            asm volatile("s_waitcnt vmcnt(0)" ::: "memory");
            const unsigned og = xb_add(&bar[XB_TOP], 1u);
            const unsigned tg = og / nx;
            if (og + 1u == (tg + 1u) * nx) xb_add(&bar[XB_TOPGEN], 1u);
            else XB_SPIN(xb_ld(&bar[XB_TOPGEN]) == tg, bar);
            __builtin_amdgcn_fence(__ATOMIC_ACQUIRE, "agent");
            xb_add(&bar[XB_XGEN(b.x)], 1u);
            asm volatile("s_waitcnt vmcnt(0)" ::: "memory");
        } else {
            XB_SPIN(xb_ld(&bar[XB_XGEN(b.x)]) == gen, bar);
            __builtin_amdgcn_fence(__ATOMIC_ACQUIRE, "agent");
            asm volatile("s_waitcnt vmcnt(0)" ::: "memory");
        }
    }
    __syncthreads();
}

constexpr int NWAVES = 8;
constexpr int RING_BYTES = 131072;
constexpr int RS_OFF = RING_BYTES;
constexpr int MISC_OFF = RS_OFF + 4096;
constexpr int LDS_BYTES = 147456;
constexpr int CW_BAR = 4096;

struct Args { const float* in[15]; float* out; unsigned char* ws; unsigned mask; int li; unsigned rep; int pad; };

__device__ __forceinline__ void p0_transpose_item(const float* W, const float* gain, int K, int N, bf16* WT, LAS float* scr, int item, int lane) {
    const int nblk = N / 32, kb = item / nblk, nb = item % nblk, k0 = 64 * kb, n0 = 32 * nb;
#pragma unroll 8
    for (int i = 0; i < 32; ++i) { const int kk = 2 * i + (lane >> 5); float w = W[(size_t)(k0 + kk) * N + n0 + (lane & 31)]; if (gain) w *= gain[k0 + kk]; scr[kk * 33 + (lane & 31)] = w; }
    LDS_WAIT(); asm volatile("" ::: "memory");
    const int c = lane & 7;
#pragma unroll
    for (int j = 0; j < 4; ++j) { const int n = (lane >> 3) + 8 * j; const LAS float* s = scr + (8 * c) * 33 + n;
        v4u o; o.x = pk2(s[0 * 33], s[1 * 33]); o.y = pk2(s[2 * 33], s[3 * 33]); o.z = pk2(s[4 * 33], s[5 * 33]); o.w = pk2(s[6 * 33], s[7 * 33]);
        *(v4u*)(WT + (size_t)(n0 + n) * K + k0 + 8 * c) = o; }
    LDS_WAIT(); asm volatile("" ::: "memory");
}
template <int NR> __device__ __forceinline__ void conv_rows_fp8(const float* src, const float* gain, unsigned char* dst, float* inv_scale, int lane) {
    f32x4 v[NR][4]; float am[NR];
#pragma unroll
    for (int i = 0; i < NR; ++i)
#pragma unroll
        for (int j = 0; j < 4; ++j) v[i][j] = *(const f32x4*)(src + (size_t)i * 1024 + lane * 16 + 4 * j);
#pragma unroll
    for (int i = 0; i < NR; ++i) { am[i] = 0.f;
#pragma unroll
        for (int j = 0; j < 4; ++j) { if (gain) v[i][j] = v[i][j] * *(const f32x4*)(gain + lane * 16 + 4 * j);
            am[i] = fmaxf(am[i], fmaxf(fmaxf(fabsf(v[i][j][0]), fabsf(v[i][j][1])), fmaxf(fabsf(v[i][j][2]), fabsf(v[i][j][3])))); } }
#pragma unroll
    for (int o = 1; o < 64; o <<= 1)
#pragma unroll
        for (int i = 0; i < NR; ++i) am[i] = fmaxf(am[i], __shfl_xor(am[i], o));
#pragma unroll
    for (int i = 0; i < NR; ++i) {
        const float sc = am[i] > 0.f ? 224.f / am[i] : 1.f;
        v4u o;
#pragma unroll
        for (int j = 0; j < 4; ++j) { int w = __builtin_amdgcn_cvt_pk_fp8_f32(v[i][j][0] * sc, v[i][j][1] * sc, 0, false); w = __builtin_amdgcn_cvt_pk_fp8_f32(v[i][j][2] * sc, v[i][j][3] * sc, w, true); o[j] = (unsigned)w; }
        *(v4u*)(dst + (size_t)i * 1024 + lane * 16) = o;
        if (lane == 0) inv_scale[i] = am[i] > 0.f ? am[i] * (1.f / 224.f) : 1.f;
    }
}
__device__ __forceinline__ void phase_prep(const Args& a, LAS unsigned char* lds, int gw, int NGW, int wave, int lane) {
    LAS float* scr = (LAS float*)(lds + wave * 16384);
    unsigned char* ws = a.ws;
    constexpr int I0 = 16 * (3072 / 32), I1 = 16 * (1024 / 32), I2 = 16 * (1536 / 32), I3 = I1, I4 = 16 * (2048 / 32), I5 = I4;
    constexpr int NIT = I0 + I1 + I2 + I3 + I4 + I5;
    for (int it = gw; it < NIT; it += NGW) {
        int r = it;
        if (r < I0) { p0_transpose_item(a.in[2], a.in[1], 1024, 3072, (bf16*)(ws + WS_WQKV0), scr, r, lane); continue; } r -= I0;
        if (r < I1) { p0_transpose_item(a.in[3], nullptr, 1024, 1024, (bf16*)(ws + WS_WO0), scr, r, lane); continue; } r -= I1;
        if (r < I2) { p0_transpose_item(a.in[5], a.in[4], 1024, 1536, (bf16*)(ws + WS_WQKV1), scr, r, lane); continue; } r -= I2;
        if (r < I3) { p0_transpose_item(a.in[9], nullptr, 1024, 1024, (bf16*)(ws + WS_WO1), scr, r, lane); continue; } r -= I3;
        if (r < I4) { p0_transpose_item(a.in[11], a.in[10], 1024, 2048, (bf16*)(ws + WS_WPQ0), scr, r, lane); continue; } r -= I4;
        p0_transpose_item(a.in[11] + (size_t)1024 * 2048, a.in[10] + 1024, 1024, 2048, (bf16*)(ws + WS_WPQ1), scr, r, lane);
    }
    for (int it = gw; it < 1024; it += NGW) {
        const float* s = a.in[12] + (size_t)it * 512 + lane * 8; const f32x4 a0 = *(const f32x4*)s, a1 = *(const f32x4*)(s + 4);
        v4u o; o.x = pk2(a0[0], a0[1]); o.y = pk2(a0[2], a0[3]); o.z = pk2(a1[0], a1[1]); o.w = pk2(a1[2], a1[3]);
        *(v4u*)((bf16*)(ws + WS_SUBK) + (size_t)it * 512 + lane * 8) = o;
    }
    for (int r4 = gw; r4 < 16384; r4 += NGW) {
        const int r = r4 * 4, tb = r >> 15, row = r & 32767;
        const float* src = (tb ? a.in[14] : a.in[13]) + (size_t)row * 1024;
        const float* gain = tb ? nullptr : a.in[10] + (row >> 14) * 1024;
        conv_rows_fp8<4>(src, gain, ws + (tb ? WS_V8 : WS_U8) + (size_t)row * 1024, (float*)(ws + (tb ? WS_ISV : WS_ISU)) + row, lane);
    }
    for (int t2 = gw; t2 < T / 2; t2 += NGW) {
        f32x4 v[2][4]; float ss[2];
#pragma unroll
        for (int i = 0; i < 2; ++i)
#pragma unroll
            for (int j = 0; j < 4; ++j) v[i][j] = *(const f32x4*)(a.in[0] + (size_t)(2 * t2 + i) * 1024 + lane * 16 + 4 * j);
#pragma unroll
        for (int i = 0; i < 2; ++i) { ss[i] = 0.f;
#pragma unroll
            for (int j = 0; j < 4; ++j) ss[i] += (v[i][j][0] * v[i][j][0] + v[i][j][1] * v[i][j][1]) + (v[i][j][2] * v[i][j][2] + v[i][j][3] * v[i][j][3]); }
#pragma unroll
        for (int o = 1; o < 64; o <<= 1) { ss[0] += __shfl_xor(ss[0], o); ss[1] += __shfl_xor(ss[1], o); }
#pragma unroll
        for (int i = 0; i < 2; ++i) {
            v4u o0, o1; o0.x = pk2(v[i][0][0], v[i][0][1]); o0.y = pk2(v[i][0][2], v[i][0][3]); o0.z = pk2(v[i][1][0], v[i][1][1]); o0.w = pk2(v[i][1][2], v[i][1][3]);
            o1.x = pk2(v[i][2][0], v[i][2][1]); o1.y = pk2(v[i][2][2], v[i][2][3]); o1.z = pk2(v[i][3][0], v[i][3][1]); o1.w = pk2(v[i][3][2], v[i][3][3]);
            bf16* hb = (bf16*)(ws + WS_HB) + (size_t)(2 * t2 + i) * 1024 + lane * 16;
            *(v4u*)hb = o0; *(v4u*)(hb + 8) = o1;
            if (lane == 0) ((float*)(ws + WS_SSP))[2 * t2 + i] = ss[i];
        }
    }
}
template <class Sched> __device__ __forceinline__ void fill_rs(LAS float* rs, const Sched& So, const float* ssp, int np, int tid) {
    pg8::Unit u;
    for (int ui = 0; ui < 4 && So.next(ui, u); ++ui) {
        if (tid < 256) { const int row = u.pm * 256 + tid; float s = 0.f; for (int p = 0; p < np; ++p) s += ssp[(size_t)p * T + row]; rs[ui * 256 + tid] = rsqrtf(s * (1.f / 1024.f) + 1e-6f); }
    }
    __syncthreads();
}

namespace nv {
__device__ __forceinline__ float softplus(float z) { return fmaxf(z, 0.f) + log1pf(expf(-fabsf(z))); }
__device__ __forceinline__ float gelu_tanh(float x) { const float k = 0.7978845608028654f; return 0.5f * x * (1.f + tanhf(k * (x + 0.044715f * x * x * x))); }

__global__ void __launch_bounds__(256) k_sb_attn_b(const bf16* __restrict__ Q, const bf16* __restrict__ K, const bf16* __restrict__ V, bf16* __restrict__ O) {
    __shared__ float Ks[64][65];
    __shared__ float Vs[64][65];
    __shared__ float qs[4][64];
    const int tid = threadIdx.x, w = tid >> 6, lane = tid & 63;
    const int nblk = S / 4;
    const int bh = blockIdx.x / nblk, t0 = (blockIdx.x % nblk) * 4;
    const int b = bh / 16, h = bh % 16;
    const int t = t0 + w;
    const size_t rowb = (size_t)b * S;
    qs[w][lane] = bf2f(Q[(rowb + t) * 1024 + h * 64 + lane]);
    float acc = 0.f, carry = 0.f;
    const int ntile = (t0 + 3) / 64 + 1;
    for (int tile = ntile - 1; tile >= 0; --tile) {
        const int s0 = tile * 64;
        __syncthreads();
#pragma unroll
        for (int i = 0; i < 16; ++i) {
            const int idx = tid + 256 * i, r = idx >> 6, d = idx & 63;
            const size_t g = (rowb + s0 + r) * 1024 + h * 64 + d;
            Ks[r][d] = bf2f(K[g]); Vs[r][d] = bf2f(V[g]);
        }
        __syncthreads();
        float z = 0.f;
#pragma unroll 16
        for (int d = 0; d < 64; ++d) z = fmaf(qs[w][d], Ks[lane][d], z);
        z *= 0.6931471805599453f;
        const int s = s0 + lane;
        const bool valid = s < t;
        const float sp = softplus(z);
        const float L = valid ? -sp : 0.f;
        float x = L;
#pragma unroll
        for (int off = 1; off < 64; off <<= 1) { const float y = __shfl_down(x, off); if (lane + off < 64) x += y; }
        const float excl = x - L;
        const float total = __shfl(x, 0);
        const float log_a = (z - sp) + carry + excl;
        const float a = valid ? expf(log_a) : 0.f;
        carry += total;
#pragma unroll 16
        for (int j = 0; j < 64; ++j) acc = fmaf(__shfl(a, j), Vs[j][lane], acc);
    }
    O[(rowb + t) * 1024 + h * 64 + lane] = (bf16)f2bf(acc);
}

__global__ void __launch_bounds__(256) k_sw_attn_b(const bf16* __restrict__ qkv, const float* __restrict__ qg, const float* __restrict__ kg,
                                                   const float* __restrict__ sinks, bf16* __restrict__ O) {
    __shared__ float sc[4][128];
    const int tid = threadIdx.x, w = tid >> 6, lane = tid & 63;
    const int gw = blockIdx.x * 4 + w;
    const int h = gw & 15, bt = gw >> 4, t = bt % S, b = bt / S;
    const int kvh = h >> 2;
    const size_t rowb = (size_t)b * S;
    float q = bf2f(qkv[(rowb + t) * 1536 + h * 64 + lane]);
    { const float ss = wave_sum(q * q); q = q * rsqrtf(ss * (1.f / 64.f) + 1e-6f) * qg[lane]; }
    const float kgl = kg[lane];
    const float slope = exp2f(-8.f * (float)(h + 1) / 16.f);
    const int slo = (t - 127) > 0 ? (t - 127) : 0;
    const int nk = t - slo + 1;
    for (int i = 0; i < nk; ++i) {
        const int s = slo + i;
        float kd = bf2f(qkv[(rowb + s) * 1536 + 1024 + kvh * 64 + lane]);
        const float ss = wave_sum(kd * kd);
        kd = kd * rsqrtf(ss * (1.f / 64.f) + 1e-6f) * kgl;
        const float dot = wave_sum(q * kd);
        if (lane == 0) sc[w][i] = dot * 0.125f - slope * (float)(t - s);
    }
    __syncthreads();
    const float sink = sinks[h];
    float m = sink;
    for (int i = lane; i < nk; i += 64) m = fmaxf(m, sc[w][i]);
    m = wave_max(m);
    float den = 0.f;
    for (int i = lane; i < nk; i += 64) { const float p = expf(sc[w][i] - m); sc[w][i] = p; den += p; }
    den = wave_sum(den) + expf(sink - m);
    __syncthreads();
    const float inv = 1.f / den;
    float acc = 0.f;
    for (int i = 0; i < nk; ++i) acc = fmaf(sc[w][i] * inv, bf2f(qkv[(rowb + slo + i) * 1536 + 1280 + kvh * 64 + lane]), acc);
    O[(rowb + t) * 1024 + h * 64 + lane] = (bf16)f2bf(acc);
}

__global__ void __launch_bounds__(256) k_peer_topk_b(const bf16* __restrict__ qp, const bf16* __restrict__ subk, int* __restrict__ eid, float* __restrict__ gate) {
    __shared__ float qs[4][256];
    const int tid = threadIdx.x, w = tid >> 6, lane = tid & 63;
    const int gw = blockIdx.x * 4 + w;
    const int h = gw & 7, t = gw >> 3;
#pragma unroll
    for (int i = 0; i < 4; ++i) qs[w][lane + 64 * i] = bf2f(qp[(size_t)t * 2048 + h * 256 + lane + 64 * i]);
    __syncthreads();
    float ts[2]; int tii[2];
#pragma unroll
    for (int p = 0; p < 2; ++p) {
        const bf16* k0 = subk + ((size_t)(h * 2 + p) * 128 + lane) * 128;
        const bf16* k1 = k0 + 64 * 128;
        float v0 = 0.f, v1 = 0.f;
        for (int c = 0; c < 128; ++c) { const float qq = qs[w][p * 128 + c]; v0 = fmaf(qq, bf2f(k0[c]), v0); v1 = fmaf(qq, bf2f(k1[c]), v1); }
        float mys = 0.f; int myi = 0;
        for (int r = 0; r < 16; ++r) {
            float bv; int bi;
            if (v0 >= v1) { bv = v0; bi = lane; } else { bv = v1; bi = lane + 64; }
#pragma unroll
            for (int off = 1; off < 64; off <<= 1) {
                const float ov = __shfl_xor(bv, off); const int oi = __shfl_xor(bi, off);
                if (ov > bv || (ov == bv && oi < bi)) { bv = ov; bi = oi; }
            }
            if (lane == r) { mys = bv; myi = bi; }
            if (bi == lane) v0 = -INFINITY;
            if (bi == lane + 64) v1 = -INFINITY;
        }
        ts[p] = mys; tii[p] = myi;
    }
    float cv[4];
    {
        const float s0 = __shfl(ts[0], lane >> 2);
#pragma unroll
        for (int c = 0; c < 4; ++c) cv[c] = s0 + __shfl(ts[1], (lane & 3) * 4 + c);
    }
    float cs = 0.f; int cf = 0;
    for (int r = 0; r < 16; ++r) {
        float bv = cv[0]; int bi = lane * 4;
#pragma unroll
        for (int c = 1; c < 4; ++c) if (cv[c] > bv) { bv = cv[c]; bi = lane * 4 + c; }
#pragma unroll
        for (int off = 1; off < 64; off <<= 1) {
            const float ov = __shfl_xor(bv, off); const int oi = __shfl_xor(bi, off);
            if (ov > bv || (ov == bv && oi < bi)) { bv = ov; bi = oi; }
        }
        if (lane == r) { cs = bv; cf = bi; }
#pragma unroll
        for (int c = 0; c < 4; ++c) if (bi == lane * 4 + c) cv[c] = -INFINITY;
    }
    const float mval = wave_max(lane < 16 ? cs : -INFINITY);
    const float ex = lane < 16 ? expf(cs - mval) : 0.f;
    const float den = wave_sum(ex);
    const int i1 = __shfl(tii[0], (cf >> 4) & 15), i2 = __shfl(tii[1], cf & 15);
    if (lane < 16) {
        eid[(size_t)t * 128 + h * 16 + lane] = i1 * 128 + i2;
        gate[(size_t)t * 128 + h * 16 + lane] = ex / den;
    }
}

__global__ void __launch_bounds__(256) k_peer_gather_b(float* h, const float* __restrict__ ssp_in, int np, const unsigned char* __restrict__ U8, const unsigned char* __restrict__ V8,
                                                       const float* __restrict__ isu, const float* __restrict__ isv, const int* __restrict__ eid, const float* __restrict__ gate,
                                                       bf16* __restrict__ hb, float* __restrict__ ssp_out) {
    const int t = blockIdx.x * 4 + (threadIdx.x >> 6), lane = threadIdx.x & 63;
    float x[16], acc[16];
#pragma unroll
    for (int j = 0; j < 4; ++j) { const f32x4 v = *(const f32x4*)(h + (size_t)t * 1024 + lane * 16 + 4 * j); x[4 * j] = v[0]; x[4 * j + 1] = v[1]; x[4 * j + 2] = v[2]; x[4 * j + 3] = v[3]; }
#pragma unroll
    for (int j = 0; j < 16; ++j) acc[j] = 0.f;
    float ssum = 0.f; for (int p = 0; p < np; ++p) ssum += ssp_in[(size_t)p * T + t];
    const float rstd = rsqrtf(ssum * (1.f / 1024.f) + 1e-6f);
    for (int k = 0; k < 128; ++k) {
        const int e = eid[(size_t)t * 128 + k];
        const float g = gate[(size_t)t * 128 + k];
        const v4u uw = *(const v4u*)(U8 + (size_t)e * 1024 + lane * 16);
        float s = 0.f;
#pragma unroll
        for (int j = 0; j < 4; ++j) { const f32x2 a = __builtin_amdgcn_cvt_pk_f32_fp8((int)uw[j], false), c = __builtin_amdgcn_cvt_pk_f32_fp8((int)uw[j], true);
            s += a[0] * x[4 * j] + a[1] * x[4 * j + 1] + c[0] * x[4 * j + 2] + c[1] * x[4 * j + 3]; }
        s = wave_sum(s);
        const float coef = g * gelu_tanh(s * rstd * isu[e]) * isv[e];
        const v4u vw = *(const v4u*)(V8 + (size_t)e * 1024 + lane * 16);
#pragma unroll
        for (int j = 0; j < 4; ++j) { const f32x2 a = __builtin_amdgcn_cvt_pk_f32_fp8((int)vw[j], false), c = __builtin_amdgcn_cvt_pk_f32_fp8((int)vw[j], true);
            acc[4 * j] = fmaf(coef, a[0], acc[4 * j]); acc[4 * j + 1] = fmaf(coef, a[1], acc[4 * j + 1]); acc[4 * j + 2] = fmaf(coef, c[0], acc[4 * j + 2]); acc[4 * j + 3] = fmaf(coef, c[1], acc[4 * j + 3]); }
    }
    float ss = 0.f;
#pragma unroll
    for (int j = 0; j < 16; ++j) { acc[j] += x[j]; ss += acc[j] * acc[j]; }
    ss = wave_sum(ss);
#pragma unroll
    for (int j = 0; j < 4; ++j) { f32x4 o = {acc[4 * j], acc[4 * j + 1], acc[4 * j + 2], acc[4 * j + 3]}; *(f32x4*)(h + (size_t)t * 1024 + lane * 16 + 4 * j) = o; }
    v4u o0, o1; o0.x = pk2(acc[0], acc[1]); o0.y = pk2(acc[2], acc[3]); o0.z = pk2(acc[4], acc[5]); o0.w = pk2(acc[6], acc[7]);
    o1.x = pk2(acc[8], acc[9]); o1.y = pk2(acc[10], acc[11]); o1.z = pk2(acc[12], acc[13]); o1.w = pk2(acc[14], acc[15]);
    *(v4u*)(hb + (size_t)t * 1024 + lane * 16) = o0; *(v4u*)(hb + (size_t)t * 1024 + lane * 16 + 8) = o1;
    if (lane == 0) ssp_out[t] = ss;
}
}

typedef short v4i16_t __attribute__((ext_vector_type(4)));
__device__ __forceinline__ int crow(int r, int hi) { return (r & 3) + 8 * (r >> 2) + 4 * hi; }
__device__ __forceinline__ unsigned cvtpk(float lo, float hi) { typedef __bf16 bf16x2_t __attribute__((ext_vector_type(2))); f32x2 v = {lo, hi}; bf16x2_t b = __builtin_convertvector(v, bf16x2_t); return __builtin_bit_cast(unsigned, b); }
__device__ __forceinline__ bf16x8 mk8(unsigned a, unsigned b, unsigned c, unsigned d) { v4u w = {a, b, c, d}; return __builtin_bit_cast(bf16x8, w); }
__device__ __forceinline__ bf16x8 vfrag(LAS const unsigned char* p) {
    const v4i16_t lo = __builtin_amdgcn_ds_read_tr16_b64_v4i16((LAS v4i16_t*)p), hi = __builtin_amdgcn_ds_read_tr16_b64_v4i16((LAS v4i16_t*)(p + 512));
    return (bf16x8){lo[0], lo[1], lo[2], lo[3], hi[0], hi[1], hi[2], hi[3]};
}
__device__ __forceinline__ void vtile_load(v4u (&vv)[8], const bf16* vp0, int pitch, int lane) {
    const bf16* vp = vp0 + (size_t)(lane >> 3) * pitch + (lane & 7) * 8;
#pragma unroll
    for (int i = 0; i < 8; ++i) vv[i] = *(const v4u*)(vp + (size_t)i * 8 * pitch);
}
__device__ __forceinline__ void vtile_store(const v4u (&vv)[8], LAS unsigned char* wl, int lane) {
    const int c = lane & 7;
#pragma unroll
    for (int i = 0; i < 8; ++i) { const int kv = 8 * i + (lane >> 3); *(LAS v4u*)(wl + (c >> 2) * 4096 + (kv >> 4) * 1024 + (kv & 15) * 64 + (c & 3) * 16) = vv[i]; }
}
__device__ __forceinline__ void otile_store(const f32x16& o0, const f32x16& o1, LAS unsigned char* stg, bf16* Orow0, int pitch, int lane) {
    const int r32 = lane & 31, hi = lane >> 5;
    LAS unsigned short* s16 = (LAS unsigned short*)stg;
#pragma unroll
    for (int r = 0; r < 16; ++r) { const int orow = crow(r, hi); s16[orow * 64 + r32] = (unsigned short)f2bf(o0[r]); s16[orow * 64 + 32 + r32] = (unsigned short)f2bf(o1[r]); }
#pragma unroll
    for (int i = 0; i < 4; ++i) { const int row = i * 8 + (lane >> 3), ch = lane & 7; const v4u v = *(LAS const v4u*)(stg + row * 128 + ch * 16); *(v4u*)(Orow0 + (size_t)row * pitch + ch * 8) = v; }
}
#define MFMA32(A, B, C) __builtin_amdgcn_mfma_f32_32x32x16_bf16((A), (B), (C), 0, 0, 0)

__device__ __forceinline__ void sb_unit(const bf16* Q, const bf16* K, const bf16* V, bf16* O, int b, int h, int t0, LAS unsigned char* wl, int lane,
                                        const bf16x8 tri0, const bf16x8 tri1, const bf16x8 ones) {
    const int r32 = lane & 31, hi = lane >> 5;
    const size_t rowb = (size_t)b * S;
    const bf16* qp = Q + (rowb + t0 + r32) * 1024 + h * 64 + hi * 8;
    bf16x8 qf[4];
#pragma unroll
    for (int d0 = 0; d0 < 4; ++d0) qf[d0] = *(const bf16x8*)(qp + d0 * 16);
    f32x16 o0 = {}, o1 = {};
    float carry = 0.f;
    const int tdiag = t0 >> 6;
    LAS const unsigned char* vb = wl + ((lane >> 4) & 1) * 32 + (lane & 3) * 8 + (4 * hi + ((lane & 15) >> 2)) * 64;
    bf16x8 kf[8]; v4u vv[8];
#define SB_LOADK(tl) do { const bf16* kp_ = K + (rowb + (tl) * 64 + r32) * 1024 + h * 64 + hi * 8; \
        _Pragma("unroll") for (int d0 = 0; d0 < 4; ++d0) { kf[2 * d0] = *(const bf16x8*)(kp_ + d0 * 16); kf[2 * d0 + 1] = *(const bf16x8*)(kp_ + 32 * 1024 + d0 * 16); } } while (0)
    SB_LOADK(tdiag); vtile_load(vv, V + (rowb + tdiag * 64) * 1024 + h * 64, 1024, lane);
    for (int tile = tdiag; tile >= 0; --tile) {
        const int s0 = tile * 64, tn = tile > 0 ? tile - 1 : 0;
        f32x16 p0 = {}, p1 = {};
#pragma unroll
        for (int d0 = 0; d0 < 4; ++d0) { p0 = MFMA32(kf[2 * d0], qf[d0], p0); p1 = MFMA32(kf[2 * d0 + 1], qf[d0], p1); }
        SB_LOADK(tn);
        vtile_store(vv, wl, lane);
        vtile_load(vv, V + (rowb + tn * 64) * 1024 + h * 64, 1024, lane);
        const int lim = t0 + r32 - s0;
        unsigned lw[16]; float sumL = 0.f;
#pragma unroll
        for (int r = 0; r < 16; r += 2) {
            float La[2], Lb[2];
#pragma unroll
            for (int q = 0; q < 2; ++q) {
                { const float zc = fminf(p0[r + q], 126.f); const float sp = __builtin_amdgcn_logf(1.f + __builtin_amdgcn_exp2f(zc)); const bool ok = crow(r + q, hi) < lim;
                  La[q] = ok ? -sp : 0.f; p0[r + q] = ok ? zc - sp : -INFINITY; }
                { const float zc = fminf(p1[r + q], 126.f); const float sp = __builtin_amdgcn_logf(1.f + __builtin_amdgcn_exp2f(zc)); const bool ok = crow(r + q, hi) + 32 < lim;
                  Lb[q] = ok ? -sp : 0.f; p1[r + q] = ok ? zc - sp : -INFINITY; }
            }
            sumL += (La[0] + La[1]) + (Lb[0] + Lb[1]);
            lw[r >> 1] = cvtpk(La[0], La[1]); lw[8 + (r >> 1)] = cvtpk(Lb[0], Lb[1]);
        }
        f32x16 cinit;
#pragma unroll
        for (int r = 0; r < 16; ++r) cinit[r] = carry;
        const bf16x8 x00 = mk8(lw[0], lw[1], lw[2], lw[3]), x01 = mk8(lw[4], lw[5], lw[6], lw[7]), x10 = mk8(lw[8], lw[9], lw[10], lw[11]), x11 = mk8(lw[12], lw[13], lw[14], lw[15]);
        f32x16 y0 = MFMA32(tri0, x00, cinit); y0 = MFMA32(tri1, x01, y0); y0 = MFMA32(ones, x10, y0); y0 = MFMA32(ones, x11, y0);
        f32x16 y1 = MFMA32(tri0, x10, cinit); y1 = MFMA32(tri1, x11, y1);
        unsigned aw[16];
#pragma unroll
        for (int r = 0; r < 16; r += 2) {
            const float a0 = __builtin_amdgcn_exp2f(p0[r] + y0[r]), a1 = __builtin_amdgcn_exp2f(p0[r + 1] + y0[r + 1]);
            const float c0 = __builtin_amdgcn_exp2f(p1[r] + y1[r]), c1 = __builtin_amdgcn_exp2f(p1[r + 1] + y1[r + 1]);
            aw[r >> 1] = cvtpk(a0, a1); aw[8 + (r >> 1)] = cvtpk(c0, c1);
        }
#pragma unroll
        for (int ks = 0; ks < 4; ++ks) {
            const bf16x8 pa = mk8(aw[4 * ks], aw[4 * ks + 1], aw[4 * ks + 2], aw[4 * ks + 3]);
            o0 = MFMA32(pa, vfrag(vb + ks * 1024), o0);
            o1 = MFMA32(pa, vfrag(vb + 4096 + ks * 1024), o1);
        }
        { const auto rr = __builtin_amdgcn_permlane32_swap(__float_as_uint(sumL), __float_as_uint(sumL), false, false); carry += __uint_as_float(rr[0]) + __uint_as_float(rr[1]); }
        if (__all(carry < -160.f)) break;
    }
#undef SB_LOADK
    otile_store(o0, o1, wl + 8192, O + (rowb + t0) * 1024 + h * 64, 1024, lane);
}
__device__ __forceinline__ void phase_sbatt(const bf16* Q, const bf16* K, const bf16* V, bf16* O, LAS unsigned char* lds, int vcu, int G, int wave, int lane) {
    const int r32 = lane & 31, hi = lane >> 5;
    unsigned t0w[4], t1w[4];
#pragma unroll
    for (int j = 0; j < 8; ++j) {
        const int kv0 = 8 * (j >> 2) + 4 * hi + (j & 3);
        const unsigned b0 = (kv0 > r32) ? 0x3F80u : 0u, b1 = (kv0 + 16 > r32) ? 0x3F80u : 0u;
        if (j & 1) { t0w[j >> 1] |= b0 << 16; t1w[j >> 1] |= b1 << 16; } else { t0w[j >> 1] = b0; t1w[j >> 1] = b1; }
    }
    const bf16x8 tri0 = mk8(t0w[0], t0w[1], t0w[2], t0w[3]), tri1 = mk8(t1w[0], t1w[1], t1w[2], t1w[3]), ones = mk8(0x3F803F80u, 0x3F803F80u, 0x3F803F80u, 0x3F803F80u);
    LAS unsigned char* wl = lds + wave * 12288;
    const int nunits = NB * 16 * (S / 32);
    for (int it = 0; ; ++it) {
        const int u = (it * G + vcu) * NWAVES + wave;
        if (u >= nunits) break;
        const int bh = u >> 7, qb = u & 127;
        sb_unit(Q, K, V, O, bh >> 4, bh & 15, qb * 32, wl, lane, tri0, tri1, ones);
    }
}

__device__ __forceinline__ void sw_unit(const bf16* QKV, const float* qg, const float* kg, float sink2, float slope2, bf16* O, int b, int h, int t0, LAS unsigned char* wl, int lane) {
    const int r32 = lane & 31, hi = lane >> 5, kvh = h >> 2;
    const size_t rowb = (size_t)b * S;
    LAS float* wsf = (LAS float*)(wl + 12288);
    bf16x8 qf[4];
    {
        const bf16* qp = QKV + (rowb + t0 + r32) * 1536 + h * 64 + hi * 8;
        v4u raw[4]; float ss = 0.f;
#pragma unroll
        for (int d0 = 0; d0 < 4; ++d0) { raw[d0] = *(const v4u*)(qp + d0 * 16);
#pragma unroll
            for (int w = 0; w < 4; ++w) { const float a = bflo(raw[d0][w]), c = bfhi(raw[d0][w]); ss += a * a + c * c; } }
        { const auto rr = __builtin_amdgcn_permlane32_swap(__float_as_uint(ss), __float_as_uint(ss), false, false); ss = __uint_as_float(rr[0]) + __uint_as_float(rr[1]); }
        const float rq = rsqrtf(ss * (1.f / 64.f) + 1e-6f) * C2;
#pragma unroll
        for (int d0 = 0; d0 < 4; ++d0) { const f32x4 g0 = *(const f32x4*)(qg + d0 * 16 + hi * 8) * *(const f32x4*)(kg + d0 * 16 + hi * 8), g1 = *(const f32x4*)(qg + d0 * 16 + hi * 8 + 4) * *(const f32x4*)(kg + d0 * 16 + hi * 8 + 4);
            qf[d0] = mk8(cvtpk(bflo(raw[d0][0]) * rq * g0[0], bfhi(raw[d0][0]) * rq * g0[1]), cvtpk(bflo(raw[d0][1]) * rq * g0[2], bfhi(raw[d0][1]) * rq * g0[3]),
                         cvtpk(bflo(raw[d0][2]) * rq * g1[0], bfhi(raw[d0][2]) * rq * g1[1]), cvtpk(bflo(raw[d0][3]) * rq * g1[2], bfhi(raw[d0][3]) * rq * g1[3])); }
    }
    float m = sink2, l = 1.f;
    f32x16 o0 = {}, o1 = {};
    LAS const unsigned char* vb = wl + ((lane >> 4) & 1) * 32 + (lane & 3) * 8 + (4 * hi + ((lane & 15) >> 2)) * 64;
    const int thi = t0 >> 6, tlo = (t0 >= 127) ? ((t0 - 127) >> 6) : 0;
    v4u kf[8], vv[8];
#define SW_LOADK(tl) do { _Pragma("unroll") for (int half = 0; half < 2; ++half) { const bf16* kp_ = QKV + (rowb + (tl) * 64 + 32 * half + r32) * 1536 + 1024 + kvh * 64 + hi * 8; \
        _Pragma("unroll") for (int d0 = 0; d0 < 4; ++d0) kf[2 * d0 + half] = *(const v4u*)(kp_ + d0 * 16); } } while (0)
    SW_LOADK(thi); vtile_load(vv, QKV + (rowb + thi * 64) * 1536 + 1280 + kvh * 64, 1536, lane);
    for (int tile = thi; tile >= tlo; --tile) {
        const int s0 = tile * 64, tn = tile > tlo ? tile - 1 : tlo;
#pragma unroll
        for (int half = 0; half < 2; ++half) {
            float ss = 0.f;
#pragma unroll
            for (int d0 = 0; d0 < 4; ++d0)
#pragma unroll
                for (int w = 0; w < 4; ++w) { const float a = bflo(kf[2 * d0 + half][w]), c = bfhi(kf[2 * d0 + half][w]); ss += a * a + c * c; }
            { const auto rr = __builtin_amdgcn_permlane32_swap(__float_as_uint(ss), __float_as_uint(ss), false, false); ss = __uint_as_float(rr[0]) + __uint_as_float(rr[1]); }
            if (hi == half) wsf[32 * half + r32] = rsqrtf(ss * (1.f / 64.f) + 1e-6f);
        }
        f32x16 p0 = {}, p1 = {};
#pragma unroll
        for (int d0 = 0; d0 < 4; ++d0) { p0 = MFMA32(__builtin_bit_cast(bf16x8, kf[2 * d0]), qf[d0], p0); p1 = MFMA32(__builtin_bit_cast(bf16x8, kf[2 * d0 + 1]), qf[d0], p1); }
        SW_LOADK(tn);
        vtile_store(vv, wl, lane);
        vtile_load(vv, QKV + (rowb + tn * 64) * 1536 + 1280 + kvh * 64, 1536, lane);
        const int dq = t0 + r32 - s0;
        float rmax = -INFINITY;
#pragma unroll
        for (int g = 0; g < 4; ++g) {
            const f32x4 rk0 = *(LAS const f32x4*)(wsf + 8 * g + 4 * hi), rk1 = *(LAS const f32x4*)(wsf + 32 + 8 * g + 4 * hi);
#pragma unroll
            for (int j = 0; j < 4; ++j) { const int r = 4 * g + j;
                { const int dist = dq - crow(r, hi); const bool ok = dist >= 0 && dist < 128; p0[r] = ok ? p0[r] * rk0[j] - slope2 * (float)dist : -INFINITY; rmax = fmaxf(rmax, p0[r]); }
                { const int dist = dq - crow(r, hi) - 32; const bool ok = dist >= 0 && dist < 128; p1[r] = ok ? p1[r] * rk1[j] - slope2 * (float)dist : -INFINITY; rmax = fmaxf(rmax, p1[r]); } }
        }
        { const auto rr = __builtin_amdgcn_permlane32_swap(__float_as_uint(rmax), __float_as_uint(rmax), false, false); rmax = fmaxf(__uint_as_float(rr[0]), __uint_as_float(rr[1])); }
        const float mn = fmaxf(m, rmax);
        const float alpha = __builtin_amdgcn_exp2f(m - mn);
        m = mn;
        float rsum = 0.f; unsigned aw[16];
#pragma unroll
        for (int r = 0; r < 16; r += 2) {
            const float a0 = __builtin_amdgcn_exp2f(p0[r] - mn), a1 = __builtin_amdgcn_exp2f(p0[r + 1] - mn), c0 = __builtin_amdgcn_exp2f(p1[r] - mn), c1 = __builtin_amdgcn_exp2f(p1[r + 1] - mn);
            rsum += (a0 + a1) + (c0 + c1);
            aw[r >> 1] = cvtpk(a0, a1); aw[8 + (r >> 1)] = cvtpk(c0, c1);
        }
        { const auto rr = __builtin_amdgcn_permlane32_swap(__float_as_uint(rsum), __float_as_uint(rsum), false, false); rsum = __uint_as_float(rr[0]) + __uint_as_float(rr[1]); }
        l = l * alpha + rsum;
        if (hi == 0) wsf[64 + r32] = alpha;
#pragma unroll
        for (int g = 0; g < 4; ++g) { const f32x4 f = *(LAS const f32x4*)(wsf + 64 + 8 * g + 4 * hi);
#pragma unroll
            for (int j = 0; j < 4; ++j) { o0[4 * g + j] *= f[j]; o1[4 * g + j] *= f[j]; } }
#pragma unroll
        for (int ks = 0; ks < 4; ++ks) {
            const bf16x8 pa = mk8(aw[4 * ks], aw[4 * ks + 1], aw[4 * ks + 2], aw[4 * ks + 3]);
            o0 = MFMA32(pa, vfrag(vb + ks * 1024), o0);
            o1 = MFMA32(pa, vfrag(vb + 4096 + ks * 1024), o1);
        }
    }
#undef SW_LOADK
    if (hi == 0) wsf[64 + r32] = 1.f / l;
#pragma unroll
    for (int g = 0; g < 4; ++g) { const f32x4 f = *(LAS const f32x4*)(wsf + 64 + 8 * g + 4 * hi);
#pragma unroll
        for (int j = 0; j < 4; ++j) { o0[4 * g + j] *= f[j]; o1[4 * g + j] *= f[j]; } }
    otile_store(o0, o1, wl + 8192, O + (rowb + t0) * 1024 + h * 64, 1024, lane);
}
__device__ __forceinline__ void phase_swatt(const bf16* QKV, const float* qg, const float* kg, const float* sinks, bf16* O, LAS unsigned char* lds, int vcu, int G, int wave, int lane) {
    LAS unsigned char* wl = lds + wave * 12800;
    const int nunits = NB * 16 * (S / 32);
    for (int it = 0; ; ++it) {
        const int u = (it * G + vcu) * NWAVES + wave;
        if (u >= nunits) break;
        const int bh = u >> 7, qb = u & 127, h = bh & 15;
        sw_unit(QKV, qg, kg, sinks[h] * LOG2E, exp2f(-0.5f * (float)(h + 1)) * LOG2E, O, bh >> 4, h, qb * 32, wl, lane);
    }
}

__device__ __forceinline__ void ce_desc(float& a, float& b) { float mx, mn; asm("v_max_f32_e32 %0, %1, %2" : "=v"(mx) : "v"(a), "v"(b)); asm("v_min_f32_e32 %0, %1, %2" : "=v"(mn) : "v"(a), "v"(b)); a = mx; b = mn; }
__device__ __forceinline__ float maxf_raw(float a, float b) { float mx; asm("v_max_f32_e32 %0, %1, %2" : "=v"(mx) : "v"(a), "v"(b)); return mx; }
__device__ __forceinline__ void sort16_desc(float (&v)[16]) {
#pragma unroll
    for (int k = 2; k <= 16; k <<= 1)
#pragma unroll
        for (int j = k >> 1; j > 0; j >>= 1)
#pragma unroll
            for (int i = 0; i < 16; ++i) { const int l = i ^ j; if (l > i) { if ((i & k) == 0) ce_desc(v[i], v[l]); else ce_desc(v[l], v[i]); } }
}
__device__ __forceinline__ void merge16_desc(float (&a)[16], const float (&b)[16]) {
#pragma unroll
    for (int i = 0; i < 16; ++i) a[i] = maxf_raw(a[i], b[15 - i]);
#pragma unroll
    for (int j = 8; j > 0; j >>= 1)
#pragma unroll
        for (int i = 0; i < 16; ++i) { const int l = i ^ j; if (l > i) ce_desc(a[i], a[l]); }
}
__device__ __forceinline__ void top16_of_4x16(float (&g0)[16], float (&g1)[16], float (&g2)[16], float (&g3)[16]) {
    sort16_desc(g0); sort16_desc(g1); sort16_desc(g2); sort16_desc(g3);
    merge16_desc(g0, g1); merge16_desc(g2, g3); merge16_desc(g0, g2);
}
__device__ __forceinline__ float setcode(float v, unsigned clear_mask, unsigned code) { return __uint_as_float((__float_as_uint(v) & clear_mask) | code); }

__device__ __forceinline__ void topk_unit(const bf16* QP, const bf16* SUBK, int* EID, float* GATE, int tt, int h, int lane) {
    const int r32 = lane & 31, hi = lane >> 5;
    float L[2][16];
#pragma unroll
    for (int p = 0; p < 2; ++p) {
        const bf16* qp = QP + (size_t)(tt * 32 + r32) * 2048 + h * 256 + p * 128 + hi * 8;
        bf16x8 qf[8];
#pragma unroll
        for (int ks = 0; ks < 8; ++ks) qf[ks] = *(const bf16x8*)(qp + ks * 16);
        const bf16* kp = SUBK + ((size_t)(h * 2 + p) * 128 + r32) * 128 + hi * 8;
        float g[4][16];
        bf16x8 afA[8], afB[8];
#define TK_LOAD(af, mt) do { _Pragma("unroll") for (int ks = 0; ks < 8; ++ks) af[ks] = *(const bf16x8*)(kp + (size_t)(mt) * 32 * 128 + ks * 16); } while (0)
#define TK_MMA(af, mt) do { f32x16 acc = {}; _Pragma("unroll") for (int ks = 0; ks < 8; ++ks) acc = MFMA32(af[ks], qf[ks], acc); \
        _Pragma("unroll") for (int r = 0; r < 16; ++r) g[mt][r] = setcode(acc[r], 0xFFFFFF80u, (unsigned)(32 * (mt) + (r & 3) + 8 * (r >> 2))); } while (0)
        TK_LOAD(afA, 0); asm volatile("" ::: "memory");
        TK_LOAD(afB, 1); asm volatile("" ::: "memory"); TK_MMA(afA, 0);
        TK_LOAD(afA, 2); asm volatile("" ::: "memory"); TK_MMA(afB, 1);
        TK_LOAD(afB, 3); asm volatile("" ::: "memory"); TK_MMA(afA, 2);
        TK_MMA(afB, 3);
#undef TK_LOAD
#undef TK_MMA
        top16_of_4x16(g[0], g[1], g[2], g[3]);
        float other[16];
#pragma unroll
        for (int i = 0; i < 16; ++i) {
            g[0][i] = __uint_as_float(__float_as_uint(g[0][i]) | (unsigned)(hi << 2));
            const auto rr = __builtin_amdgcn_permlane32_swap(__float_as_uint(g[0][i]), __float_as_uint(g[0][i]), false, false);
            other[i] = __uint_as_float(hi ? rr[0] : rr[1]);
        }
        merge16_desc(g[0], other);
#pragma unroll
        for (int i = 0; i < 16; ++i) L[p][i] = g[0][i];
    }
    unsigned TA[4], TB[4];
#pragma unroll
    for (int k = 0; k < 16; ++k) {
        const unsigned ca = (__float_as_uint(L[0][k]) & 0x7Fu) << (8 * (k & 3)), cb = (__float_as_uint(L[1][k]) & 0x7Fu) << (8 * (k & 3));
        if ((k & 3) == 0) { TA[k >> 2] = ca; TB[k >> 2] = cb; } else { TA[k >> 2] |= ca; TB[k >> 2] |= cb; }
    }
    float c[4][16];
    {
        int n = 0;
#pragma unroll
        for (int i = 0; i < 16; ++i)
#pragma unroll
            for (int j = 0; j < 16; ++j)
                if ((i + 1) * (j + 1) <= 16) { c[n >> 4][n & 15] = setcode(L[0][i] + L[1][j], 0xFFFFFF00u, (unsigned)(i * 16 + j)); ++n; }
#pragma unroll
        for (int k = 50; k < 64; ++k) c[k >> 4][k & 15] = -INFINITY;
    }
    top16_of_4x16(c[0], c[1], c[2], c[3]);
    float ex[16]; float den = 0.f;
#pragma unroll
    for (int r = 0; r < 16; ++r) { ex[r] = __builtin_amdgcn_exp2f((c[0][r] - c[0][0]) * LOG2E); den += ex[r]; }
    const float inv = 1.f / den;
    unsigned eidv[16];
#pragma unroll
    for (int r = 0; r < 16; ++r) {
        const unsigned code = __float_as_uint(c[0][r]) & 0xFFu, i = code >> 4, j = code & 15u;
        const unsigned sa = (i & 7u) | 0x0C0C0C00u, sb = (j & 7u) | 0x0C0C0C00u;
        const unsigned ia = (i & 8u) ? __builtin_amdgcn_perm(TA[3], TA[2], sa) : __builtin_amdgcn_perm(TA[1], TA[0], sa);
        const unsigned ib = (j & 8u) ? __builtin_amdgcn_perm(TB[3], TB[2], sb) : __builtin_amdgcn_perm(TB[1], TB[0], sb);
        eidv[r] = ia * 128u + ib;
        ex[r] *= inv;
    }
    if (hi == 0) {
        const size_t off = (size_t)(tt * 32 + r32) * 128 + h * 16;
#pragma unroll
        for (int q = 0; q < 4; ++q) {
            v4u e4 = {eidv[4 * q], eidv[4 * q + 1], eidv[4 * q + 2], eidv[4 * q + 3]}; *(v4u*)(EID + off + 4 * q) = e4;
            f32x4 g4 = {ex[4 * q], ex[4 * q + 1], ex[4 * q + 2], ex[4 * q + 3]}; *(f32x4*)(GATE + off + 4 * q) = g4;
        }
    }
}
__device__ __forceinline__ void phase_topk(const bf16* QP, const bf16* SUBK, int* EID, float* GATE, int vcu, int G, int wave, int lane) {
    const int nunits = (T / 32) * 8;
    for (int it = 0; ; ++it) {
        const int u = (it * G + vcu) * NWAVES + wave;
        if (u >= nunits) break;
        topk_unit(QP, SUBK, EID, GATE, u >> 3, u & 7, lane);
    }
}

__device__ __forceinline__ float gelu_tanh_f(float x) { const float u = 0.7978845608028654f * (x + 0.044715f * x * x * x); const float e = __builtin_amdgcn_exp2f(u * (2.f * LOG2E)); return x * (1.f - __builtin_amdgcn_rcpf(e + 1.f)); }
__device__ __forceinline__ void gather_token(float* h, const float* ssp_in, int np, const unsigned char* U8, const unsigned char* V8, const float* isu, const float* isv,
                                             const int* eid, const float* gate, bf16* hb, float* ssp_out, int t, int lane) {
    float x[16], acc[16];
#pragma unroll
    for (int j = 0; j < 4; ++j) { const f32x4 v = *(const f32x4*)(h + (size_t)t * 1024 + lane * 16 + 4 * j); x[4 * j] = v[0]; x[4 * j + 1] = v[1]; x[4 * j + 2] = v[2]; x[4 * j + 3] = v[3]; }
#pragma unroll
    for (int j = 0; j < 16; ++j) acc[j] = 0.f;
    float ssum = 0.f; for (int p = 0; p < np; ++p) ssum += ssp_in[(size_t)p * T + t];
    const float rstd = rsqrtf(ssum * (1.f / 1024.f) + 1e-6f);
    for (int k = 0; k < 128; ++k) {
        const int e = eid[(size_t)t * 128 + k];
        const float g = gate[(size_t)t * 128 + k];
        const v4u uw = *(const v4u*)(U8 + (size_t)e * 1024 + lane * 16);
        const v4u vw = *(const v4u*)(V8 + (size_t)e * 1024 + lane * 16);
        float s = 0.f;
#pragma unroll
        for (int j = 0; j < 4; ++j) { const f32x2 a = __builtin_amdgcn_cvt_pk_f32_fp8((int)uw[j], false), c = __builtin_amdgcn_cvt_pk_f32_fp8((int)uw[j], true);
            s += a[0] * x[4 * j] + a[1] * x[4 * j + 1] + c[0] * x[4 * j + 2] + c[1] * x[4 * j + 3]; }
        s = wave_sum(s);
        const float coef = g * gelu_tanh_f(s * rstd * isu[e]) * isv[e];
#pragma unroll
        for (int j = 0; j < 4; ++j) { const f32x2 a = __builtin_amdgcn_cvt_pk_f32_fp8((int)vw[j], false), c = __builtin_amdgcn_cvt_pk_f32_fp8((int)vw[j], true);
            acc[4 * j] = fmaf(coef, a[0], acc[4 * j]); acc[4 * j + 1] = fmaf(coef, a[1], acc[4 * j + 1]); acc[4 * j + 2] = fmaf(coef, c[0], acc[4 * j + 2]); acc[4 * j + 3] = fmaf(coef, c[1], acc[4 * j + 3]); }
    }
    float ss = 0.f;
#pragma unroll
    for (int j = 0; j < 16; ++j) { acc[j] += x[j]; ss += acc[j] * acc[j]; }
    ss = wave_sum(ss);
#pragma unroll
    for (int j = 0; j < 4; ++j) { f32x4 o = {acc[4 * j], acc[4 * j + 1], acc[4 * j + 2], acc[4 * j + 3]}; *(f32x4*)(h + (size_t)t * 1024 + lane * 16 + 4 * j) = o; }
    v4u o0, o1; o0.x = pk2(acc[0], acc[1]); o0.y = pk2(acc[2], acc[3]); o0.z = pk2(acc[4], acc[5]); o0.w = pk2(acc[6], acc[7]);
    o1.x = pk2(acc[8], acc[9]); o1.y = pk2(acc[10], acc[11]); o1.z = pk2(acc[12], acc[13]); o1.w = pk2(acc[14], acc[15]);
    *(v4u*)(hb + (size_t)t * 1024 + lane * 16) = o0; *(v4u*)(hb + (size_t)t * 1024 + lane * 16 + 8) = o1;
    if (lane == 0) ssp_out[t] = ss;
}
__device__ __forceinline__ void phase_gather(float* h, const float* ssp_in, int np, const unsigned char* U8, const unsigned char* V8, const float* isu, const float* isv,
                                             const int* eid, const float* gate, bf16* hb, float* ssp_out, int gw, int NGW, int lane) {
    for (int t = gw; t < T; t += NGW) gather_token(h, ssp_in, np, U8, V8, isu, isv, eid, gate, hb, ssp_out, t, lane);
}

#define DPP_ADD(s, CTRL) do { (s) += __builtin_bit_cast(float, __builtin_amdgcn_update_dpp(0, __builtin_bit_cast(int, (s)), (CTRL), 0xF, 0xF, true)); } while (0)
#define DPP_XOR1 0xB1
#define DPP_XOR2 0x4E
#define DPP_HALF_MIRROR 0x141
#define DPP_ROW_MIRROR 0x140
#define DPP_ROW_ROR8 0x128

__device__ __forceinline__ void peer_rows(v4u (&row)[16], const v4u (&ev)[4], const unsigned char* tab) {
#pragma unroll
    for (int j = 0; j < 16; ++j) row[j] = *(const v4u*)(tab + (size_t)ev[j >> 2][j & 3] * 1024);
}
__device__ __forceinline__ void fmac_s(float& acc, float a, float b) { asm("v_fmac_f32_e32 %0, %1, %2" : "+v"(acc) : "v"(a), "v"(b)); }
__device__ __forceinline__ float fmul_s(float a, float b) { float r; asm("v_mul_f32_e32 %0, %1, %2" : "=v"(r) : "v"(a), "v"(b)); return r; }
__device__ __forceinline__ float fadd_s(float a, float b) { float r; asm("v_add_f32_e32 %0, %1, %2" : "=v"(r) : "v"(a), "v"(b)); return r; }
#define DPP_ADD_ASM(d, s, CTRL) asm("s_nop 1\n\tv_add_f32_dpp %0, %1, %1 " CTRL " row_mask:0xf bank_mask:0xf" : "=v"(d) : "v"(s))
typedef _Float16 h16x2 __attribute__((ext_vector_type(2)));
__device__ __forceinline__ void peer_u_token(const v4u (&row)[16], const f32x4 (&xv)[4], float* hp_t, int r, int c) {
    h16x2 xh[8];
#pragma unroll
    for (int w = 0; w < 4; ++w) { xh[2 * w] = (h16x2){(_Float16)xv[w][0], (_Float16)xv[w][1]}; xh[2 * w + 1] = (h16x2){(_Float16)xv[w][2], (_Float16)xv[w][3]}; }
    float p[16];
#pragma unroll
    for (int j = 0; j < 16; ++j) {
        h16x2 s0 = {(_Float16)0.f, (_Float16)0.f}, s1 = s0;
#pragma unroll
        for (int w = 0; w < 4; ++w) {
            const h16x2 lo = __builtin_amdgcn_cvt_scalef32_pk_f16_fp8((int)row[j][w], 0.0625f, false), hi = __builtin_amdgcn_cvt_scalef32_pk_f16_fp8((int)row[j][w], 0.0625f, true);
            s0 = __builtin_elementwise_fma(lo, xh[2 * w], s0); s1 = __builtin_elementwise_fma(hi, xh[2 * w + 1], s1);
        }
        const h16x2 ss = s0 + s1;
        float t = fmul_s(fadd_s((float)ss[0], (float)ss[1]), 16.f), u;
        DPP_ADD_ASM(u, t, "quad_perm:[1,0,3,2]"); DPP_ADD_ASM(t, u, "quad_perm:[2,3,0,1]"); DPP_ADD_ASM(u, t, "row_half_mirror");
        p[j] = u;
    }
    if (c == 0) {
        float* o = hp_t + 16 * r;
#pragma unroll
        for (int q = 0; q < 4; ++q) { f32x4 v = {p[4 * q], p[4 * q + 1], p[4 * q + 2], p[4 * q + 3]}; *(f32x4*)(o + 4 * q) = v; }
    }
}
__device__ __forceinline__ void glds16(const void* gsrc, unsigned lds_dst) { unsigned keep;
    asm volatile("s_mov_b32 %0, m0\n\ts_mov_b32 m0, %2\n\ts_nop 0\n\tglobal_load_lds_dwordx4 %1, off\n\ts_mov_b32 m0, %0" : "=&s"(keep) : "v"(gsrc), "s"(lds_dst) : "memory"); }
#define LDS_ADDR(p) ((unsigned)__builtin_amdgcn_readfirstlane((int)(unsigned)(uintptr_t)(p)))
typedef unsigned u32x2 __attribute__((ext_vector_type(2)));
#define FENCE() asm volatile("" ::: "memory")
#define PEER_SLOT(i) (wl + ((((i) >> 3) & 1) * 8192 + ((i) & 7) * 1024))
__device__ __forceinline__ void phase_peer_u(const float* h, const int* eid, const unsigned char* U8, float* hp, LAS unsigned char* wl, int sl, int m, int nmem, int wave, int lane) {
    const int r = lane >> 3, c = lane & 7;
    const int nw = nmem * NWAVES, t0 = m * NWAVES + wave;
    const unsigned char* tab = U8 + 128 * sl + 16 * c;
    const int ntok = (T - t0 + nw - 1) / nw;
    float* hp_s = hp + (size_t)sl * T * 128;
#define TOK(i) ((i) < ntok ? t0 + (i) * nw : t0)
#define STG_LD(k, i) do { const int t_ = TOK(i); sE[k] = *(const u32x2*)(eid + (size_t)t_ * 128 + 2 * lane); sX[k] = *(const f32x2*)(h + (size_t)t_ * 1024 + 128 * sl + 2 * lane); } while (0)
#define STG_ST(k, i) do { LAS unsigned char* s_ = PEER_SLOT(i); *(LAS u32x2*)(s_ + 8 * lane) = sE[k]; *(LAS f32x2*)(s_ + 512 + 8 * lane) = sX[k]; } while (0)
#define RD_EV(i) do { LAS const unsigned char* s_ = PEER_SLOT(i); _Pragma("unroll") for (int q = 0; q < 4; ++q) ev[q] = *(LAS const v4u*)(s_ + 64 * r + 16 * q); } while (0)
#define RD_X(i) do { LAS const unsigned char* s_ = PEER_SLOT(i); _Pragma("unroll") for (int q = 0; q < 4; ++q) xv[q] = *(LAS const f32x4*)(s_ + 512 + 64 * c + 16 * q); } while (0)
    v4u ev[4], rA[16], rB[16]; f32x4 xv[4]; u32x2 sE[8]; f32x2 sX[8];
#pragma unroll
    for (int k = 0; k < 8; ++k) STG_LD(k, k);
    for (int i0 = 0; i0 < ntok; i0 += 8) {
#pragma unroll
        for (int k = 0; k < 8; ++k) STG_ST(k, i0 + k);
        FENCE();
        RD_EV(i0); peer_rows(rA, ev, tab); FENCE();
#pragma unroll
        for (int k = 0; k < 8; ++k) STG_LD(k, i0 + 8 + k);
        FENCE();
#pragma unroll
        for (int k = 0; k < 8; k += 2) {
            RD_EV(i0 + k + 1); peer_rows(rB, ev, tab); FENCE();
            RD_X(i0 + k); peer_u_token(rA, xv, hp_s + (size_t)TOK(i0 + k) * 128, r, c); FENCE();
            if (k + 2 < 8) { RD_EV(i0 + k + 2); peer_rows(rA, ev, tab); FENCE(); }
            RD_X(i0 + k + 1); peer_u_token(rB, xv, hp_s + (size_t)TOK(i0 + k + 1) * 128, r, c); FENCE();
        }
    }
#undef STG_LD
#undef STG_ST
#undef RD_X
}
__device__ __forceinline__ void phase_peer_coef(const float* hp, const float* ssp_in, int np, const int* eid, const float* gate, const float* isu, const float* isv, float* coef, int gw, int NGW, int lane) {
    for (int t = gw; t < T; t += NGW) {
        float ssum = 0.f; for (int p = 0; p < np; ++p) ssum += ssp_in[(size_t)p * T + t];
        const float rstd = rsqrtf(ssum * (1.f / 1024.f) + 1e-6f);
#pragma unroll
        for (int half = 0; half < 2; ++half) {
            const int k = lane + 64 * half; float s = 0.f;
#pragma unroll
            for (int s8 = 0; s8 < 8; ++s8) s += hp[((size_t)s8 * T + t) * 128 + k];
            const int e = eid[(size_t)t * 128 + k];
            coef[(size_t)t * 128 + k] = gate[(size_t)t * 128 + k] * gelu_tanh_f(s * rstd * isu[e]) * isv[e];
        }
    }
}
__device__ __forceinline__ void peer_v_token(const v4u (&row)[16], const f32x4 (&cv)[4], const f32x2 hold, float* hdst_l, bf16* hb_l, float* ssp_t, int lane) {
    h16x2 ah[8];
#pragma unroll
    for (int i = 0; i < 8; ++i) ah[i] = (h16x2){(_Float16)0.f, (_Float16)0.f};
#pragma unroll
    for (int j = 0; j < 16; ++j) {
        const float cj = cv[j >> 2][j & 3] * 256.f; const h16x2 ch = {(_Float16)cj, (_Float16)cj};
#pragma unroll
        for (int w = 0; w < 4; ++w) {
            const h16x2 lo = __builtin_amdgcn_cvt_scalef32_pk_f16_fp8((int)row[j][w], 0.00390625f, false), hi = __builtin_amdgcn_cvt_scalef32_pk_f16_fp8((int)row[j][w], 0.00390625f, true);
            ah[2 * w] = __builtin_elementwise_fma(lo, ch, ah[2 * w]); ah[2 * w + 1] = __builtin_elementwise_fma(hi, ch, ah[2 * w + 1]);
        }
    }
    float acc[16];
#pragma unroll
    for (int i = 0; i < 8; ++i) { acc[2 * i] = (float)ah[i][0]; acc[2 * i + 1] = (float)ah[i][1]; }
    float a8[8], a4[4], a2[2];
#pragma unroll
    for (int i = 0; i < 8; ++i) { const auto rr = __builtin_amdgcn_permlane32_swap(__float_as_uint(acc[i]), __float_as_uint(acc[i + 8]), false, false); a8[i] = fadd_s(__uint_as_float(rr[0]), __uint_as_float(rr[1])); }
#pragma unroll
    for (int i = 0; i < 4; ++i) { const auto rr = __builtin_amdgcn_permlane16_swap(__float_as_uint(a8[i]), __float_as_uint(a8[i + 4]), false, false); a4[i] = fadd_s(__uint_as_float(rr[0]), __uint_as_float(rr[1])); }
    const bool b3 = (lane & 8) != 0;
#pragma unroll
    for (int i = 0; i < 2; ++i) { const float keep = b3 ? a4[i + 2] : a4[i]; float send = b3 ? a4[i] : a4[i + 2];
        a2[i] = keep + __builtin_bit_cast(float, __builtin_amdgcn_update_dpp(0, __builtin_bit_cast(int, send), DPP_ROW_ROR8, 0xF, 0xF, true)); }
    const float n0 = hold[0] + a2[0], n1 = hold[1] + a2[1];
    f32x2 o = {n0, n1}; *(f32x2*)hdst_l = o;
    *(unsigned*)hb_l = pk2(n0, n1);
    const float ss = wave_sum(n0 * n0 + n1 * n1);
    if (lane == 0) *ssp_t = ss;
}
#define PEER_SLOTV(i) (wl + ((((i) >> 2) & 1) * 8192 + ((i) & 3) * 2048))
__device__ __forceinline__ void phase_peer_v(const float* h, float* hdst, const int* eid, const float* coef, const unsigned char* V8, bf16* hb, float* ssp_out, float* scratch, LAS unsigned char* wl, int sl, int m, int nmem, int wave, int lane) {
    const int r = lane >> 3, c = lane & 7;
    const int nw = nmem * NWAVES, t0 = m * NWAVES + wave;
    const unsigned char* tab = V8 + 128 * sl + 16 * c;
    const int ntok = (T - t0 + nw - 1) / nw;
    const size_t loff = 128 * sl + 16 * c + 2 * r; float* ssp_s = ssp_out + (size_t)sl * T;
#define STG_LD(k, i) do { const int t_ = TOK(i); sE[k] = *(const u32x2*)(eid + (size_t)t_ * 128 + 2 * lane); sC[k] = *(const f32x2*)(coef + (size_t)t_ * 128 + 2 * lane); sH[k] = *(const f32x2*)(h + (size_t)t_ * 1024 + 128 * sl + 2 * lane); } while (0)
#define STG_ST(k, i) do { LAS unsigned char* s_ = PEER_SLOTV(i); *(LAS u32x2*)(s_ + 8 * lane) = sE[k]; *(LAS f32x2*)(s_ + 512 + 8 * lane) = sC[k]; *(LAS f32x2*)(s_ + 1024 + 8 * lane) = sH[k]; } while (0)
#define RD_EVV(i) do { LAS const unsigned char* s_ = PEER_SLOTV(i); _Pragma("unroll") for (int q = 0; q < 4; ++q) ev[q] = *(LAS const v4u*)(s_ + 64 * r + 16 * q); } while (0)
#define RD_C(i) do { LAS const unsigned char* s_ = PEER_SLOTV(i); _Pragma("unroll") for (int q = 0; q < 4; ++q) cv[q] = *(LAS const f32x4*)(s_ + 512 + 64 * r + 16 * q); hold = *(LAS const f32x2*)(s_ + 1024 + (16 * c + 2 * r) * 4); } while (0)
#define V_TOK(i, R) do { const bool ok_ = (i) < ntok; const size_t o_ = (size_t)TOK(i) * 1024 + loff; \
        peer_v_token(R, cv, hold, (ok_ ? hdst : scratch) + o_, (ok_ ? hb : (bf16*)scratch) + o_, (ok_ ? ssp_s : scratch) + TOK(i), lane); } while (0)
    v4u ev[4], rA[16], rB[16]; f32x4 cv[4]; f32x2 hold; u32x2 sE[4]; f32x2 sC[4], sH[4];
#pragma unroll
    for (int k = 0; k < 4; ++k) STG_LD(k, k);
    for (int i0 = 0; i0 < ntok; i0 += 4) {
#pragma unroll
        for (int k = 0; k < 4; ++k) STG_ST(k, i0 + k);
        FENCE();
        RD_EVV(i0); peer_rows(rA, ev, tab); FENCE();
#pragma unroll
        for (int k = 0; k < 4; ++k) STG_LD(k, i0 + 4 + k);
        FENCE();
#pragma unroll
        for (int k = 0; k < 4; k += 2) {
            RD_EVV(i0 + k + 1); peer_rows(rB, ev, tab); FENCE();
            RD_C(i0 + k); V_TOK(i0 + k, rA); FENCE();
            if (k + 2 < 4) { RD_EVV(i0 + k + 2); peer_rows(rA, ev, tab); FENCE(); }
            RD_C(i0 + k + 1); V_TOK(i0 + k + 1, rB); FENCE();
        }
    }
#undef STG_LD
#undef STG_ST
#undef V_TOK
#undef RD_EVV
#undef RD_EV
#undef RD_C
#undef TOK
#undef FENCE
}

#ifndef PROBE_REP
#define PROBE_REP 0u
#endif
enum Phase { PH_PREP = 0, PH_QKV0 = 1, PH_SBATT = 2, PH_OPROJ0 = 3, PH_PQ0 = 4, PH_TOPK0 = 5, PH_GATH0 = 6, PH_QKV1 = 7, PH_SWATT = 8, PH_OPROJ1 = 9, PH_PQ1 = 10, PH_TOPK1 = 11, PH_GATH1 = 12, PH_N = 13 };

__global__ void __launch_bounds__(NWAVES * 64, 2) mega(Args a) {
    extern __shared__ __attribute__((aligned(16))) unsigned char lds_raw[];
    LAS unsigned char* lds = (LAS unsigned char*)lds_raw;
    volatile LAS unsigned* MISC = (volatile LAS unsigned*)(lds + MISC_OFF);
    LAS float* rs = (LAS float*)(lds + RS_OFF);
    const int tid = threadIdx.x, lane = tid & 63, wave = __builtin_amdgcn_readfirstlane(tid >> 6);
    const int G = gridDim.x; const int bx = blockIdx.x; const int vcu = (G % 8 == 0) ? (bx % 8) * (G / 8) + bx / 8 : bx;
    const int gw = vcu * NWAVES + wave, NGW = G * NWAVES;
    unsigned char* ws = a.ws;
    gu32* ctl = (gu32*)(ws + WS_CTL);
    for (int u = tid; u < 64; u += NWAVES * 64) ((LAS unsigned*)(lds + MISC_OFF))[u] = 0u;
    __syncthreads();
    XcdBarrier bar = xcd_barrier_post((unsigned*)(ctl + CW_BAR) + a.li * XCD_BAR_WORDS, MISC + 8);
    bool first = true;
#define PHASE_ON(k) ((a.mask >> (k)) & 1u)
#define SEAM() do { if (!first) xcd_barrier(bar); first = false; } while (0)

    bf16* HB = (bf16*)(ws + WS_HB); bf16* QB = (bf16*)(ws + WS_QB); bf16* AO = (bf16*)(ws + WS_AO); bf16* QP = (bf16*)(ws + WS_QP);
    float* SSP0 = (float*)(ws + WS_SSP); float* SSP1 = SSP0 + 16 * T; float* SSP2 = SSP1 + 16 * T; float* SSP3 = SSP2 + 16 * T;

#define NREP(b) (1 + (int)((PROBE_REP >> (b)) & 1u))
    if (PHASE_ON(PH_PREP)) { SEAM(); for (int q = 0; q < NREP(0); ++q) phase_prep(a, lds, gw, NGW, wave, lane); }

    if (PHASE_ON(PH_QKV0)) { SEAM();
        _Pragma("unroll") for (int q = 0; q < NREP(1); ++q) {
        pg8::Gemm g{HB, (const bf16*)(ws + WS_WQKV0), T, 3072, 1024}; pg8::StaticOrder So; So.init(T, 3072, G, bx);
        fill_rs(rs, So, SSP0, 1, tid);
        pg8::EpiScaleBf16 E{QB, 1024, 1024, (size_t)(WS_KB - WS_QB) / 2, C2, rs};
        pg8::gemm_phase<pg8::EpiScaleBf16, pg8::StaticOrder, true, true>(lds, g, So, E); }
    }
    if (PHASE_ON(PH_SBATT)) { SEAM(); for (int q = 0; q < NREP(2); ++q) phase_sbatt(QB, (const bf16*)(ws + WS_KB), (const bf16*)(ws + WS_VB), AO, lds, vcu, G, wave, lane); }
    if (PHASE_ON(PH_OPROJ0)) { SEAM();
        _Pragma("unroll") for (int q = 0; q < NREP(3); ++q) {
        pg8::Gemm g{AO, (const bf16*)(ws + WS_WO0), T, 1024, 1024}; pg8::StaticOrder So; So.init(T, 1024, G, bx);
        pg8::EpiResid E{a.in[0], a.out, HB, SSP1, T};
        pg8::gemm_phase<pg8::EpiResid, pg8::StaticOrder, true, true>(lds, g, So, E); }
    }
    if (PHASE_ON(PH_PQ0)) { SEAM();
        _Pragma("unroll") for (int q = 0; q < NREP(4); ++q) {
        pg8::Gemm g{HB, (const bf16*)(ws + WS_WPQ0), T, 2048, 1024}; pg8::StaticOrder So; So.init(T, 2048, G, bx);
        fill_rs(rs, So, SSP1, 16, tid);
        pg8::EpiScaleBf16 E{QP, 2048, 0, 0, 1.f, rs};
        pg8::gemm_phase<pg8::EpiScaleBf16, pg8::StaticOrder, true, true>(lds, g, So, E);
        _Pragma("unroll") for (int q2 = 0; q2 < NREP(5); ++q2) { pg8::Unit u; for (int ui = 0; So.next(ui, u); ++ui) topk_unit(QP, (const bf16*)(ws + WS_SUBK), (int*)(ws + WS_EID), (float*)(ws + WS_GATE), u.pm * 8 + wave, u.pn, lane); } }
    }
    const int sl = bx & 7, smem = bx >> 3, nmem = (G - 1 - sl) / 8 + 1;
    float* HP = (float*)(ws + WS_HP); float* COEF = (float*)(ws + WS_COEF); const int* EIDp = (const int*)(ws + WS_EID); const float* GATEp = (const float*)(ws + WS_GATE);
    if (PHASE_ON(PH_GATH0)) { SEAM();
        _Pragma("unroll") for (int q = 0; q < NREP(6); ++q) phase_peer_u(a.out, EIDp, ws + WS_U8, HP, lds + wave * 16384, sl, smem, nmem, wave, lane);
        xcd_barrier(bar);
        _Pragma("unroll") for (int q = 0; q < NREP(13); ++q) phase_peer_coef(HP, SSP1, 16, EIDp, GATEp, (const float*)(ws + WS_ISU), (const float*)(ws + WS_ISV), COEF, gw, NGW, lane);
        xcd_barrier(bar);
        if (NREP(14) > 1) phase_peer_v(a.out, HP, EIDp, COEF, ws + WS_V8, (bf16*)QP, SSP3, HP, lds + wave * 16384, sl, smem, nmem, wave, lane);
        phase_peer_v(a.out, a.out, EIDp, COEF, ws + WS_V8, HB, SSP2, HP, lds + wave * 16384, sl, smem, nmem, wave, lane);
    }
    if (PHASE_ON(PH_QKV1)) { SEAM();
        _Pragma("unroll") for (int q = 0; q < NREP(7); ++q) {
        pg8::Gemm g{HB, (const bf16*)(ws + WS_WQKV1), T, 1536, 1024}; pg8::StaticOrder So; So.init(T, 1536, G, bx);
        fill_rs(rs, So, SSP2, 8, tid);
        pg8::EpiScaleBf16 E{QB, 1536, 0, 0, 1.f, rs};
        pg8::gemm_phase<pg8::EpiScaleBf16, pg8::StaticOrder, true, true>(lds, g, So, E); }
    }
    if (PHASE_ON(PH_SWATT)) { SEAM(); for (int q = 0; q < NREP(8); ++q) phase_swatt(QB, a.in[6], a.in[7], a.in[8], AO, lds, vcu, G, wave, lane); }
    if (PHASE_ON(PH_OPROJ1)) { SEAM();
        _Pragma("unroll") for (int q = NREP(9) - 1; q >= 0; --q) {
        pg8::Gemm g{AO, (const bf16*)(ws + WS_WO1), T, 1024, 1024}; pg8::StaticOrder So; So.init(T, 1024, G, bx);
        pg8::EpiResid E{a.out, q ? HP : a.out, q ? (bf16*)QP : HB, q ? SSP0 : SSP3, T};
        pg8::gemm_phase<pg8::EpiResid, pg8::StaticOrder, true, true>(lds, g, So, E); }
    }
    if (PHASE_ON(PH_PQ1)) { SEAM();
        _Pragma("unroll") for (int q = 0; q < NREP(10); ++q) {
        pg8::Gemm g{HB, (const bf16*)(ws + WS_WPQ1), T, 2048, 1024}; pg8::StaticOrder So; So.init(T, 2048, G, bx);
        fill_rs(rs, So, SSP3, 16, tid);
        pg8::EpiScaleBf16 E{QP, 2048, 0, 0, 1.f, rs};
        pg8::gemm_phase<pg8::EpiScaleBf16, pg8::StaticOrder, true, true>(lds, g, So, E);
        _Pragma("unroll") for (int q2 = 0; q2 < NREP(11); ++q2) { pg8::Unit u; for (int ui = 0; So.next(ui, u); ++ui) topk_unit(QP, (const bf16*)(ws + WS_SUBK) + (size_t)8 * 2 * 128 * 128, (int*)(ws + WS_EID), (float*)(ws + WS_GATE), u.pm * 8 + wave, u.pn, lane); } }
    }
    if (PHASE_ON(PH_GATH1)) { SEAM();
        _Pragma("unroll") for (int q = 0; q < NREP(12); ++q) phase_peer_u(a.out, EIDp, ws + WS_U8 + (size_t)16384 * 1024, HP, lds + wave * 16384, sl, smem, nmem, wave, lane);
        xcd_barrier(bar);
        _Pragma("unroll") for (int q = 0; q < NREP(13); ++q) phase_peer_coef(HP, SSP3, 16, EIDp, GATEp, (const float*)(ws + WS_ISU) + 16384, (const float*)(ws + WS_ISV) + 16384, COEF, gw, NGW, lane);
        xcd_barrier(bar);
        if (NREP(14) > 1) phase_peer_v(a.out, HP, EIDp, COEF, ws + WS_V8 + (size_t)16384 * 1024, (bf16*)QP, SSP0, HP, lds + wave * 16384, sl, smem, nmem, wave, lane);
        phase_peer_v(a.out, a.out, EIDp, COEF, ws + WS_V8 + (size_t)16384 * 1024, HB, SSP0, HP, lds + wave * 16384, sl, smem, nmem, wave, lane);
    }
    if (NREP(16) > 1) { for (int q = 0; q < 10; ++q) xcd_barrier(bar); }
#undef NREP
#undef PHASE_ON
#undef SEAM
}

static void launch_mega(const Args& a0, unsigned mask, int li, int grid, hipStream_t stream) {
    Args a = a0; a.mask = mask; a.li = li; a.rep = 0u; a.pad = 0;
    void* params[] = {&a};
    hipError_t e = hipLaunchCooperativeKernel((const void*)mega, dim3(grid), dim3(NWAVES * 64), params, LDS_BYTES, stream);
    if (e != hipSuccess) fprintf(stderr, "kernel_launch: cooperative launch failed: %s (grid %d)\n", hipGetErrorString(e), grid);
}

extern "C" void kernel_launch(void* const* d_in, const int* in_sizes, int n_in, void* d_out, int out_size, void* d_ws, size_t ws_size, hipStream_t stream) {
    static int grid = 0;
    if (grid == 0) {
        if (n_in != 15 || out_size != T * D || ws_size < WS_END) { fprintf(stderr, "kernel_launch: unexpected shapes (n_in %d out %d ws %zu)\n", n_in, out_size, ws_size); grid = -1; return; }
        int dev = 0, cus = 0, per_cu = 0;
        if (hipGetDevice(&dev) != hipSuccess || hipDeviceGetAttribute(&cus, hipDeviceAttributeMultiprocessorCount, dev) != hipSuccess) { grid = -1; return; }
        if (hipFuncSetAttribute((const void*)mega, hipFuncAttributeMaxDynamicSharedMemorySize, LDS_BYTES) != hipSuccess) { fprintf(stderr, "kernel_launch: hipFuncSetAttribute failed\n"); grid = -1; return; }
        if (hipOccupancyMaxActiveBlocksPerMultiprocessor(&per_cu, (const void*)mega, NWAVES * 64, LDS_BYTES) != hipSuccess || per_cu < 1) { fprintf(stderr, "kernel_launch: occupancy query says %d blocks per CU\n", per_cu); per_cu = 1; }
        (void)hipGetLastError();
        grid = cus;
        if (grid != 256) fprintf(stderr, "kernel_launch: note: %d CUs (tuned for 256)\n", grid);
    }
    if (grid < 0) return;
    (void)hipMemsetAsync((char*)d_ws + WS_CTL, 0, CTL_ZERO_BYTES, stream);
    Args a{};
    for (int i = 0; i < 15; ++i) a.in[i] = (const float*)d_in[i];
    a.out = (float*)d_out; a.ws = (unsigned char*)d_ws;
    unsigned char* ws = (unsigned char*)d_ws;
    bf16* QB = (bf16*)(ws + WS_QB); bf16* KB = (bf16*)(ws + WS_KB); bf16* VB = (bf16*)(ws + WS_VB); bf16* AO = (bf16*)(ws + WS_AO); bf16* QP = (bf16*)(ws + WS_QP); bf16* HB = (bf16*)(ws + WS_HB);
    float* SSP0 = (float*)(ws + WS_SSP); float* SSP1 = SSP0 + 16 * T; float* SSP2 = SSP1 + 16 * T;  float* SSP3 = SSP2 + 16 * T;
    int* EID = (int*)(ws + WS_EID); float* GATE = (float*)(ws + WS_GATE);
    const unsigned char* U8 = ws + WS_U8; const unsigned char* V8 = ws + WS_V8; const float* ISU = (const float*)(ws + WS_ISU); const float* ISV = (const float*)(ws + WS_ISV);
    const bf16* SUBK = (const bf16*)(ws + WS_SUBK);
#define M(k) (1u << (k))
    launch_mega(a, (1u << PH_N) - 1u, 0, grid, stream);
#undef M
}
```

```cpp
#include <hip/hip_runtime.h>
#include <cstdint>
#include <cstdio>

constexpr int D = 1024, NB = 4, S = 4096, T = NB * S;
constexpr float LOG2E = 1.4426950408889634f;
constexpr float C2 = 0.125f * LOG2E;

constexpr size_t MiB = 1u << 20;
constexpr size_t WS_CTL = 0, CTL_ZERO_BYTES = 1 * MiB;
constexpr size_t WS_WQKV0 = 2 * MiB, WS_WO0 = 8 * MiB, WS_WQKV1 = 10 * MiB, WS_WO1 = 13 * MiB, WS_WPQ0 = 15 * MiB, WS_WPQ1 = 19 * MiB;
constexpr size_t WS_SUBK = 23 * MiB;
constexpr size_t WS_ISU = 24 * MiB;
constexpr size_t WS_ISV = WS_ISU + 2 * 16384 * 4;
constexpr size_t WS_SSP = 25 * MiB;
constexpr size_t WS_U8 = 32 * MiB, WS_V8 = 64 * MiB;
constexpr size_t WS_HB = 96 * MiB;
constexpr size_t WS_QB = 128 * MiB, WS_KB = 160 * MiB, WS_VB = 192 * MiB;
constexpr size_t WS_AO = 224 * MiB;
constexpr size_t WS_QP = 256 * MiB;
constexpr size_t WS_EID = 320 * MiB, WS_GATE = 328 * MiB;
constexpr size_t WS_HP = 336 * MiB;
constexpr size_t WS_COEF = 400 * MiB;
constexpr size_t WS_END = 408 * MiB;
namespace pg8 {
#define PG8_LAS __attribute__((address_space(3)))
typedef unsigned short bf16_t;
typedef short bf16x8 __attribute__((ext_vector_type(8)));
typedef float f32x4 __attribute__((ext_vector_type(4)));
typedef unsigned u32x4 __attribute__((ext_vector_type(4)));
constexpr int BM = 256, BK = 64, HALF = 128, HTB = HALF * BK * 2  , STAGE_BYTES = 8 * HTB, NXCD = 8, WGM = 8;

__host__ __device__ __forceinline__ int lds_byte(int r, int c) { const int st = (r >> 4) * 2 + (c >> 5), rr = r & 15, cc = c & 31, ob = rr * 64 + cc * 2; return st * 1024 + (ob ^ (((ob >> 9) & 1) << 5)); }
__host__ __device__ __forceinline__ void stage_rc(int b, int& R, int& C) { const int st = b / 1024, sb = b % 1024, swz = sb ^ (((sb >> 9) & 1) << 5); R = (st >> 1) * 16 + swz / 64; C = (st & 1) * 32 + (swz % 64) / 2; }
__host__ __device__ __forceinline__ int perm32(int rho) { const int n = rho >> 4, i = rho & 15; return 8 * (i >> 2) + 4 * n + (i & 3); }

struct Unit { int pm, pn; };
struct Gemm { const bf16_t* A; const bf16_t* Bt; int M, N, K; };

struct StaticOrder {
    int nM, nN, nwg, G, c;
    __host__ __device__ void init(int M, int N, int G_, int c_) { nM = M / BM; nN = N / BM; nwg = nM * nN; G = G_; c = c_; }
    __host__ __device__ bool next(int i, Unit& u) const {
        const long L = (long)i * G + c; if (L >= nwg) return false;
        int wgid = (int)L; { const int q = nwg / NXCD, r = nwg % NXCD, xcd = wgid % NXCD, off = wgid / NXCD; wgid = (xcd < r ? xcd * (q + 1) : r * (q + 1) + (xcd - r) * q) + off; }
        const int nig = WGM * nN, gid = wgid / nig, fm = gid * WGM, gsz = (nM - fm) < WGM ? (nM - fm) : WGM;
        u.pm = fm + ((wgid % nig) % gsz); u.pn = (wgid % nig) / gsz; return true;
    }
    __device__ __forceinline__ void a_ready(const Unit&) const {}
    __device__ __forceinline__ void done(const Unit&) const {}
};


__device__ __forceinline__ unsigned cvt_pk_bf16(float lo, float hi) { unsigned r; asm volatile("v_cvt_pk_bf16_f32 %0, %1, %2" : "=v"(r) : "v"(lo), "v"(hi)); return r; }

struct EpiScaleBf16 {
    static constexpr bool PERM = true, AFTER_DRAIN = false;
    bf16_t* O; int ldc; int split_cols; size_t split_stride; float scale0; const PG8_LAS float* rs;
    __device__ __forceinline__ void operator()(const f32x4 (&acc)[2][2][4][2], const Unit& u, int ui, int wr, int wc, int fr, int fq) const {
        const int row0 = u.pm * BM + wr * 64 + fr; int colt = u.pn * BM; bf16_t* base = O;
        float sc = 1.f; if (split_cols) { const int t = colt / split_cols; base += (size_t)t * split_stride; colt -= t * split_cols; if (t == 0) sc = scale0; }
        const int col0 = colt + wc * 32 + 8 * fq;
        const PG8_LAS float* rsu = rs + (ui & 3) * 256 + wr * 64 + fr;
#pragma unroll
        for (int ai = 0; ai < 2; ++ai)
#pragma unroll
            for (int m = 0; m < 4; ++m) { bf16_t* rowp = base + (size_t)(row0 + ai * HALF + m * 16) * ldc + col0; const float s = rsu[ai * HALF + m * 16] * sc;
#pragma unroll
                for (int bj = 0; bj < 2; ++bj) { const f32x4 v0 = acc[ai][bj][m][0] * s, v1 = acc[ai][bj][m][1] * s;
                    u32x4 w; w.x = cvt_pk_bf16(v0[0], v0[1]); w.y = cvt_pk_bf16(v0[2], v0[3]); w.z = cvt_pk_bf16(v1[0], v1[1]); w.w = cvt_pk_bf16(v1[2], v1[3]);
                    *(u32x4*)(rowp + bj * HALF) = w; } }
    }
};
__device__ __forceinline__ float bf_lo(unsigned w) { return __builtin_bit_cast(float, w << 16); }
__device__ __forceinline__ float bf_hi(unsigned w) { return __builtin_bit_cast(float, w & 0xffff0000u); }
struct EpiResid {
    static constexpr bool PERM = true, AFTER_DRAIN = false;
    const bf16_t* hb_in; bf16_t* hb; float* ssp; int nrows;
    __device__ __forceinline__ void operator()(const f32x4 (&acc)[2][2][4][2], const Unit& u, int ui, int wr, int wc, int fr, int fq) const {
        const int col0 = u.pn * BM + wc * 32 + 8 * fq;
#pragma unroll
        for (int ai = 0; ai < 2; ++ai)
#pragma unroll
            for (int m = 0; m < 4; ++m) { const int row = u.pm * BM + ai * HALF + wr * 64 + m * 16 + fr; const size_t off = (size_t)row * 1024 + col0; float ss = 0.f;
#pragma unroll
                for (int bj = 0; bj < 2; ++bj) { const u32x4 rw = *(const u32x4*)(hb_in + off + bj * HALF);
                    const f32x4 r0 = {bf_lo(rw.x), bf_hi(rw.x), bf_lo(rw.y), bf_hi(rw.y)}, r1 = {bf_lo(rw.z), bf_hi(rw.z), bf_lo(rw.w), bf_hi(rw.w)};
                    const f32x4 v0 = acc[ai][bj][m][0] + r0, v1 = acc[ai][bj][m][1] + r1;
                    ss += (v0[0] * v0[0] + v0[1] * v0[1]) + (v0[2] * v0[2] + v0[3] * v0[3]) + (v1[0] * v1[0] + v1[1] * v1[1]) + (v1[2] * v1[2] + v1[3] * v1[3]);
                    u32x4 w; w.x = cvt_pk_bf16(v0[0], v0[1]); w.y = cvt_pk_bf16(v0[2], v0[3]); w.z = cvt_pk_bf16(v1[0], v1[1]); w.w = cvt_pk_bf16(v1[2], v1[3]);
                    *(u32x4*)(hb + off + bj * HALF) = w; }
                ss += __shfl_xor(ss, 16); ss += __shfl_xor(ss, 32);
                if (fq == 0) ssp[(size_t)(u.pn * 4 + wc) * nrows + row] = ss;
                asm volatile("" ::: "memory"); }
    }
};
template <class Epi, class Sched, bool ALIGN_EPI = false, bool SP2 = false>
__device__ __forceinline__ void gemm_phase(PG8_LAS unsigned char* lds, const Gemm g, const Sched& S, const Epi& E) {
    const int tid = threadIdx.x, wid = __builtin_amdgcn_readfirstlane(tid >> 6), lane = tid & 63, wr = wid >> 2, wc = wid & 3, fr = lane & 15, fq = lane >> 4;
    const int K = g.K, nt = K / BK;
    unsigned voffA[2], voffB[2];
#pragma unroll
    for (int i = 0; i < 2; ++i) { int R, C; stage_rc(tid * 16 + i * 8192, R, C); const int Rb = Epi::PERM ? ((R & ~31) + perm32(R & 31)) : R;
        voffA[i] = (unsigned)(R * K + C) * 2u; voffB[i] = (unsigned)(Rb * K + C) * 2u; }
    const size_t kstep = (size_t)(BK * 2);
    const size_t hstep = (size_t)HALF * K * 2;
    const size_t tstep = 2 * hstep;
    const unsigned ldsw = (unsigned)wid * 1024u;
    const int aoff = lds_byte(wr * 64 + fr, fq * 8), boff = lds_byte(wc * 32 + fr, fq * 8);
#define PG8_SA(b, h) (((b) * 2 + (h)) * HTB)
#define PG8_SB(b, h) ((4 + (b) * 2 + (h)) * HTB)
#define PG8_STAGE(bufoff, gbase, voff) do { _Pragma("unroll") for (int _i = 0; _i < 2; ++_i) \
        __builtin_amdgcn_global_load_lds((const unsigned*)((const char*)(gbase) + (voff)[_i]), (PG8_LAS unsigned*)(lds + (bufoff) + ldsw + _i * 8192), 16, 0, 0); } while (0)
#define PG8_LDA(dst, b, h) do { _Pragma("unroll") for (int m = 0; m < 4; ++m) _Pragma("unroll") for (int k = 0; k < 2; ++k) dst[m][k] = *(const PG8_LAS bf16x8*)(lds + PG8_SA(b, h) + aoff + m * 2048 + k * 1024); } while (0)
#define PG8_LDB(dst, b, h) do { _Pragma("unroll") for (int n = 0; n < 2; ++n) _Pragma("unroll") for (int k = 0; k < 2; ++k) dst[n][k] = *(const PG8_LAS bf16x8*)(lds + PG8_SB(b, h) + boff + n * 2048 + k * 1024); } while (0)
#define PG8_MMA(ai, bj, At, Bt) do { __builtin_amdgcn_s_setprio(1); _Pragma("unroll") for (int m = 0; m < 4; ++m) _Pragma("unroll") for (int n = 0; n < 2; ++n) _Pragma("unroll") for (int k = 0; k < 2; ++k) \
        acc[ai][bj][m][n] = __builtin_amdgcn_mfma_f32_16x16x32_bf16(Bt[n][k], At[m][k], acc[ai][bj][m][n], 0, 0, 0); __builtin_amdgcn_s_setprio(0); } while (0)
#define PG8_WAIT_V(n) asm volatile("s_waitcnt vmcnt(" #n ")" ::: "memory")
#define PG8_WAIT_L(n) asm volatile("s_waitcnt lgkmcnt(" #n ")" ::: "memory")
#define PG8_BAR __builtin_amdgcn_s_barrier()
#define PG8_SCHED __builtin_amdgcn_sched_barrier(0)
    Unit cur, nxt; int ui = 0;
    if (!S.next(0, cur)) return;
    f32x4 acc[2][2][4][2];
#pragma unroll
    for (int a = 0; a < 2; ++a)
#pragma unroll
        for (int b = 0; b < 2; ++b)
#pragma unroll
            for (int m = 0; m < 4; ++m)
#pragma unroll
                for (int n = 0; n < 2; ++n) acc[a][b][m][n] = (f32x4){0.f, 0.f, 0.f, 0.f};
    bf16x8 At[4][2], B0[2][2], B1[2][2];
    const char* cA = (const char*)g.A + (size_t)cur.pm * tstep; const char* cB = (const char*)g.Bt + (size_t)cur.pn * tstep;
    S.a_ready(cur);
    if constexpr (SP2) {
        PG8_STAGE(PG8_SB(0, 0), cB, voffB); PG8_STAGE(PG8_SB(0, 1), cB + hstep, voffB); PG8_STAGE(PG8_SA(0, 0), cA, voffA); PG8_STAGE(PG8_SA(0, 1), cA + hstep, voffA);
        if (wr == 1) PG8_BAR;
        PG8_WAIT_V(2); PG8_BAR;
        PG8_STAGE(PG8_SB(1, 0), cB + kstep, voffB); PG8_STAGE(PG8_SA(1, 0), cA + kstep, voffA); PG8_STAGE(PG8_SB(1, 1), cB + hstep + kstep, voffB);
        PG8_WAIT_V(6); PG8_BAR;
    } else {
        PG8_STAGE(PG8_SB(0, 0), cB, voffB); PG8_STAGE(PG8_SA(0, 0), cA, voffA); PG8_STAGE(PG8_SB(0, 1), cB + hstep, voffB); PG8_STAGE(PG8_SA(0, 1), cA + hstep, voffA);
        if (wr == 1) PG8_BAR;
        PG8_WAIT_V(4); PG8_BAR;
        PG8_STAGE(PG8_SB(1, 0), cB + kstep, voffB); PG8_STAGE(PG8_SA(1, 0), cA + kstep, voffA); PG8_STAGE(PG8_SB(1, 1), cB + hstep + kstep, voffB);
        PG8_WAIT_V(6); PG8_BAR;
    }
    for (;;) {
        const bool has_next = S.next(ui + 1, nxt);
        const char* nA = has_next ? (const char*)g.A + (size_t)nxt.pm * tstep : cA; const char* nB = has_next ? (const char*)g.Bt + (size_t)nxt.pn * tstep : cB;
        for (int t = 0; t < nt; t += 2) {
            const bool last = (t == nt - 2);
            const char* a1 = cA + (size_t)(t + 1) * kstep;
            const char* a2 = last ? nA : cA + (size_t)(t + 2) * kstep; const char* b2 = last ? nB : cB + (size_t)(t + 2) * kstep;
            const char* a3 = a2 + kstep; const char* b3 = b2 + kstep;
            if (last && has_next) S.a_ready(nxt);
            if constexpr (SP2) {
            PG8_LDB(B0, 0, 0); PG8_LDB(B1, 0, 1); PG8_SCHED; PG8_LDA(At, 0, 0); PG8_STAGE(PG8_SA(1, 1), a1 + hstep, voffA);
            PG8_WAIT_V(8); PG8_WAIT_L(0); PG8_BAR; PG8_MMA(0, 0, At, B0); PG8_MMA(0, 1, At, B1); PG8_BAR; PG8_SCHED;
            PG8_LDA(At, 0, 1); PG8_STAGE(PG8_SB(0, 0), b2, voffB); PG8_STAGE(PG8_SB(0, 1), b2 + hstep, voffB); PG8_STAGE(PG8_SA(0, 0), a2, voffA);
            PG8_WAIT_V(8); PG8_WAIT_L(0); PG8_BAR; PG8_MMA(1, 0, At, B0); PG8_MMA(1, 1, At, B1); PG8_BAR; PG8_SCHED;
            PG8_LDB(B0, 1, 0); PG8_LDB(B1, 1, 1); PG8_SCHED; PG8_LDA(At, 1, 0); PG8_STAGE(PG8_SA(0, 1), a2 + hstep, voffA);
            PG8_WAIT_V(8); PG8_WAIT_L(0); PG8_BAR; PG8_MMA(0, 0, At, B0); PG8_MMA(0, 1, At, B1); PG8_BAR; PG8_SCHED;
            PG8_LDA(At, 1, 1); PG8_STAGE(PG8_SB(1, 0), b3, voffB); PG8_STAGE(PG8_SB(1, 1), b3 + hstep, voffB); PG8_STAGE(PG8_SA(1, 0), a3, voffA);
            PG8_WAIT_V(8); PG8_WAIT_L(0); PG8_BAR; PG8_MMA(1, 0, At, B0); PG8_MMA(1, 1, At, B1); PG8_BAR; PG8_SCHED;
            } else {
            PG8_LDB(B0, 0, 0); PG8_SCHED; PG8_LDA(At, 0, 0); PG8_STAGE(PG8_SA(1, 1), a1 + hstep, voffA);
            PG8_WAIT_L(8); PG8_BAR; PG8_WAIT_L(0); PG8_MMA(0, 0, At, B0); PG8_BAR; PG8_SCHED;
            PG8_LDB(B1, 0, 1); PG8_STAGE(PG8_SB(0, 0), b2, voffB);
            PG8_BAR; PG8_WAIT_L(0); PG8_MMA(0, 1, At, B1); PG8_BAR;
            PG8_LDA(At, 0, 1); PG8_STAGE(PG8_SA(0, 0), a2, voffA);
            PG8_BAR; PG8_WAIT_L(0); PG8_MMA(1, 0, At, B0); PG8_BAR; PG8_SCHED;
            PG8_STAGE(PG8_SB(0, 1), b2 + hstep, voffB);
            PG8_WAIT_V(6); PG8_BAR; PG8_MMA(1, 1, At, B1); PG8_BAR;
            PG8_LDB(B0, 1, 0); PG8_SCHED; PG8_LDA(At, 1, 0); PG8_STAGE(PG8_SA(0, 1), a2 + hstep, voffA);
            PG8_WAIT_L(8); PG8_BAR; PG8_WAIT_L(0); PG8_MMA(0, 0, At, B0); PG8_BAR; PG8_SCHED;
            PG8_LDB(B1, 1, 1); PG8_STAGE(PG8_SB(1, 0), b3, voffB);
            PG8_BAR; PG8_WAIT_L(0); PG8_MMA(0, 1, At, B1); PG8_BAR;
            PG8_LDA(At, 1, 1); PG8_STAGE(PG8_SA(1, 0), a3, voffA);
            PG8_BAR; PG8_WAIT_L(0); PG8_MMA(1, 0, At, B0); PG8_BAR; PG8_SCHED;
            PG8_STAGE(PG8_SB(1, 1), b3 + hstep, voffB);
            PG8_WAIT_V(6); PG8_BAR; PG8_MMA(1, 1, At, B1); PG8_BAR;
            }
        }
        if constexpr (ALIGN_EPI) { if (wr == 0) PG8_BAR; }
        if constexpr (!Epi::AFTER_DRAIN) { E(acc, cur, ui, wr, wc, fr, fq); S.done(cur); }
        if (!has_next) break;
#pragma unroll
        for (int a = 0; a < 2; ++a)
#pragma unroll
            for (int b = 0; b < 2; ++b)
#pragma unroll
                for (int m = 0; m < 4; ++m)
#pragma unroll
                    for (int n = 0; n < 2; ++n) acc[a][b][m][n] = (f32x4){0.f, 0.f, 0.f, 0.f};
        cur = nxt; cA = nA; cB = nB; ++ui;
        if constexpr (ALIGN_EPI) { if (wr == 1) PG8_BAR; }
    }
    PG8_WAIT_V(0);
    if constexpr (!ALIGN_EPI) { if (wr == 0) PG8_BAR; }
    PG8_BAR;
    if constexpr (Epi::AFTER_DRAIN) { E.fused(acc, cur, wr, wc, fr, fq, lds, wid, lane); S.done(cur); }
#undef PG8_SA
#undef PG8_SB
#undef PG8_STAGE
#undef PG8_LDA
#undef PG8_LDB
#undef PG8_MMA
#undef PG8_WAIT_V
#undef PG8_WAIT_L
#undef PG8_BAR
#undef PG8_SCHED
}
}

#define GAS __attribute__((address_space(1)))
#define LAS __attribute__((address_space(3)))
typedef unsigned short bf16;
typedef unsigned v4u __attribute__((ext_vector_type(4)));
typedef float f32x4 __attribute__((ext_vector_type(4)));
typedef float f32x2 __attribute__((ext_vector_type(2)));
typedef float f32x16 __attribute__((ext_vector_type(16)));
typedef short bf16x8 __attribute__((ext_vector_type(8)));
typedef GAS unsigned gu32;
#define RLX_AGENT __ATOMIC_RELAXED, __HIP_MEMORY_SCOPE_AGENT
#define LDS_WAIT() asm volatile("s_waitcnt lgkmcnt(0)" ::: "memory")
#define VM_WAIT() asm volatile("s_waitcnt vmcnt(0)" ::: "memory")
__device__ __forceinline__ unsigned f2bf(float f) { unsigned u = __builtin_bit_cast(unsigned, f); return (u + 0x7fffu + ((u >> 16) & 1u)) >> 16; }
__device__ __forceinline__ unsigned pk2(float lo, float hi) { return f2bf(lo) | (f2bf(hi) << 16); }
__device__ __forceinline__ float bf2f(unsigned short b) { return __builtin_bit_cast(float, (unsigned)b << 16); }
__device__ __forceinline__ float bflo(unsigned w) { return __builtin_bit_cast(float, w << 16); }
__device__ __forceinline__ float bfhi(unsigned w) { return __builtin_bit_cast(float, w & 0xffff0000u); }
__device__ __forceinline__ float wave_sum(float v) {
#pragma unroll
    for (int o = 1; o < 64; o <<= 1) v += __shfl_xor(v, o);
    return v;
}
__device__ __forceinline__ float wave_max(float v) {
#pragma unroll
    for (int o = 1; o < 64; o <<= 1) v = fmaxf(v, __shfl_xor(v, o));
    return v;
}

#define XB_TMO      128
#define XB_XCNT(j)  (256  + 64 * (j))
#define XB_XSUB(j)  (1280 + 64 * (j))
#define XB_XGEN(j)  (2304 + 64 * (j))
#define XB_TOP      3328
#define XB_TOPGEN   3392
#define XCD_BAR_WORDS 3456
#define XB_SPIN_CAP (1u << 18)

__device__ __forceinline__ unsigned xb_ld(unsigned* p)              { return __hip_atomic_load(p, __ATOMIC_RELAXED, __HIP_MEMORY_SCOPE_AGENT); }
__device__ __forceinline__ unsigned xb_add(unsigned* p, unsigned v) { return __hip_atomic_fetch_add(p, v, __ATOMIC_RELAXED, __HIP_MEMORY_SCOPE_AGENT); }
__device__ __forceinline__ unsigned xb_xcc_id() { return (unsigned)__builtin_amdgcn_s_getreg((3 << 11) | 20) & 0xFu; }
#define XB_SPIN(cond, bar) do { unsigned _sp = 0; while (cond) { __builtin_amdgcn_s_sleep(1); \
    if ((++_sp & 255u) == 0u) { if (xb_ld(&(bar)[XB_TMO])) break; if (_sp > XB_SPIN_CAP) { atomicAdd(&(bar)[XB_TMO], 1u); break; } } } } while (0)

struct XcdBarrier {
    unsigned* bar; unsigned x;
    volatile LAS unsigned* st;
};

__device__ __forceinline__ XcdBarrier xcd_barrier_post(unsigned* bar, volatile LAS unsigned* st) {
    XcdBarrier b; b.bar = bar; b.x = xb_xcc_id(); b.st = st;
    if (threadIdx.x == 0) (void)xb_add(&bar[XB_XCNT(b.x)], 1u);
    return b;
}
__device__ __forceinline__ void xcd_barrier_complete(unsigned* bar, unsigned x, unsigned& nloc, unsigned& nx) {
    const unsigned G = gridDim.x * gridDim.y * gridDim.z;
    unsigned sum, cnt, mine, sp = 0u;
    for (;;) {
        sum = 0u; cnt = 0u; mine = 0u;
#pragma unroll
        for (unsigned j = 0; j < 16; ++j) { const unsigned c = xb_ld(&bar[XB_XCNT(j)]); sum += c; cnt += (c > 0u) ? 1u : 0u; mine = (j == x) ? c : mine; }
        if (sum == G) break;
        __builtin_amdgcn_s_sleep(1);
        if ((++sp & 255u) == 0u) { if (xb_ld(&bar[XB_TMO])) break; if (sp > XB_SPIN_CAP) { atomicAdd(&bar[XB_TMO], 1u); break; } }
    }
    nloc = mine > 0u ? mine : 1u; nx = cnt > 0u ? cnt : 1u;
}

__device__ __forceinline__ void xcd_barrier(const XcdBarrier& b) {
    asm volatile("s_waitcnt vmcnt(0)" ::: "memory");
    __syncthreads();
    if (threadIdx.x == 0) {
        unsigned* bar = b.bar;
        __builtin_amdgcn_s_waitcnt(0);
        unsigned nloc = b.st[0], nx = b.st[1];
        if (nloc == 0u) { xcd_barrier_complete(bar, b.x, nloc, nx); b.st[0] = nloc; b.st[1] = nx; }
        const unsigned old = xb_add(&bar[XB_XSUB(b.x)], 1u);
        const unsigned gen = old / nloc;
        if (old + 1u == (gen + 1u) * nloc) {
            __builtin_amdgcn_fence(__ATOMIC_RELEASE, "agent");
            asm volatile("s_waitcnt vmcnt(0)" ::: "memory");
            const unsigned og = xb_add(&bar[XB_TOP], 1u);
            const unsigned tg = og / nx;
            if (og + 1u == (tg + 1u) * nx) xb_add(&bar[XB_TOPGEN], 1u);
            else XB_SPIN(xb_ld(&bar[XB_TOPGEN]) == tg, bar);
            __builtin_amdgcn_fence(__ATOMIC_ACQUIRE, "agent");
            xb_add(&bar[XB_XGEN(b.x)], 1u);
            asm volatile("s_waitcnt vmcnt(0)" ::: "memory");
        } else {
            XB_SPIN(xb_ld(&bar[XB_XGEN(b.x)]) == gen, bar);
            __builtin_amdgcn_fence(__ATOMIC_ACQUIRE, "agent");
            asm volatile("s_waitcnt vmcnt(0)" ::: "memory");
        }
    }
    __syncthreads();
}

constexpr int NWAVES = 8;
constexpr int RING_BYTES = 131072;
constexpr int RS_OFF = RING_BYTES;
constexpr int MISC_OFF = RS_OFF + 4096;
constexpr int LDS_BYTES = 147456;
constexpr int CW_BAR = 4096;

struct Args { const float* in[15]; float* out; unsigned char* ws; unsigned mask; int li; unsigned rep; int pad; };

__device__ __forceinline__ void p0_transpose_item(const float* W, const float* gain, int K, int N, bf16* WT, LAS float* scr, int item, int lane) {
    const int nblk = N / 32, kb = item / nblk, nb = item % nblk, k0 = 64 * kb, n0 = 32 * nb;
#pragma unroll 8
    for (int i = 0; i < 32; ++i) { const int kk = 2 * i + (lane >> 5); float w = W[(size_t)(k0 + kk) * N + n0 + (lane & 31)]; if (gain) w *= gain[k0 + kk]; scr[kk * 33 + (lane & 31)] = w; }
    LDS_WAIT(); asm volatile("" ::: "memory");
    const int c = lane & 7;
#pragma unroll
    for (int j = 0; j < 4; ++j) { const int n = (lane >> 3) + 8 * j; const LAS float* s = scr + (8 * c) * 33 + n;
        v4u o; o.x = pk2(s[0 * 33], s[1 * 33]); o.y = pk2(s[2 * 33], s[3 * 33]); o.z = pk2(s[4 * 33], s[5 * 33]); o.w = pk2(s[6 * 33], s[7 * 33]);
        *(v4u*)(WT + (size_t)(n0 + n) * K + k0 + 8 * c) = o; }
    LDS_WAIT(); asm volatile("" ::: "memory");
}
template <int NR> __device__ __forceinline__ void conv_rows_fp8(const float* src, const float* gain, unsigned char* dst, float* inv_scale, int lane) {
    f32x4 v[NR][4]; float am[NR];
#pragma unroll
    for (int i = 0; i < NR; ++i)
#pragma unroll
        for (int j = 0; j < 4; ++j) v[i][j] = *(const f32x4*)(src + (size_t)i * 1024 + lane * 16 + 4 * j);
#pragma unroll
    for (int i = 0; i < NR; ++i) { am[i] = 0.f;
#pragma unroll
        for (int j = 0; j < 4; ++j) { if (gain) v[i][j] = v[i][j] * *(const f32x4*)(gain + lane * 16 + 4 * j);
            am[i] = fmaxf(am[i], fmaxf(fmaxf(fabsf(v[i][j][0]), fabsf(v[i][j][1])), fmaxf(fabsf(v[i][j][2]), fabsf(v[i][j][3])))); } }
#pragma unroll
    for (int o = 1; o < 64; o <<= 1)
#pragma unroll
        for (int i = 0; i < NR; ++i) am[i] = fmaxf(am[i], __shfl_xor(am[i], o));
#pragma unroll
    for (int i = 0; i < NR; ++i) {
        const float sc = am[i] > 0.f ? 224.f / am[i] : 1.f;
        v4u o;
#pragma unroll
        for (int j = 0; j < 4; ++j) { int w = __builtin_amdgcn_cvt_pk_fp8_f32(v[i][j][0] * sc, v[i][j][1] * sc, 0, false); w = __builtin_amdgcn_cvt_pk_fp8_f32(v[i][j][2] * sc, v[i][j][3] * sc, w, true); o[j] = (unsigned)w; }
        *(v4u*)(dst + (size_t)i * 1024 + lane * 16) = o;
        if (lane == 0) inv_scale[i] = am[i] > 0.f ? am[i] * (1.f / 224.f) : 1.f;
    }
}
__device__ __forceinline__ void phase_prep(const Args& a, LAS unsigned char* lds, int gw, int NGW, int wave, int lane) {
    LAS float* scr = (LAS float*)(lds + wave * 16384);
    unsigned char* ws = a.ws;
    constexpr int I0 = 16 * (3072 / 32), I1 = 16 * (1024 / 32), I2 = 16 * (1536 / 32), I3 = I1, I4 = 16 * (2048 / 32), I5 = I4;
    constexpr int NIT = I0 + I1 + I2 + I3 + I4 + I5;
    for (int it = gw; it < NIT; it += NGW) {
        int r = it;
        if (r < I0) { p0_transpose_item(a.in[2], a.in[1], 1024, 3072, (bf16*)(ws + WS_WQKV0), scr, r, lane); continue; } r -= I0;
        if (r < I1) { p0_transpose_item(a.in[3], nullptr, 1024, 1024, (bf16*)(ws + WS_WO0), scr, r, lane); continue; } r -= I1;
        if (r < I2) { p0_transpose_item(a.in[5], a.in[4], 1024, 1536, (bf16*)(ws + WS_WQKV1), scr, r, lane); continue; } r -= I2;
        if (r < I3) { p0_transpose_item(a.in[9], nullptr, 1024, 1024, (bf16*)(ws + WS_WO1), scr, r, lane); continue; } r -= I3;
        if (r < I4) { p0_transpose_item(a.in[11], a.in[10], 1024, 2048, (bf16*)(ws + WS_WPQ0), scr, r, lane); continue; } r -= I4;
        p0_transpose_item(a.in[11] + (size_t)1024 * 2048, a.in[10] + 1024, 1024, 2048, (bf16*)(ws + WS_WPQ1), scr, r, lane);
    }
    for (int it = gw; it < 1024; it += NGW) {
        const float* s = a.in[12] + (size_t)it * 512 + lane * 8; const f32x4 a0 = *(const f32x4*)s, a1 = *(const f32x4*)(s + 4);
        v4u o; o.x = pk2(a0[0], a0[1]); o.y = pk2(a0[2], a0[3]); o.z = pk2(a1[0], a1[1]); o.w = pk2(a1[2], a1[3]);
        *(v4u*)((bf16*)(ws + WS_SUBK) + (size_t)it * 512 + lane * 8) = o;
    }
    for (int r4 = gw; r4 < 16384; r4 += NGW) {
        const int r = r4 * 4, tb = r >> 15, row = r & 32767;
        const float* src = (tb ? a.in[14] : a.in[13]) + (size_t)row * 1024;
        const float* gain = tb ? nullptr : a.in[10] + (row >> 14) * 1024;
        conv_rows_fp8<4>(src, gain, ws + (tb ? WS_V8 : WS_U8) + (size_t)row * 1024, (float*)(ws + (tb ? WS_ISV : WS_ISU)) + row, lane);
    }
    for (int t2 = gw; t2 < T / 2; t2 += NGW) {
        f32x4 v[2][4]; float ss[2];
#pragma unroll
        for (int i = 0; i < 2; ++i)
#pragma unroll
            for (int j = 0; j < 4; ++j) v[i][j] = *(const f32x4*)(a.in[0] + (size_t)(2 * t2 + i) * 1024 + lane * 16 + 4 * j);
#pragma unroll
        for (int i = 0; i < 2; ++i) { ss[i] = 0.f;
#pragma unroll
            for (int j = 0; j < 4; ++j) ss[i] += (v[i][j][0] * v[i][j][0] + v[i][j][1] * v[i][j][1]) + (v[i][j][2] * v[i][j][2] + v[i][j][3] * v[i][j][3]); }
#pragma unroll
        for (int o = 1; o < 64; o <<= 1) { ss[0] += __shfl_xor(ss[0], o); ss[1] += __shfl_xor(ss[1], o); }
#pragma unroll
        for (int i = 0; i < 2; ++i) {
            v4u o0, o1; o0.x = pk2(v[i][0][0], v[i][0][1]); o0.y = pk2(v[i][0][2], v[i][0][3]); o0.z = pk2(v[i][1][0], v[i][1][1]); o0.w = pk2(v[i][1][2], v[i][1][3]);
            o1.x = pk2(v[i][2][0], v[i][2][1]); o1.y = pk2(v[i][2][2], v[i][2][3]); o1.z = pk2(v[i][3][0], v[i][3][1]); o1.w = pk2(v[i][3][2], v[i][3][3]);
            bf16* hb = (bf16*)(ws + WS_HB) + (size_t)(2 * t2 + i) * 1024 + lane * 16;
            *(v4u*)hb = o0; *(v4u*)(hb + 8) = o1;
            if (lane == 0) ((float*)(ws + WS_SSP))[2 * t2 + i] = ss[i];
        }
    }
}
template <class Sched> __device__ __forceinline__ void fill_rs(LAS float* rs, const Sched& So, const float* ssp, int np, int tid) {
    pg8::Unit u;
    for (int ui = 0; ui < 4 && So.next(ui, u); ++ui) {
        if (tid < 256) { const int row = u.pm * 256 + tid; float s = 0.f; for (int p = 0; p < np; ++p) s += ssp[(size_t)p * T + row]; rs[ui * 256 + tid] = rsqrtf(s * (1.f / 1024.f) + 1e-6f); }
    }
    __syncthreads();
}

namespace nv {
__device__ __forceinline__ float softplus(float z) { return fmaxf(z, 0.f) + log1pf(expf(-fabsf(z))); }
__device__ __forceinline__ float gelu_tanh(float x) { const float k = 0.7978845608028654f; return 0.5f * x * (1.f + tanhf(k * (x + 0.044715f * x * x * x))); }

__global__ void __launch_bounds__(256) k_sb_attn_b(const bf16* __restrict__ Q, const bf16* __restrict__ K, const bf16* __restrict__ V, bf16* __restrict__ O) {
    __shared__ float Ks[64][65];
    __shared__ float Vs[64][65];
    __shared__ float qs[4][64];
    const int tid = threadIdx.x, w = tid >> 6, lane = tid & 63;
    const int nblk = S / 4;
    const int bh = blockIdx.x / nblk, t0 = (blockIdx.x % nblk) * 4;
    const int b = bh / 16, h = bh % 16;
    const int t = t0 + w;
    const size_t rowb = (size_t)b * S;
    qs[w][lane] = bf2f(Q[(rowb + t) * 1024 + h * 64 + lane]);
    float acc = 0.f, carry = 0.f;
    const int ntile = (t0 + 3) / 64 + 1;
    for (int tile = ntile - 1; tile >= 0; --tile) {
        const int s0 = tile * 64;
        __syncthreads();
#pragma unroll
        for (int i = 0; i < 16; ++i) {
            const int idx = tid + 256 * i, r = idx >> 6, d = idx & 63;
            const size_t g = (rowb + s0 + r) * 1024 + h * 64 + d;
            Ks[r][d] = bf2f(K[g]); Vs[r][d] = bf2f(V[g]);
        }
        __syncthreads();
        float z = 0.f;
#pragma unroll 16
        for (int d = 0; d < 64; ++d) z = fmaf(qs[w][d], Ks[lane][d], z);
        z *= 0.6931471805599453f;
        const int s = s0 + lane;
        const bool valid = s < t;
        const float sp = softplus(z);
        const float L = valid ? -sp : 0.f;
        float x = L;
#pragma unroll
        for (int off = 1; off < 64; off <<= 1) { const float y = __shfl_down(x, off); if (lane + off < 64) x += y; }
        const float excl = x - L;
        const float total = __shfl(x, 0);
        const float log_a = (z - sp) + carry + excl;
        const float a = valid ? expf(log_a) : 0.f;
        carry += total;
#pragma unroll 16
        for (int j = 0; j < 64; ++j) acc = fmaf(__shfl(a, j), Vs[j][lane], acc);
    }
    O[(rowb + t) * 1024 + h * 64 + lane] = (bf16)f2bf(acc);
}

__global__ void __launch_bounds__(256) k_sw_attn_b(const bf16* __restrict__ qkv, const float* __restrict__ qg, const float* __restrict__ kg,
                                                   const float* __restrict__ sinks, bf16* __restrict__ O) {
    __shared__ float sc[4][128];
    const int tid = threadIdx.x, w = tid >> 6, lane = tid & 63;
    const int gw = blockIdx.x * 4 + w;
    const int h = gw & 15, bt = gw >> 4, t = bt % S, b = bt / S;
    const int kvh = h >> 2;
    const size_t rowb = (size_t)b * S;
    float q = bf2f(qkv[(rowb + t) * 1536 + h * 64 + lane]);
    { const float ss = wave_sum(q * q); q = q * rsqrtf(ss * (1.f / 64.f) + 1e-6f) * qg[lane]; }
    const float kgl = kg[lane];
    const float slope = exp2f(-8.f * (float)(h + 1) / 16.f);
    const int slo = (t - 127) > 0 ? (t - 127) : 0;
    const int nk = t - slo + 1;
    for (int i = 0; i < nk; ++i) {
        const int s = slo + i;
        float kd = bf2f(qkv[(rowb + s) * 1536 + 1024 + kvh * 64 + lane]);
        const float ss = wave_sum(kd * kd);
        kd = kd * rsqrtf(ss * (1.f / 64.f) + 1e-6f) * kgl;
        const float dot = wave_sum(q * kd);
        if (lane == 0) sc[w][i] = dot * 0.125f - slope * (float)(t - s);
    }
    __syncthreads();
    const float sink = sinks[h];
    float m = sink;
    for (int i = lane; i < nk; i += 64) m = fmaxf(m, sc[w][i]);
    m = wave_max(m);
    float den = 0.f;
    for (int i = lane; i < nk; i += 64) { const float p = expf(sc[w][i] - m); sc[w][i] = p; den += p; }
    den = wave_sum(den) + expf(sink - m);
    __syncthreads();
    const float inv = 1.f / den;
    float acc = 0.f;
    for (int i = 0; i < nk; ++i) acc = fmaf(sc[w][i] * inv, bf2f(qkv[(rowb + slo + i) * 1536 + 1280 + kvh * 64 + lane]), acc);
    O[(rowb + t) * 1024 + h * 64 + lane] = (bf16)f2bf(acc);
}

__global__ void __launch_bounds__(256) k_peer_topk_b(const bf16* __restrict__ qp, const bf16* __restrict__ subk, int* __restrict__ eid, float* __restrict__ gate) {
    __shared__ float qs[4][256];
    const int tid = threadIdx.x, w = tid >> 6, lane = tid & 63;
    const int gw = blockIdx.x * 4 + w;
    const int h = gw & 7, t = gw >> 3;
#pragma unroll
    for (int i = 0; i < 4; ++i) qs[w][lane + 64 * i] = bf2f(qp[(size_t)t * 2048 + h * 256 + lane + 64 * i]);
    __syncthreads();
    float ts[2]; int tii[2];
#pragma unroll
    for (int p = 0; p < 2; ++p) {
        const bf16* k0 = subk + ((size_t)(h * 2 + p) * 128 + lane) * 128;
        const bf16* k1 = k0 + 64 * 128;
        float v0 = 0.f, v1 = 0.f;
        for (int c = 0; c < 128; ++c) { const float qq = qs[w][p * 128 + c]; v0 = fmaf(qq, bf2f(k0[c]), v0); v1 = fmaf(qq, bf2f(k1[c]), v1); }
        float mys = 0.f; int myi = 0;
        for (int r = 0; r < 16; ++r) {
            float bv; int bi;
            if (v0 >= v1) { bv = v0; bi = lane; } else { bv = v1; bi = lane + 64; }
#pragma unroll
            for (int off = 1; off < 64; off <<= 1) {
                const float ov = __shfl_xor(bv, off); const int oi = __shfl_xor(bi, off);
                if (ov > bv || (ov == bv && oi < bi)) { bv = ov; bi = oi; }
            }
            if (lane == r) { mys = bv; myi = bi; }
            if (bi == lane) v0 = -INFINITY;
            if (bi == lane + 64) v1 = -INFINITY;
        }
        ts[p] = mys; tii[p] = myi;
    }
    float cv[4];
    {
        const float s0 = __shfl(ts[0], lane >> 2);
#pragma unroll
        for (int c = 0; c < 4; ++c) cv[c] = s0 + __shfl(ts[1], (lane & 3) * 4 + c);
    }
    float cs = 0.f; int cf = 0;
    for (int r = 0; r < 16; ++r) {
        float bv = cv[0]; int bi = lane * 4;
#pragma unroll
        for (int c = 1; c < 4; ++c) if (cv[c] > bv) { bv = cv[c]; bi = lane * 4 + c; }
#pragma unroll
        for (int off = 1; off < 64; off <<= 1) {
            const float ov = __shfl_xor(bv, off); const int oi = __shfl_xor(bi, off);
            if (ov > bv || (ov == bv && oi < bi)) { bv = ov; bi = oi; }
        }
        if (lane == r) { cs = bv; cf = bi; }
#pragma unroll
        for (int c = 0; c < 4; ++c) if (bi == lane * 4 + c) cv[c] = -INFINITY;
    }
    const float mval = wave_max(lane < 16 ? cs : -INFINITY);
    const float ex = lane < 16 ? expf(cs - mval) : 0.f;
    const float den = wave_sum(ex);
    const int i1 = __shfl(tii[0], (cf >> 4) & 15), i2 = __shfl(tii[1], cf & 15);
    if (lane < 16) {
        eid[(size_t)t * 128 + h * 16 + lane] = i1 * 128 + i2;
        gate[(size_t)t * 128 + h * 16 + lane] = ex / den;
    }
}

__global__ void __launch_bounds__(256) k_peer_gather_b(float* h, const float* __restrict__ ssp_in, int np, const unsigned char* __restrict__ U8, const unsigned char* __restrict__ V8,
                                                       const float* __restrict__ isu, const float* __restrict__ isv, const int* __restrict__ eid, const float* __restrict__ gate,
                                                       bf16* __restrict__ hb, float* __restrict__ ssp_out) {
    const int t = blockIdx.x * 4 + (threadIdx.x >> 6), lane = threadIdx.x & 63;
    float x[16], acc[16];
#pragma unroll
    for (int j = 0; j < 4; ++j) { const f32x4 v = *(const f32x4*)(h + (size_t)t * 1024 + lane * 16 + 4 * j); x[4 * j] = v[0]; x[4 * j + 1] = v[1]; x[4 * j + 2] = v[2]; x[4 * j + 3] = v[3]; }
#pragma unroll
    for (int j = 0; j < 16; ++j) acc[j] = 0.f;
    float ssum = 0.f; for (int p = 0; p < np; ++p) ssum += ssp_in[(size_t)p * T + t];
    const float rstd = rsqrtf(ssum * (1.f / 1024.f) + 1e-6f);
    for (int k = 0; k < 128; ++k) {
        const int e = eid[(size_t)t * 128 + k];
        const float g = gate[(size_t)t * 128 + k];
        const v4u uw = *(const v4u*)(U8 + (size_t)e * 1024 + lane * 16);
        float s = 0.f;
#pragma unroll
        for (int j = 0; j < 4; ++j) { const f32x2 a = __builtin_amdgcn_cvt_pk_f32_fp8((int)uw[j], false), c = __builtin_amdgcn_cvt_pk_f32_fp8((int)uw[j], true);
            s += a[0] * x[4 * j] + a[1] * x[4 * j + 1] + c[0] * x[4 * j + 2] + c[1] * x[4 * j + 3]; }
        s = wave_sum(s);
        const float coef = g * gelu_tanh(s * rstd * isu[e]) * isv[e];
        const v4u vw = *(const v4u*)(V8 + (size_t)e * 1024 + lane * 16);
#pragma unroll
        for (int j = 0; j < 4; ++j) { const f32x2 a = __builtin_amdgcn_cvt_pk_f32_fp8((int)vw[j], false), c = __builtin_amdgcn_cvt_pk_f32_fp8((int)vw[j], true);
            acc[4 * j] = fmaf(coef, a[0], acc[4 * j]); acc[4 * j + 1] = fmaf(coef, a[1], acc[4 * j + 1]); acc[4 * j + 2] = fmaf(coef, c[0], acc[4 * j + 2]); acc[4 * j + 3] = fmaf(coef, c[1], acc[4 * j + 3]); }
    }
    float ss = 0.f;
#pragma unroll
    for (int j = 0; j < 16; ++j) { acc[j] += x[j]; ss += acc[j] * acc[j]; }
    ss = wave_sum(ss);
#pragma unroll
    for (int j = 0; j < 4; ++j) { f32x4 o = {acc[4 * j], acc[4 * j + 1], acc[4 * j + 2], acc[4 * j + 3]}; *(f32x4*)(h + (size_t)t * 1024 + lane * 16 + 4 * j) = o; }
    v4u o0, o1; o0.x = pk2(acc[0], acc[1]); o0.y = pk2(acc[2], acc[3]); o0.z = pk2(acc[4], acc[5]); o0.w = pk2(acc[6], acc[7]);
    o1.x = pk2(acc[8], acc[9]); o1.y = pk2(acc[10], acc[11]); o1.z = pk2(acc[12], acc[13]); o1.w = pk2(acc[14], acc[15]);
    *(v4u*)(hb + (size_t)t * 1024 + lane * 16) = o0; *(v4u*)(hb + (size_t)t * 1024 + lane * 16 + 8) = o1;
    if (lane == 0) ssp_out[t] = ss;
}
}

typedef short v4i16_t __attribute__((ext_vector_type(4)));
__device__ __forceinline__ int crow(int r, int hi) { return (r & 3) + 8 * (r >> 2) + 4 * hi; }
__device__ __forceinline__ unsigned cvtpk(float lo, float hi) { typedef __bf16 bf16x2_t __attribute__((ext_vector_type(2))); f32x2 v = {lo, hi}; bf16x2_t b = __builtin_convertvector(v, bf16x2_t); return __builtin_bit_cast(unsigned, b); }
__device__ __forceinline__ bf16x8 mk8(unsigned a, unsigned b, unsigned c, unsigned d) { v4u w = {a, b, c, d}; return __builtin_bit_cast(bf16x8, w); }
__device__ __forceinline__ bf16x8 vfrag(LAS const unsigned char* p) {
    const v4i16_t lo = __builtin_amdgcn_ds_read_tr16_b64_v4i16((LAS v4i16_t*)p), hi = __builtin_amdgcn_ds_read_tr16_b64_v4i16((LAS v4i16_t*)(p + 512));
    return (bf16x8){lo[0], lo[1], lo[2], lo[3], hi[0], hi[1], hi[2], hi[3]};
}
__device__ __forceinline__ void vtile_load(v4u (&vv)[8], const bf16* vp0, int pitch, int lane) {
    const bf16* vp = vp0 + (size_t)(lane >> 3) * pitch + (lane & 7) * 8;
#pragma unroll
    for (int i = 0; i < 8; ++i) vv[i] = *(const v4u*)(vp + (size_t)i * 8 * pitch);
}
__device__ __forceinline__ void vtile_store(const v4u (&vv)[8], LAS unsigned char* wl, int lane) {
    const int c = lane & 7;
#pragma unroll
    for (int i = 0; i < 8; ++i) { const int kv = 8 * i + (lane >> 3); *(LAS v4u*)(wl + (c >> 2) * 4096 + (kv >> 4) * 1024 + (kv & 15) * 64 + (c & 3) * 16) = vv[i]; }
}
__device__ __forceinline__ void otile_store(const f32x16& o0, const f32x16& o1, LAS unsigned char* stg, bf16* Orow0, int pitch, int lane) {
    const int r32 = lane & 31, hi = lane >> 5;
    LAS unsigned short* s16 = (LAS unsigned short*)stg;
#pragma unroll
    for (int r = 0; r < 16; ++r) { const int orow = crow(r, hi); s16[orow * 64 + r32] = (unsigned short)f2bf(o0[r]); s16[orow * 64 + 32 + r32] = (unsigned short)f2bf(o1[r]); }
#pragma unroll
    for (int i = 0; i < 4; ++i) { const int row = i * 8 + (lane >> 3), ch = lane & 7; const v4u v = *(LAS const v4u*)(stg + row * 128 + ch * 16); *(v4u*)(Orow0 + (size_t)row * pitch + ch * 8) = v; }
}
#define MFMA32(A, B, C) __builtin_amdgcn_mfma_f32_32x32x16_bf16((A), (B), (C), 0, 0, 0)

__device__ __forceinline__ void sb_unit(const bf16* Q, const bf16* K, const bf16* V, bf16* O, int b, int h, int t0, LAS unsigned char* wl, int lane,
                                        const bf16x8 tri0, const bf16x8 tri1, const bf16x8 ones) {
    const int r32 = lane & 31, hi = lane >> 5;
    const size_t rowb = (size_t)b * S;
    const bf16* qp = Q + (rowb + t0 + r32) * 1024 + h * 64 + hi * 8;
    bf16x8 qf[4];
#pragma unroll
    for (int d0 = 0; d0 < 4; ++d0) qf[d0] = *(const bf16x8*)(qp + d0 * 16);
    f32x16 o0 = {}, o1 = {};
    float carry = 0.f;
    const int tdiag = t0 >> 6;
    LAS const unsigned char* vb = wl + ((lane >> 4) & 1) * 32 + (lane & 3) * 8 + (4 * hi + ((lane & 15) >> 2)) * 64;
    bf16x8 kf[8]; v4u vv[8];
#define SB_LOADK(tl) do { const bf16* kp_ = K + (rowb + (tl) * 64 + r32) * 1024 + h * 64 + hi * 8; \
        _Pragma("unroll") for (int d0 = 0; d0 < 4; ++d0) { kf[2 * d0] = *(const bf16x8*)(kp_ + d0 * 16); kf[2 * d0 + 1] = *(const bf16x8*)(kp_ + 32 * 1024 + d0 * 16); } } while (0)
    SB_LOADK(tdiag); vtile_load(vv, V + (rowb + tdiag * 64) * 1024 + h * 64, 1024, lane);
    for (int tile = tdiag; tile >= 0; --tile) {
        const int s0 = tile * 64, tn = tile > 0 ? tile - 1 : 0;
        f32x16 p0 = {}, p1 = {};
#pragma unroll
        for (int d0 = 0; d0 < 4; ++d0) { p0 = MFMA32(kf[2 * d0], qf[d0], p0); p1 = MFMA32(kf[2 * d0 + 1], qf[d0], p1); }
        SB_LOADK(tn);
        vtile_store(vv, wl, lane);
        vtile_load(vv, V + (rowb + tn * 64) * 1024 + h * 64, 1024, lane);
        const int lim = t0 + r32 - s0;
        unsigned lw[16]; float sumL = 0.f;
#pragma unroll
        for (int r = 0; r < 16; r += 2) {
            float La[2], Lb[2];
#pragma unroll
            for (int q = 0; q < 2; ++q) {
                { const float zc = fminf(p0[r + q], 126.f); const float sp = __builtin_amdgcn_logf(1.f + __builtin_amdgcn_exp2f(zc)); const bool ok = crow(r + q, hi) < lim;
                  La[q] = ok ? -sp : 0.f; p0[r + q] = ok ? zc - sp : -INFINITY; }
                { const float zc = fminf(p1[r + q], 126.f); const float sp = __builtin_amdgcn_logf(1.f + __builtin_amdgcn_exp2f(zc)); const bool ok = crow(r + q, hi) + 32 < lim;
                  Lb[q] = ok ? -sp : 0.f; p1[r + q] = ok ? zc - sp : -INFINITY; }
            }
            sumL += (La[0] + La[1]) + (Lb[0] + Lb[1]);
            lw[r >> 1] = cvtpk(La[0], La[1]); lw[8 + (r >> 1)] = cvtpk(Lb[0], Lb[1]);
        }
        f32x16 cinit;
#pragma unroll
        for (int r = 0; r < 16; ++r) cinit[r] = carry;
        const bf16x8 x00 = mk8(lw[0], lw[1], lw[2], lw[3]), x01 = mk8(lw[4], lw[5], lw[6], lw[7]), x10 = mk8(lw[8], lw[9], lw[10], lw[11]), x11 = mk8(lw[12], lw[13], lw[14], lw[15]);
        f32x16 y0 = MFMA32(tri0, x00, cinit); y0 = MFMA32(tri1, x01, y0); y0 = MFMA32(ones, x10, y0); y0 = MFMA32(ones, x11, y0);
        f32x16 y1 = MFMA32(tri0, x10, cinit); y1 = MFMA32(tri1, x11, y1);
        unsigned aw[16];
#pragma unroll
        for (int r = 0; r < 16; r += 2) {
            const float a0 = __builtin_amdgcn_exp2f(p0[r] + y0[r]), a1 = __builtin_amdgcn_exp2f(p0[r + 1] + y0[r + 1]);
            const float c0 = __builtin_amdgcn_exp2f(p1[r] + y1[r]), c1 = __builtin_amdgcn_exp2f(p1[r + 1] + y1[r + 1]);
            aw[r >> 1] = cvtpk(a0, a1); aw[8 + (r >> 1)] = cvtpk(c0, c1);
        }
#pragma unroll
        for (int ks = 0; ks < 4; ++ks) {
            const bf16x8 pa = mk8(aw[4 * ks], aw[4 * ks + 1], aw[4 * ks + 2], aw[4 * ks + 3]);
            o0 = MFMA32(pa, vfrag(vb + ks * 1024), o0);
            o1 = MFMA32(pa, vfrag(vb + 4096 + ks * 1024), o1);
        }
        { const auto rr = __builtin_amdgcn_permlane32_swap(__float_as_uint(sumL), __float_as_uint(sumL), false, false); carry += __uint_as_float(rr[0]) + __uint_as_float(rr[1]); }
        if (__all(carry < -160.f)) break;
    }
#undef SB_LOADK
    otile_store(o0, o1, wl + 8192, O + (rowb + t0) * 1024 + h * 64, 1024, lane);
}
__device__ __forceinline__ void phase_sbatt(const bf16* Q, const bf16* K, const bf16* V, bf16* O, LAS unsigned char* lds, int vcu, int G, int wave, int lane) {
    const int r32 = lane & 31, hi = lane >> 5;
    unsigned t0w[4], t1w[4];
#pragma unroll
    for (int j = 0; j < 8; ++j) {
        const int kv0 = 8 * (j >> 2) + 4 * hi + (j & 3);
        const unsigned b0 = (kv0 > r32) ? 0x3F80u : 0u, b1 = (kv0 + 16 > r32) ? 0x3F80u : 0u;
        if (j & 1) { t0w[j >> 1] |= b0 << 16; t1w[j >> 1] |= b1 << 16; } else { t0w[j >> 1] = b0; t1w[j >> 1] = b1; }
    }
    const bf16x8 tri0 = mk8(t0w[0], t0w[1], t0w[2], t0w[3]), tri1 = mk8(t1w[0], t1w[1], t1w[2], t1w[3]), ones = mk8(0x3F803F80u, 0x3F803F80u, 0x3F803F80u, 0x3F803F80u);
    LAS unsigned char* wl = lds + wave * 12288;
    const int nunits = NB * 16 * (S / 32);
    for (int it = 0; ; ++it) {
        const int u = (it * G + vcu) * NWAVES + wave;
        if (u >= nunits) break;
        const int bh = u >> 7, qb = u & 127;
        sb_unit(Q, K, V, O, bh >> 4, bh & 15, qb * 32, wl, lane, tri0, tri1, ones);
    }
}

__device__ __forceinline__ void sw_unit(const bf16* QKV, const float* qg, const float* kg, float sink2, float slope2, bf16* O, int b, int h, int t0, LAS unsigned char* wl, int lane) {
    const int r32 = lane & 31, hi = lane >> 5, kvh = h >> 2;
    const size_t rowb = (size_t)b * S;
    LAS float* wsf = (LAS float*)(wl + 12288);
    bf16x8 qf[4];
    {
        const bf16* qp = QKV + (rowb + t0 + r32) * 1536 + h * 64 + hi * 8;
        v4u raw[4]; float ss = 0.f;
#pragma unroll
        for (int d0 = 0; d0 < 4; ++d0) { raw[d0] = *(const v4u*)(qp + d0 * 16);
#pragma unroll
            for (int w = 0; w < 4; ++w) { const float a = bflo(raw[d0][w]), c = bfhi(raw[d0][w]); ss += a * a + c * c; } }
        { const auto rr = __builtin_amdgcn_permlane32_swap(__float_as_uint(ss), __float_as_uint(ss), false, false); ss = __uint_as_float(rr[0]) + __uint_as_float(rr[1]); }
        const float rq = rsqrtf(ss * (1.f / 64.f) + 1e-6f) * C2;
#pragma unroll
        for (int d0 = 0; d0 < 4; ++d0) { const f32x4 g0 = *(const f32x4*)(qg + d0 * 16 + hi * 8) * *(const f32x4*)(kg + d0 * 16 + hi * 8), g1 = *(const f32x4*)(qg + d0 * 16 + hi * 8 + 4) * *(const f32x4*)(kg + d0 * 16 + hi * 8 + 4);
            qf[d0] = mk8(cvtpk(bflo(raw[d0][0]) * rq * g0[0], bfhi(raw[d0][0]) * rq * g0[1]), cvtpk(bflo(raw[d0][1]) * rq * g0[2], bfhi(raw[d0][1]) * rq * g0[3]),
                         cvtpk(bflo(raw[d0][2]) * rq * g1[0], bfhi(raw[d0][2]) * rq * g1[1]), cvtpk(bflo(raw[d0][3]) * rq * g1[2], bfhi(raw[d0][3]) * rq * g1[3])); }
    }
    float m = sink2, l = 1.f;
    f32x16 o0 = {}, o1 = {};
    LAS const unsigned char* vb = wl + ((lane >> 4) & 1) * 32 + (lane & 3) * 8 + (4 * hi + ((lane & 15) >> 2)) * 64;
    const int thi = t0 >> 6, tlo = (t0 >= 127) ? ((t0 - 127) >> 6) : 0;
    v4u kf[8], vv[8];
#define SW_LOADK(tl) do { _Pragma("unroll") for (int half = 0; half < 2; ++half) { const bf16* kp_ = QKV + (rowb + (tl) * 64 + 32 * half + r32) * 1536 + 1024 + kvh * 64 + hi * 8; \
        _Pragma("unroll") for (int d0 = 0; d0 < 4; ++d0) kf[2 * d0 + half] = *(const v4u*)(kp_ + d0 * 16); } } while (0)
    SW_LOADK(thi); vtile_load(vv, QKV + (rowb + thi * 64) * 1536 + 1280 + kvh * 64, 1536, lane);
    for (int tile = thi; tile >= tlo; --tile) {
        const int s0 = tile * 64, tn = tile > tlo ? tile - 1 : tlo;
#pragma unroll
        for (int half = 0; half < 2; ++half) {
            float ss = 0.f;
#pragma unroll
            for (int d0 = 0; d0 < 4; ++d0)
#pragma unroll
                for (int w = 0; w < 4; ++w) { const float a = bflo(kf[2 * d0 + half][w]), c = bfhi(kf[2 * d0 + half][w]); ss += a * a + c * c; }
            { const auto rr = __builtin_amdgcn_permlane32_swap(__float_as_uint(ss), __float_as_uint(ss), false, false); ss = __uint_as_float(rr[0]) + __uint_as_float(rr[1]); }
            if (hi == half) wsf[32 * half + r32] = rsqrtf(ss * (1.f / 64.f) + 1e-6f);
        }
        f32x16 p0 = {}, p1 = {};
#pragma unroll
        for (int d0 = 0; d0 < 4; ++d0) { p0 = MFMA32(__builtin_bit_cast(bf16x8, kf[2 * d0]), qf[d0], p0); p1 = MFMA32(__builtin_bit_cast(bf16x8, kf[2 * d0 + 1]), qf[d0], p1); }
        SW_LOADK(tn);
        vtile_store(vv, wl, lane);
        vtile_load(vv, QKV + (rowb + tn * 64) * 1536 + 1280 + kvh * 64, 1536, lane);
        const int dq = t0 + r32 - s0;
        float rmax = -INFINITY;
#pragma unroll
        for (int g = 0; g < 4; ++g) {
            const f32x4 rk0 = *(LAS const f32x4*)(wsf + 8 * g + 4 * hi), rk1 = *(LAS const f32x4*)(wsf + 32 + 8 * g + 4 * hi);
#pragma unroll
            for (int j = 0; j < 4; ++j) { const int r = 4 * g + j;
                { const int dist = dq - crow(r, hi); const bool ok = dist >= 0 && dist < 128; p0[r] = ok ? p0[r] * rk0[j] - slope2 * (float)dist : -INFINITY; rmax = fmaxf(rmax, p0[r]); }
                { const int dist = dq - crow(r, hi) - 32; const bool ok = dist >= 0 && dist < 128; p1[r] = ok ? p1[r] * rk1[j] - slope2 * (float)dist : -INFINITY; rmax = fmaxf(rmax, p1[r]); } }
        }
        { const auto rr = __builtin_amdgcn_permlane32_swap(__float_as_uint(rmax), __float_as_uint(rmax), false, false); rmax = fmaxf(__uint_as_float(rr[0]), __uint_as_float(rr[1])); }
        const float mn = fmaxf(m, rmax);
        const float alpha = __builtin_amdgcn_exp2f(m - mn);
        m = mn;
        float rsum = 0.f; unsigned aw[16];
#pragma unroll
        for (int r = 0; r < 16; r += 2) {
            const float a0 = __builtin_amdgcn_exp2f(p0[r] - mn), a1 = __builtin_amdgcn_exp2f(p0[r + 1] - mn), c0 = __builtin_amdgcn_exp2f(p1[r] - mn), c1 = __builtin_amdgcn_exp2f(p1[r + 1] - mn);
            rsum += (a0 + a1) + (c0 + c1);
            aw[r >> 1] = cvtpk(a0, a1); aw[8 + (r >> 1)] = cvtpk(c0, c1);
        }
        { const auto rr = __builtin_amdgcn_permlane32_swap(__float_as_uint(rsum), __float_as_uint(rsum), false, false); rsum = __uint_as_float(rr[0]) + __uint_as_float(rr[1]); }
        l = l * alpha + rsum;
        if (hi == 0) wsf[64 + r32] = alpha;
#pragma unroll
        for (int g = 0; g < 4; ++g) { const f32x4 f = *(LAS const f32x4*)(wsf + 64 + 8 * g + 4 * hi);
#pragma unroll
            for (int j = 0; j < 4; ++j) { o0[4 * g + j] *= f[j]; o1[4 * g + j] *= f[j]; } }
#pragma unroll
        for (int ks = 0; ks < 4; ++ks) {
            const bf16x8 pa = mk8(aw[4 * ks], aw[4 * ks + 1], aw[4 * ks + 2], aw[4 * ks + 3]);
            o0 = MFMA32(pa, vfrag(vb + ks * 1024), o0);
            o1 = MFMA32(pa, vfrag(vb + 4096 + ks * 1024), o1);
        }
    }
#undef SW_LOADK
    if (hi == 0) wsf[64 + r32] = 1.f / l;
#pragma unroll
    for (int g = 0; g < 4; ++g) { const f32x4 f = *(LAS const f32x4*)(wsf + 64 + 8 * g + 4 * hi);
#pragma unroll
        for (int j = 0; j < 4; ++j) { o0[4 * g + j] *= f[j]; o1[4 * g + j] *= f[j]; } }
    otile_store(o0, o1, wl + 8192, O + (rowb + t0) * 1024 + h * 64, 1024, lane);
}
__device__ __forceinline__ void phase_swatt(const bf16* QKV, const float* qg, const float* kg, const float* sinks, bf16* O, LAS unsigned char* lds, int vcu, int G, int wave, int lane) {
    LAS unsigned char* wl = lds + wave * 12800;
    const int nunits = NB * 16 * (S / 32);
    for (int it = 0; ; ++it) {
        const int u = (it * G + vcu) * NWAVES + wave;
        if (u >= nunits) break;
        const int bh = u >> 7, qb = u & 127, h = bh & 15;
        sw_unit(QKV, qg, kg, sinks[h] * LOG2E, exp2f(-0.5f * (float)(h + 1)) * LOG2E, O, bh >> 4, h, qb * 32, wl, lane);
    }
}

__device__ __forceinline__ void ce_desc(float& a, float& b) { float mx, mn; asm("v_max_f32_e32 %0, %1, %2" : "=v"(mx) : "v"(a), "v"(b)); asm("v_min_f32_e32 %0, %1, %2" : "=v"(mn) : "v"(a), "v"(b)); a = mx; b = mn; }
__device__ __forceinline__ float maxf_raw(float a, float b) { float mx; asm("v_max_f32_e32 %0, %1, %2" : "=v"(mx) : "v"(a), "v"(b)); return mx; }
__device__ __forceinline__ void sort16_desc(float (&v)[16]) {
#pragma unroll
    for (int k = 2; k <= 16; k <<= 1)
#pragma unroll
        for (int j = k >> 1; j > 0; j >>= 1)
#pragma unroll
            for (int i = 0; i < 16; ++i) { const int l = i ^ j; if (l > i) { if ((i & k) == 0) ce_desc(v[i], v[l]); else ce_desc(v[l], v[i]); } }
}
__device__ __forceinline__ void merge16_desc(float (&a)[16], const float (&b)[16]) {
#pragma unroll
    for (int i = 0; i < 16; ++i) a[i] = maxf_raw(a[i], b[15 - i]);
#pragma unroll
    for (int j = 8; j > 0; j >>= 1)
#pragma unroll
        for (int i = 0; i < 16; ++i) { const int l = i ^ j; if (l > i) ce_desc(a[i], a[l]); }
}
__device__ __forceinline__ void top16_of_4x16(float (&g0)[16], float (&g1)[16], float (&g2)[16], float (&g3)[16]) {
    sort16_desc(g0); sort16_desc(g1); sort16_desc(g2); sort16_desc(g3);
    merge16_desc(g0, g1); merge16_desc(g2, g3); merge16_desc(g0, g2);
}
__device__ __forceinline__ float setcode(float v, unsigned clear_mask, unsigned code) { return __uint_as_float((__float_as_uint(v) & clear_mask) | code); }

__device__ __forceinline__ void topk_unit(const bf16* QP, const bf16* SUBK, unsigned short* EID, float* GATE, int tt, int h, int lane) {
    const int r32 = lane & 31, hi = lane >> 5;
    float L[2][16];
#pragma unroll
    for (int p = 0; p < 2; ++p) {
        const bf16* qp = QP + (size_t)(tt * 32 + r32) * 2048 + h * 256 + p * 128 + hi * 8;
        bf16x8 qf[8];
#pragma unroll
        for (int ks = 0; ks < 8; ++ks) qf[ks] = *(const bf16x8*)(qp + ks * 16);
        const bf16* kp = SUBK + ((size_t)(h * 2 + p) * 128 + r32) * 128 + hi * 8;
        float g[4][16];
        bf16x8 afA[8], afB[8];
#define TK_LOAD(af, mt) do { _Pragma("unroll") for (int ks = 0; ks < 8; ++ks) af[ks] = *(const bf16x8*)(kp + (size_t)(mt) * 32 * 128 + ks * 16); } while (0)
#define TK_MMA(af, mt) do { f32x16 acc = {}; _Pragma("unroll") for (int ks = 0; ks < 8; ++ks) acc = MFMA32(af[ks], qf[ks], acc); \
        _Pragma("unroll") for (int r = 0; r < 16; ++r) g[mt][r] = setcode(acc[r], 0xFFFFFF80u, (unsigned)(32 * (mt) + (r & 3) + 8 * (r >> 2))); } while (0)
        TK_LOAD(afA, 0); asm volatile("" ::: "memory");
        TK_LOAD(afB, 1); asm volatile("" ::: "memory"); TK_MMA(afA, 0);
        TK_LOAD(afA, 2); asm volatile("" ::: "memory"); TK_MMA(afB, 1);
        TK_LOAD(afB, 3); asm volatile("" ::: "memory"); TK_MMA(afA, 2);
        TK_MMA(afB, 3);
#undef TK_LOAD
#undef TK_MMA
        top16_of_4x16(g[0], g[1], g[2], g[3]);
        float other[16];
#pragma unroll
        for (int i = 0; i < 16; ++i) {
            g[0][i] = __uint_as_float(__float_as_uint(g[0][i]) | (unsigned)(hi << 2));
            const auto rr = __builtin_amdgcn_permlane32_swap(__float_as_uint(g[0][i]), __float_as_uint(g[0][i]), false, false);
            other[i] = __uint_as_float(hi ? rr[0] : rr[1]);
        }
        merge16_desc(g[0], other);
#pragma unroll
        for (int i = 0; i < 16; ++i) L[p][i] = g[0][i];
    }
    unsigned TA[4], TB[4];
#pragma unroll
    for (int k = 0; k < 16; ++k) {
        const unsigned ca = (__float_as_uint(L[0][k]) & 0x7Fu) << (8 * (k & 3)), cb = (__float_as_uint(L[1][k]) & 0x7Fu) << (8 * (k & 3));
        if ((k & 3) == 0) { TA[k >> 2] = ca; TB[k >> 2] = cb; } else { TA[k >> 2] |= ca; TB[k >> 2] |= cb; }
    }
    float c[4][16];
    {
        int n = 0;
#pragma unroll
        for (int i = 0; i < 16; ++i)
#pragma unroll
            for (int j = 0; j < 16; ++j)
                if ((i + 1) * (j + 1) <= 16) { c[n >> 4][n & 15] = setcode(L[0][i] + L[1][j], 0xFFFFFF00u, (unsigned)(i * 16 + j)); ++n; }
#pragma unroll
        for (int k = 50; k < 64; ++k) c[k >> 4][k & 15] = -INFINITY;
    }
    top16_of_4x16(c[0], c[1], c[2], c[3]);
    float ex[16]; float den = 0.f;
#pragma unroll
    for (int r = 0; r < 16; ++r) { ex[r] = __builtin_amdgcn_exp2f((c[0][r] - c[0][0]) * LOG2E); den += ex[r]; }
    const float inv = 1.f / den;
    unsigned eidv[16];
#pragma unroll
    for (int r = 0; r < 16; ++r) {
        const unsigned code = __float_as_uint(c[0][r]) & 0xFFu, i = code >> 4, j = code & 15u;
        const unsigned sa = (i & 7u) | 0x0C0C0C00u, sb = (j & 7u) | 0x0C0C0C00u;
        const unsigned ia = (i & 8u) ? __builtin_amdgcn_perm(TA[3], TA[2], sa) : __builtin_amdgcn_perm(TA[1], TA[0], sa);
        const unsigned ib = (j & 8u) ? __builtin_amdgcn_perm(TB[3], TB[2], sb) : __builtin_amdgcn_perm(TB[1], TB[0], sb);
        eidv[r] = ia * 128u + ib;
        ex[r] *= inv;
    }
    if (hi == 0) {
        const size_t off = (size_t)(tt * 32 + r32) * 128 + h * 16;
        v4u e0 = {eidv[0] | (eidv[1] << 16), eidv[2] | (eidv[3] << 16), eidv[4] | (eidv[5] << 16), eidv[6] | (eidv[7] << 16)}, e1 = {eidv[8] | (eidv[9] << 16), eidv[10] | (eidv[11] << 16), eidv[12] | (eidv[13] << 16), eidv[14] | (eidv[15] << 16)};
        *(v4u*)(EID + off) = e0; *(v4u*)(EID + off + 8) = e1;
#pragma unroll
        for (int q = 0; q < 4; ++q) { f32x4 g4 = {ex[4 * q], ex[4 * q + 1], ex[4 * q + 2], ex[4 * q + 3]}; *(f32x4*)(GATE + off + 4 * q) = g4; }
    }
}
__device__ __forceinline__ void phase_topk(const bf16* QP, const bf16* SUBK, unsigned short* EID, float* GATE, int vcu, int G, int wave, int lane) {
    const int nunits = (T / 32) * 8;
    for (int it = 0; ; ++it) {
        const int u = (it * G + vcu) * NWAVES + wave;
        if (u >= nunits) break;
        topk_unit(QP, SUBK, EID, GATE, u >> 3, u & 7, lane);
    }
}

__device__ __forceinline__ float gelu_tanh_f(float x) { const float u = 0.7978845608028654f * (x + 0.044715f * x * x * x); const float e = __builtin_amdgcn_exp2f(u * (2.f * LOG2E)); return x * (1.f - __builtin_amdgcn_rcpf(e + 1.f)); }
__device__ __forceinline__ void gather_token(float* h, const float* ssp_in, int np, const unsigned char* U8, const unsigned char* V8, const float* isu, const float* isv,
                                             const int* eid, const float* gate, bf16* hb, float* ssp_out, int t, int lane) {
    float x[16], acc[16];
#pragma unroll
    for (int j = 0; j < 4; ++j) { const f32x4 v = *(const f32x4*)(h + (size_t)t * 1024 + lane * 16 + 4 * j); x[4 * j] = v[0]; x[4 * j + 1] = v[1]; x[4 * j + 2] = v[2]; x[4 * j + 3] = v[3]; }
#pragma unroll
    for (int j = 0; j < 16; ++j) acc[j] = 0.f;
    float ssum = 0.f; for (int p = 0; p < np; ++p) ssum += ssp_in[(size_t)p * T + t];
    const float rstd = rsqrtf(ssum * (1.f / 1024.f) + 1e-6f);
    for (int k = 0; k < 128; ++k) {
        const int e = eid[(size_t)t * 128 + k];
        const float g = gate[(size_t)t * 128 + k];
        const v4u uw = *(const v4u*)(U8 + (size_t)e * 1024 + lane * 16);
        const v4u vw = *(const v4u*)(V8 + (size_t)e * 1024 + lane * 16);
        float s = 0.f;
#pragma unroll
        for (int j = 0; j < 4; ++j) { const f32x2 a = __builtin_amdgcn_cvt_pk_f32_fp8((int)uw[j], false), c = __builtin_amdgcn_cvt_pk_f32_fp8((int)uw[j], true);
            s += a[0] * x[4 * j] + a[1] * x[4 * j + 1] + c[0] * x[4 * j + 2] + c[1] * x[4 * j + 3]; }
        s = wave_sum(s);
        const float coef = g * gelu_tanh_f(s * rstd * isu[e]) * isv[e];
#pragma unroll
        for (int j = 0; j < 4; ++j) { const f32x2 a = __builtin_amdgcn_cvt_pk_f32_fp8((int)vw[j], false), c = __builtin_amdgcn_cvt_pk_f32_fp8((int)vw[j], true);
            acc[4 * j] = fmaf(coef, a[0], acc[4 * j]); acc[4 * j + 1] = fmaf(coef, a[1], acc[4 * j + 1]); acc[4 * j + 2] = fmaf(coef, c[0], acc[4 * j + 2]); acc[4 * j + 3] = fmaf(coef, c[1], acc[4 * j + 3]); }
    }
    float ss = 0.f;
#pragma unroll
    for (int j = 0; j < 16; ++j) { acc[j] += x[j]; ss += acc[j] * acc[j]; }
    ss = wave_sum(ss);
#pragma unroll
    for (int j = 0; j < 4; ++j) { f32x4 o = {acc[4 * j], acc[4 * j + 1], acc[4 * j + 2], acc[4 * j + 3]}; *(f32x4*)(h + (size_t)t * 1024 + lane * 16 + 4 * j) = o; }
    v4u o0, o1; o0.x = pk2(acc[0], acc[1]); o0.y = pk2(acc[2], acc[3]); o0.z = pk2(acc[4], acc[5]); o0.w = pk2(acc[6], acc[7]);
    o1.x = pk2(acc[8], acc[9]); o1.y = pk2(acc[10], acc[11]); o1.z = pk2(acc[12], acc[13]); o1.w = pk2(acc[14], acc[15]);
    *(v4u*)(hb + (size_t)t * 1024 + lane * 16) = o0; *(v4u*)(hb + (size_t)t * 1024 + lane * 16 + 8) = o1;
    if (lane == 0) ssp_out[t] = ss;
}
__device__ __forceinline__ void phase_gather(float* h, const float* ssp_in, int np, const unsigned char* U8, const unsigned char* V8, const float* isu, const float* isv,
                                             const int* eid, const float* gate, bf16* hb, float* ssp_out, int gw, int NGW, int lane) {
    for (int t = gw; t < T; t += NGW) gather_token(h, ssp_in, np, U8, V8, isu, isv, eid, gate, hb, ssp_out, t, lane);
}

#define DPP_ADD(s, CTRL) do { (s) += __builtin_bit_cast(float, __builtin_amdgcn_update_dpp(0, __builtin_bit_cast(int, (s)), (CTRL), 0xF, 0xF, true)); } while (0)
#define DPP_XOR1 0xB1
#define DPP_XOR2 0x4E
#define DPP_HALF_MIRROR 0x141
#define DPP_ROW_MIRROR 0x140
#define DPP_ROW_ROR8 0x128

__device__ __forceinline__ void peer_rows(v4u (&row)[16], const v4u (&ev)[2], const unsigned char* tab, unsigned lane_off) {
#pragma unroll
    for (int j = 0; j < 16; ++j) { const unsigned w = ev[j >> 3][(j >> 1) & 3]; const unsigned e10 = (j & 1) ? ((w >> 6) & 0x3FFFC00u) : ((w & 0xFFFFu) << 10);
        row[j] = *(const v4u*)(tab + (size_t)(e10 + lane_off)); }
}
__device__ __forceinline__ void fmac_s(float& acc, float a, float b) { asm("v_fmac_f32_e32 %0, %1, %2" : "+v"(acc) : "v"(a), "v"(b)); }
__device__ __forceinline__ float fmul_s(float a, float b) { float r; asm("v_mul_f32_e32 %0, %1, %2" : "=v"(r) : "v"(a), "v"(b)); return r; }
__device__ __forceinline__ float fadd_s(float a, float b) { float r; asm("v_add_f32_e32 %0, %1, %2" : "=v"(r) : "v"(a), "v"(b)); return r; }
#define DPP_ADD_ASM(d, s, CTRL) asm("s_nop 1\n\tv_add_f32_dpp %0, %1, %1 " CTRL " row_mask:0xf bank_mask:0xf" : "=v"(d) : "v"(s))
typedef _Float16 h16x2 __attribute__((ext_vector_type(2)));
__device__ __forceinline__ void peer_u_token(const v4u (&row)[16], const v4u (&xw)[2], _Float16* hp_t, int r, int c) {
    h16x2 xh[8];
#pragma unroll
    for (int w = 0; w < 8; ++w) { const unsigned d = xw[w >> 2][w & 3]; xh[w] = (h16x2){(_Float16)bflo(d), (_Float16)bfhi(d)}; }
    float p[16];
#pragma unroll
    for (int j = 0; j < 16; ++j) {
        h16x2 s0 = {(_Float16)0.f, (_Float16)0.f}, s1 = s0;
#pragma unroll
        for (int w = 0; w < 4; ++w) {
            const h16x2 lo = __builtin_amdgcn_cvt_scalef32_pk_f16_fp8((int)row[j][w], 0.0625f, false), hi = __builtin_amdgcn_cvt_scalef32_pk_f16_fp8((int)row[j][w], 0.0625f, true);
            s0 = __builtin_elementwise_fma(lo, xh[2 * w], s0); s1 = __builtin_elementwise_fma(hi, xh[2 * w + 1], s1);
        }
        const h16x2 ss = s0 + s1;
        float t = fadd_s((float)ss[0], (float)ss[1]), u;
        DPP_ADD_ASM(u, t, "quad_perm:[1,0,3,2]"); DPP_ADD_ASM(t, u, "quad_perm:[2,3,0,1]"); DPP_ADD_ASM(u, t, "row_half_mirror");
        p[j] = u;
    }
    if (c == 0) {
        v4u o0, o1;
#pragma unroll
        for (int q = 0; q < 4; ++q) { o0[q] = __builtin_bit_cast(unsigned, (h16x2){(_Float16)p[2 * q], (_Float16)p[2 * q + 1]}); o1[q] = __builtin_bit_cast(unsigned, (h16x2){(_Float16)p[8 + 2 * q], (_Float16)p[8 + 2 * q + 1]}); }
        *(v4u*)(hp_t + 16 * r) = o0; *(v4u*)(hp_t + 16 * r + 8) = o1;
    }
}
__device__ __forceinline__ void glds16(const void* gsrc, unsigned lds_dst) { unsigned keep;
    asm volatile("s_mov_b32 %0, m0\n\ts_mov_b32 m0, %2\n\ts_nop 0\n\tglobal_load_lds_dwordx4 %1, off\n\ts_mov_b32 m0, %0" : "=&s"(keep) : "v"(gsrc), "s"(lds_dst) : "memory"); }
#define LDS_ADDR(p) ((unsigned)__builtin_amdgcn_readfirstlane((int)(unsigned)(uintptr_t)(p)))
typedef unsigned u32x2 __attribute__((ext_vector_type(2)));
#define FENCE() asm volatile("" ::: "memory")
#define PEER_SLOT(i) (wl + ((((i) >> 2) & 1) * 4096 + ((i) & 3) * 1024))
__device__ __forceinline__ void phase_peer_u(const bf16* h, const unsigned short* eid, const unsigned char* U8, _Float16* hp, LAS unsigned char* wl, int sl, int m, int nmem, int wave, int lane) {
    const int r = lane >> 3, c = lane & 7;
    const int nw = nmem * NWAVES, t0 = m * NWAVES + wave;
    const unsigned char* tab = U8 + 128 * sl; const unsigned loff16 = 16u * (unsigned)c;
    const int ntok = (T - t0 + nw - 1) / nw;
    _Float16* hp_s = hp + (size_t)sl * T * 128;
#define TOK(i) ((i) < ntok ? t0 + (i) * nw : t0)
#define STG_LD(k, i) do { const int t_ = TOK(i); sE[k] = *(const unsigned*)(eid + (size_t)t_ * 128 + 2 * lane); sX[k] = *(const unsigned*)(h + (size_t)t_ * 1024 + 128 * sl + 2 * lane); } while (0)
#define STG_ST(k, i) do { LAS unsigned char* s_ = PEER_SLOT(i); *(LAS unsigned*)(s_ + 4 * lane) = sE[k]; *(LAS unsigned*)(s_ + 512 + 4 * lane) = sX[k]; } while (0)
#define RD_EV(i) do { LAS const unsigned char* s_ = PEER_SLOT(i); ev[0] = *(LAS const v4u*)(s_ + 32 * r); ev[1] = *(LAS const v4u*)(s_ + 32 * r + 16); } while (0)
#define RD_X(i) do { LAS const unsigned char* s_ = PEER_SLOT(i); xw[0] = *(LAS const v4u*)(s_ + 512 + 32 * c); xw[1] = *(LAS const v4u*)(s_ + 512 + 32 * c + 16); } while (0)
    v4u ev[2], rA[16], rB[16], xw[2]; unsigned sE[4], sX[4];
#pragma unroll
    for (int k = 0; k < 4; ++k) STG_LD(k, k);
    for (int i0 = 0; i0 < ntok; i0 += 4) {
#pragma unroll
        for (int k = 0; k < 4; ++k) STG_ST(k, i0 + k);
        FENCE();
        RD_EV(i0); peer_rows(rA, ev, tab, loff16); FENCE();
#pragma unroll
        for (int k = 0; k < 4; ++k) STG_LD(k, i0 + 4 + k);
        FENCE();
#pragma unroll
        for (int k = 0; k < 4; k += 2) {
            RD_EV(i0 + k + 1); peer_rows(rB, ev, tab, loff16); FENCE();
            RD_X(i0 + k); peer_u_token(rA, xw, hp_s + (size_t)TOK(i0 + k) * 128, r, c); FENCE();
            if (k + 2 < 4) { RD_EV(i0 + k + 2); peer_rows(rA, ev, tab, loff16); FENCE(); }
            RD_X(i0 + k + 1); peer_u_token(rB, xw, hp_s + (size_t)TOK(i0 + k + 1) * 128, r, c); FENCE();
        }
    }
#undef STG_LD
#undef STG_ST
#undef RD_X
}
__device__ __forceinline__ void phase_peer_coef(const _Float16* hp, const float* ssp_in, int np, const unsigned short* eid, const float* gate, const float* isu, const float* isv, _Float16* coef, int gw, int NGW, int lane) {
    for (int t = gw; t < T; t += NGW) {
        float ssum = 0.f; for (int p = 0; p < np; ++p) ssum += ssp_in[(size_t)p * T + t];
        const float rstd = rsqrtf(ssum * (1.f / 1024.f) + 1e-6f);
#pragma unroll
        for (int half = 0; half < 2; ++half) {
            const int k = lane + 64 * half; float s = 0.f;
#pragma unroll
            for (int s8 = 0; s8 < 8; ++s8) s += (float)hp[((size_t)s8 * T + t) * 128 + k];
            const int e = eid[(size_t)t * 128 + k];
            coef[(size_t)t * 128 + k] = (_Float16)(gate[(size_t)t * 128 + k] * gelu_tanh_f(s * (16.f * rstd) * isu[e]) * (256.f * isv[e]));
        }
    }
}
__device__ __forceinline__ void peer_v_token(const v4u (&row)[16], const v4u (&cw)[2], const f32x2 hold, float* hdst_l, bf16* hb_l, float* ssp_t, int lane) {
    h16x2 ah[8];
#pragma unroll
    for (int i = 0; i < 8; ++i) ah[i] = (h16x2){(_Float16)0.f, (_Float16)0.f};
#pragma unroll
    for (int j = 0; j < 16; ++j) {
        const unsigned cd = cw[j >> 3][(j >> 1) & 3]; const h16x2 ch = __builtin_bit_cast(h16x2, __builtin_amdgcn_perm(cd, cd, (j & 1) ? 0x07060706u : 0x05040504u));
#pragma unroll
        for (int w = 0; w < 4; ++w) {
            const h16x2 lo = __builtin_amdgcn_cvt_scalef32_pk_f16_fp8((int)row[j][w], 0.00390625f, false), hi = __builtin_amdgcn_cvt_scalef32_pk_f16_fp8((int)row[j][w], 0.00390625f, true);
            ah[2 * w] = __builtin_elementwise_fma(lo, ch, ah[2 * w]); ah[2 * w + 1] = __builtin_elementwise_fma(hi, ch, ah[2 * w + 1]);
        }
    }
    float acc[16];
#pragma unroll
    for (int i = 0; i < 8; ++i) { acc[2 * i] = (float)ah[i][0]; acc[2 * i + 1] = (float)ah[i][1]; }
    float a8[8], a4[4], a2[2];
#pragma unroll
    for (int i = 0; i < 8; ++i) { const auto rr = __builtin_amdgcn_permlane32_swap(__float_as_uint(acc[i]), __float_as_uint(acc[i + 8]), false, false); a8[i] = fadd_s(__uint_as_float(rr[0]), __uint_as_float(rr[1])); }
#pragma unroll
    for (int i = 0; i < 4; ++i) { const auto rr = __builtin_amdgcn_permlane16_swap(__float_as_uint(a8[i]), __float_as_uint(a8[i + 4]), false, false); a4[i] = fadd_s(__uint_as_float(rr[0]), __uint_as_float(rr[1])); }
    const bool b3 = (lane & 8) != 0;
#pragma unroll
    for (int i = 0; i < 2; ++i) { const float keep = b3 ? a4[i + 2] : a4[i]; float send = b3 ? a4[i] : a4[i + 2];
        a2[i] = keep + __builtin_bit_cast(float, __builtin_amdgcn_update_dpp(0, __builtin_bit_cast(int, send), DPP_ROW_ROR8, 0xF, 0xF, true)); }
    const float n0 = hold[0] + a2[0], n1 = hold[1] + a2[1];
    if (hdst_l) { f32x2 o = {n0, n1}; *(f32x2*)hdst_l = o; return; }
    *(unsigned*)hb_l = pk2(n0, n1);
    const float ss = wave_sum(n0 * n0 + n1 * n1);
    if (lane == 0) *ssp_t = ss;
}
#define PEER_SLOTV(i) (wl + ((((i) >> 2) & 1) * 8192 + ((i) & 3) * 2048))
__device__ __forceinline__ void phase_peer_v(const bf16* h, float* hdst, const unsigned short* eid, const _Float16* coef, const unsigned char* V8, bf16* hb, float* ssp_out, float* scratch, LAS unsigned char* wl, int sl, int m, int nmem, int wave, int lane) {
    const int r = lane >> 3, c = lane & 7;
    const int nw = nmem * NWAVES, t0 = m * NWAVES + wave;
    const unsigned char* tab = V8 + 128 * sl; const unsigned loff16 = 16u * (unsigned)c;
    const int ntok = (T - t0 + nw - 1) / nw;
    const size_t loff = 128 * sl + 16 * c + 2 * r; float* ssp_s = ssp_out + (size_t)sl * T;
#define STG_LD(k, i) do { const int t_ = TOK(i); sE[k] = *(const unsigned*)(eid + (size_t)t_ * 128 + 2 * lane); sC[k] = *(const unsigned*)(coef + (size_t)t_ * 128 + 2 * lane); sH[k] = *(const unsigned*)(h + (size_t)t_ * 1024 + 128 * sl + 2 * lane); } while (0)
#define STG_ST(k, i) do { LAS unsigned char* s_ = PEER_SLOTV(i); *(LAS unsigned*)(s_ + 4 * lane) = sE[k]; *(LAS unsigned*)(s_ + 512 + 4 * lane) = sC[k]; *(LAS unsigned*)(s_ + 1024 + 4 * lane) = sH[k]; } while (0)
#define RD_EVV(i) do { LAS const unsigned char* s_ = PEER_SLOTV(i); ev[0] = *(LAS const v4u*)(s_ + 32 * r); ev[1] = *(LAS const v4u*)(s_ + 32 * r + 16); } while (0)
#define RD_C(i) do { LAS const unsigned char* s_ = PEER_SLOTV(i); cv[0] = *(LAS const v4u*)(s_ + 512 + 32 * r); cv[1] = *(LAS const v4u*)(s_ + 512 + 32 * r + 16); { const unsigned hw_ = *(LAS const unsigned*)(s_ + 1024 + (16 * c + 2 * r) * 2); hold = (f32x2){bflo(hw_), bfhi(hw_)}; } } while (0)
#define V_TOK(i, R) do { const bool ok_ = (i) < ntok; const size_t o_ = (size_t)TOK(i) * 1024 + loff; \
        peer_v_token(R, cv, hold, hdst ? (ok_ ? hdst : scratch) + o_ : nullptr, (ok_ ? hb : (bf16*)scratch) + o_, (ok_ ? ssp_s : scratch) + TOK(i), lane); } while (0)
    v4u ev[2], rA[16], rB[16], cv[2]; f32x2 hold; unsigned sE[4], sC[4], sH[4];
#pragma unroll
    for (int k = 0; k < 4; ++k) STG_LD(k, k);
    for (int i0 = 0; i0 < ntok; i0 += 4) {
#pragma unroll
        for (int k = 0; k < 4; ++k) STG_ST(k, i0 + k);
        FENCE();
        RD_EVV(i0); peer_rows(rA, ev, tab, loff16); FENCE();
#pragma unroll
        for (int k = 0; k < 4; ++k) STG_LD(k, i0 + 4 + k);
        FENCE();
#pragma unroll
        for (int k = 0; k < 4; k += 2) {
            RD_EVV(i0 + k + 1); peer_rows(rB, ev, tab, loff16); FENCE();
            RD_C(i0 + k); V_TOK(i0 + k, rA); FENCE();
            if (k + 2 < 4) { RD_EVV(i0 + k + 2); peer_rows(rA, ev, tab, loff16); FENCE(); }
            RD_C(i0 + k + 1); V_TOK(i0 + k + 1, rB); FENCE();
        }
    }
#undef STG_LD
#undef STG_ST
#undef V_TOK
#undef RD_EVV
#undef RD_EV
#undef RD_C
#undef TOK
#undef FENCE
}

#ifndef PROBE_REP
#define PROBE_REP 0x80u
#endif
enum Phase { PH_PREP = 0, PH_QKV0 = 1, PH_SBATT = 2, PH_OPROJ0 = 3, PH_PQ0 = 4, PH_TOPK0 = 5, PH_GATH0 = 6, PH_QKV1 = 7, PH_SWATT = 8, PH_OPROJ1 = 9, PH_PQ1 = 10, PH_TOPK1 = 11, PH_GATH1 = 12, PH_N = 13 };

__global__ void __launch_bounds__(NWAVES * 64, 2) mega(Args a) {
    extern __shared__ __attribute__((aligned(16))) unsigned char lds_raw[];
    LAS unsigned char* lds = (LAS unsigned char*)lds_raw;
    volatile LAS unsigned* MISC = (volatile LAS unsigned*)(lds + MISC_OFF);
    LAS float* rs = (LAS float*)(lds + RS_OFF);
    const int tid = threadIdx.x, lane = tid & 63, wave = __builtin_amdgcn_readfirstlane(tid >> 6);
    const int G = gridDim.x; const int bx = blockIdx.x; const int vcu = (G % 8 == 0) ? (bx % 8) * (G / 8) + bx / 8 : bx;
    const int gw = vcu * NWAVES + wave, NGW = G * NWAVES;
    unsigned char* ws = a.ws;
    gu32* ctl = (gu32*)(ws + WS_CTL);
    for (int u = tid; u < 64; u += NWAVES * 64) ((LAS unsigned*)(lds + MISC_OFF))[u] = 0u;
    __syncthreads();
    XcdBarrier bar = xcd_barrier_post((unsigned*)(ctl + CW_BAR) + a.li * XCD_BAR_WORDS, MISC + 8);
    bool first = true;
#define PHASE_ON(k) ((a.mask >> (k)) & 1u)
#define SEAM() do { if (!first) xcd_barrier(bar); first = false; } while (0)

    bf16* HB = (bf16*)(ws + WS_HB); bf16* QB = (bf16*)(ws + WS_QB); bf16* AO = (bf16*)(ws + WS_AO); bf16* QP = (bf16*)(ws + WS_QP);
    float* SSP0 = (float*)(ws + WS_SSP); float* SSP1 = SSP0 + 16 * T; float* SSP2 = SSP1 + 16 * T; float* SSP3 = SSP2 + 16 * T;

#define NREP(b) (1 + (int)((PROBE_REP >> (b)) & 1u))
    if (PHASE_ON(PH_PREP)) { SEAM(); for (int q = 0; q < NREP(0); ++q) phase_prep(a, lds, gw, NGW, wave, lane); }

    if (PHASE_ON(PH_QKV0)) { SEAM();
        _Pragma("unroll") for (int q = 0; q < NREP(1); ++q) {
        pg8::Gemm g{HB, (const bf16*)(ws + WS_WQKV0), T, 3072, 1024}; pg8::StaticOrder So; So.init(T, 3072, G, bx);
        fill_rs(rs, So, SSP0, 1, tid);
        pg8::EpiScaleBf16 E{QB, 1024, 1024, (size_t)(WS_KB - WS_QB) / 2, C2, rs};
        pg8::gemm_phase<pg8::EpiScaleBf16, pg8::StaticOrder, true, true>(lds, g, So, E); }
    }
    if (PHASE_ON(PH_SBATT)) { SEAM(); for (int q = 0; q < NREP(2); ++q) phase_sbatt(QB, (const bf16*)(ws + WS_KB), (const bf16*)(ws + WS_VB), AO, lds, vcu, G, wave, lane); }
    if (PHASE_ON(PH_OPROJ0)) { SEAM();
        _Pragma("unroll") for (int q = 0; q < NREP(3); ++q) {
        pg8::Gemm g{AO, (const bf16*)(ws + WS_WO0), T, 1024, 1024}; pg8::StaticOrder So; So.init(T, 1024, G, bx);
        pg8::EpiResid E{HB, HB, SSP1, T};
        pg8::gemm_phase<pg8::EpiResid, pg8::StaticOrder, true, true>(lds, g, So, E); }
    }
    if (PHASE_ON(PH_PQ0)) { SEAM();
        _Pragma("unroll") for (int q = 0; q < NREP(4); ++q) {
        pg8::Gemm g{HB, (const bf16*)(ws + WS_WPQ0), T, 2048, 1024}; pg8::StaticOrder So; So.init(T, 2048, G, bx);
        fill_rs(rs, So, SSP1, 16, tid);
        pg8::EpiScaleBf16 E{QP, 2048, 0, 0, 1.f, rs};
        pg8::gemm_phase<pg8::EpiScaleBf16, pg8::StaticOrder, true, true>(lds, g, So, E);
        _Pragma("unroll") for (int q2 = 0; q2 < NREP(5); ++q2) { pg8::Unit u; for (int ui = 0; So.next(ui, u); ++ui) topk_unit(QP, (const bf16*)(ws + WS_SUBK), (unsigned short*)(ws + WS_EID), (float*)(ws + WS_GATE), u.pm * 8 + wave, u.pn, lane); } }
    }
    const int sl = bx & 7, smem = bx >> 3, nmem = (G - 1 - sl) / 8 + 1;
    float* HP = (float*)(ws + WS_HP); _Float16* COEF = (_Float16*)(ws + WS_COEF); const unsigned short* EIDp = (const unsigned short*)(ws + WS_EID); const float* GATEp = (const float*)(ws + WS_GATE);
    if (PHASE_ON(PH_GATH0)) { SEAM();
        _Pragma("unroll") for (int q = 0; q < NREP(6); ++q) phase_peer_u(HB, EIDp, ws + WS_U8, (_Float16*)HP, lds + wave * 16384, sl, smem, nmem, wave, lane);
        xcd_barrier(bar);
        _Pragma("unroll") for (int q = 0; q < NREP(13); ++q) phase_peer_coef((const _Float16*)HP, SSP1, 16, EIDp, GATEp, (const float*)(ws + WS_ISU), (const float*)(ws + WS_ISV), COEF, gw, NGW, lane);
        xcd_barrier(bar);
        if (NREP(14) > 1) phase_peer_v(HB, nullptr, EIDp, COEF, ws + WS_V8, (bf16*)QP, SSP3, HP, lds + wave * 16384, sl, smem, nmem, wave, lane);
        phase_peer_v(HB, nullptr, EIDp, COEF, ws + WS_V8, HB, SSP2, HP, lds + wave * 16384, sl, smem, nmem, wave, lane);
    }
    if (PHASE_ON(PH_QKV1)) { SEAM();
        _Pragma("unroll") for (int q = 0; q < NREP(7); ++q) {
        pg8::Gemm g{HB, (const bf16*)(ws + WS_WQKV1), T, 1536, 1024}; pg8::StaticOrder So; So.init(T, 1536, G, bx);
        fill_rs(rs, So, SSP2, 8, tid);
        pg8::EpiScaleBf16 E{QB, 1536, 0, 0, 1.f, rs};
        pg8::gemm_phase<pg8::EpiScaleBf16, pg8::StaticOrder, true, true>(lds, g, So, E); }
    }
    if (PHASE_ON(PH_SWATT)) { SEAM(); for (int q = 0; q < NREP(8); ++q) phase_swatt(QB, a.in[6], a.in[7], a.in[8], AO, lds, vcu, G, wave, lane); }
    if (PHASE_ON(PH_OPROJ1)) { SEAM();
        _Pragma("unroll") for (int q = NREP(9) - 1; q >= 0; --q) {
        pg8::Gemm g{AO, (const bf16*)(ws + WS_WO1), T, 1024, 1024}; pg8::StaticOrder So; So.init(T, 1024, G, bx);
        pg8::EpiResid E{HB, q ? (bf16*)QP : HB, q ? SSP0 : SSP3, T};
        pg8::gemm_phase<pg8::EpiResid, pg8::StaticOrder, true, true>(lds, g, So, E); }
    }
    if (PHASE_ON(PH_PQ1)) { SEAM();
        _Pragma("unroll") for (int q = 0; q < NREP(10); ++q) {
        pg8::Gemm g{HB, (const bf16*)(ws + WS_WPQ1), T, 2048, 1024}; pg8::StaticOrder So; So.init(T, 2048, G, bx);
        fill_rs(rs, So, SSP3, 16, tid);
        pg8::EpiScaleBf16 E{QP, 2048, 0, 0, 1.f, rs};
        pg8::gemm_phase<pg8::EpiScaleBf16, pg8::StaticOrder, true, true>(lds, g, So, E);
        _Pragma("unroll") for (int q2 = 0; q2 < NREP(11); ++q2) { pg8::Unit u; for (int ui = 0; So.next(ui, u); ++ui) topk_unit(QP, (const bf16*)(ws + WS_SUBK) + (size_t)8 * 2 * 128 * 128, (unsigned short*)(ws + WS_EID), (float*)(ws + WS_GATE), u.pm * 8 + wave, u.pn, lane); } }
    }
    if (PHASE_ON(PH_GATH1)) { SEAM();
        _Pragma("unroll") for (int q = 0; q < NREP(12); ++q) phase_peer_u(HB, EIDp, ws + WS_U8 + (size_t)16384 * 1024, (_Float16*)HP, lds + wave * 16384, sl, smem, nmem, wave, lane);
        xcd_barrier(bar);
        _Pragma("unroll") for (int q = 0; q < NREP(13); ++q) phase_peer_coef((const _Float16*)HP, SSP3, 16, EIDp, GATEp, (const float*)(ws + WS_ISU) + 16384, (const float*)(ws + WS_ISV) + 16384, COEF, gw, NGW, lane);
        xcd_barrier(bar);
        if (NREP(14) > 1) phase_peer_v(HB, HP, EIDp, COEF, ws + WS_V8 + (size_t)16384 * 1024, (bf16*)QP, SSP0, HP, lds + wave * 16384, sl, smem, nmem, wave, lane);
        phase_peer_v(HB, a.out, EIDp, COEF, ws + WS_V8 + (size_t)16384 * 1024, (bf16*)QP, SSP0, HP,
                     lds + wave * 16384, sl, smem, nmem, wave, lane);
    }
    if (NREP(16) > 1) { for (int q = 0; q < 10; ++q) xcd_barrier(bar); }
#undef NREP
#undef PHASE_ON
#undef SEAM
}

static void launch_mega(const Args& a0, unsigned mask, int li, int grid, hipStream_t stream) {
    Args a = a0; a.mask = mask; a.li = li; a.rep = 0u; a.pad = 0;
    void* params[] = {&a};
    hipError_t e = hipLaunchCooperativeKernel((const void*)mega, dim3(grid), dim3(NWAVES * 64), params, LDS_BYTES, stream);
    if (e != hipSuccess) fprintf(stderr, "kernel_launch: cooperative launch failed: %s (grid %d)\n", hipGetErrorString(e), grid);
}

extern "C" void kernel_launch(void* const* d_in, const int* in_sizes, int n_in, void* d_out, int out_size, void* d_ws, size_t ws_size, hipStream_t stream) {
    static int grid = 0;
    if (grid == 0) {
        if (n_in != 15 || out_size != T * D || ws_size < WS_END) { fprintf(stderr, "kernel_launch: unexpected shapes (n_in %d out %d ws %zu)\n", n_in, out_size, ws_size); grid = -1; return; }
        int dev = 0, cus = 0, per_cu = 0;
        if (hipGetDevice(&dev) != hipSuccess || hipDeviceGetAttribute(&cus, hipDeviceAttributeMultiprocessorCount, dev) != hipSuccess) { grid = -1; return; }
        if (hipFuncSetAttribute((const void*)mega, hipFuncAttributeMaxDynamicSharedMemorySize, LDS_BYTES) != hipSuccess) { fprintf(stderr, "kernel_launch: hipFuncSetAttribute failed\n"); grid = -1; return; }
        if (hipOccupancyMaxActiveBlocksPerMultiprocessor(&per_cu, (const void*)mega, NWAVES * 64, LDS_BYTES) != hipSuccess || per_cu < 1) { fprintf(stderr, "kernel_launch: occupancy query says %d blocks per CU\n", per_cu); per_cu = 1; }
        (void)hipGetLastError();
        grid = cus;
        if (grid != 256) fprintf(stderr, "kernel_launch: note: %d CUs (tuned for 256)\n", grid);
    }
    if (grid < 0) return;
    (void)hipMemsetAsync((char*)d_ws + WS_CTL, 0, CTL_ZERO_BYTES, stream);
    Args a{};
    for (int i = 0; i < 15; ++i) a.in[i] = (const float*)d_in[i];
    a.out = (float*)d_out; a.ws = (unsigned char*)d_ws;
    unsigned char* ws = (unsigned char*)d_ws;
    bf16* QB = (bf16*)(ws + WS_QB); bf16* KB = (bf16*)(ws + WS_KB); bf16* VB = (bf16*)(ws + WS_VB); bf16* AO = (bf16*)(ws + WS_AO); bf16* QP = (bf16*)(ws + WS_QP); bf16* HB = (bf16*)(ws + WS_HB);
    float* SSP0 = (float*)(ws + WS_SSP); float* SSP1 = SSP0 + 16 * T; float* SSP2 = SSP1 + 16 * T;  float* SSP3 = SSP2 + 16 * T;
    int* EID = (int*)(ws + WS_EID); float* GATE = (float*)(ws + WS_GATE);
    const unsigned char* U8 = ws + WS_U8; const unsigned char* V8 = ws + WS_V8; const float* ISU = (const float*)(ws + WS_ISU); const float* ISV = (const float*)(ws + WS_ISV);
    const bf16* SUBK = (const bf16*)(ws + WS_SUBK);
#define M(k) (1u << (k))
    launch_mega(a, (1u << PH_N) - 1u, 0, grid, stream);
#undef M
}
```

```cpp
#include <hip/hip_runtime.h>
#include <cstdint>
#include <cstdio>

constexpr int D = 1024, NB = 4, S = 4096, T = NB * S;
constexpr float LOG2E = 1.4426950408889634f;
constexpr float C2 = 0.125f * LOG2E;

constexpr size_t MiB = 1u << 20;
constexpr size_t WS_CTL = 0, CTL_ZERO_BYTES = 1 * MiB;
constexpr size_t WS_WQKV0 = 2 * MiB, WS_WO0 = 8 * MiB, WS_WQKV1 = 10 * MiB, WS_WO1 = 13 * MiB, WS_WPQ0 = 15 * MiB, WS_WPQ1 = 19 * MiB;
constexpr size_t WS_SUBK = 23 * MiB;
constexpr size_t WS_ISU = 24 * MiB;
constexpr size_t WS_ISV = WS_ISU + 2 * 16384 * 4;
constexpr size_t WS_SSP = 25 * MiB;
constexpr size_t WS_U8 = 32 * MiB, WS_V8 = 64 * MiB;
constexpr size_t WS_HB = 96 * MiB;
constexpr size_t WS_QB = 128 * MiB, WS_KB = 160 * MiB, WS_VB = 192 * MiB;
constexpr size_t WS_AO = 224 * MiB;
constexpr size_t WS_QP = 256 * MiB;
constexpr size_t WS_EID = 320 * MiB, WS_GATE = 328 * MiB;
constexpr size_t WS_HP = 336 * MiB;
constexpr size_t WS_COEF = 400 * MiB;
constexpr size_t WS_END = 408 * MiB;
namespace pg8 {
#define PG8_LAS __attribute__((address_space(3)))
typedef unsigned short bf16_t;
typedef short bf16x8 __attribute__((ext_vector_type(8)));
typedef float f32x4 __attribute__((ext_vector_type(4)));
typedef unsigned u32x4 __attribute__((ext_vector_type(4)));
constexpr int BM = 256, BK = 64, HALF = 128, HTB = HALF * BK * 2  , STAGE_BYTES = 8 * HTB, NXCD = 8, WGM = 8;

__host__ __device__ __forceinline__ int lds_byte(int r, int c) { const int st = (r >> 4) * 2 + (c >> 5), rr = r & 15, cc = c & 31, ob = rr * 64 + cc * 2; return st * 1024 + (ob ^ (((ob >> 9) & 1) << 5)); }
__host__ __device__ __forceinline__ void stage_rc(int b, int& R, int& C) { const int st = b / 1024, sb = b % 1024, swz = sb ^ (((sb >> 9) & 1) << 5); R = (st >> 1) * 16 + swz / 64; C = (st & 1) * 32 + (swz % 64) / 2; }
__host__ __device__ __forceinline__ int perm32(int rho) { const int n = rho >> 4, i = rho & 15; return 8 * (i >> 2) + 4 * n + (i & 3); }

struct Unit { int pm, pn; };
struct Gemm { const bf16_t* A; const bf16_t* Bt; int M, N, K; };

struct StaticOrder {
    int nM, nN, nwg, G, c;
    __host__ __device__ void init(int M, int N, int G_, int c_) { nM = M / BM; nN = N / BM; nwg = nM * nN; G = G_; c = c_; }
    __host__ __device__ bool next(int i, Unit& u) const {
        const long L = (long)i * G + c; if (L >= nwg) return false;
        int wgid = (int)L; { const int q = nwg / NXCD, r = nwg % NXCD, xcd = wgid % NXCD, off = wgid / NXCD; wgid = (xcd < r ? xcd * (q + 1) : r * (q + 1) + (xcd - r) * q) + off; }
        const int nig = WGM * nN, gid = wgid / nig, fm = gid * WGM, gsz = (nM - fm) < WGM ? (nM - fm) : WGM;
        u.pm = fm + ((wgid % nig) % gsz); u.pn = (wgid % nig) / gsz; return true;
    }
    __device__ __forceinline__ void a_ready(const Unit&) const {}
    __device__ __forceinline__ void done(const Unit&) const {}
};


__device__ __forceinline__ unsigned cvt_pk_bf16(float lo, float hi) { unsigned r; asm volatile("v_cvt_pk_bf16_f32 %0, %1, %2" : "=v"(r) : "v"(lo), "v"(hi)); return r; }

struct EpiScaleBf16 {
    static constexpr bool PERM = true, AFTER_DRAIN = false;
    bf16_t* O; int ldc; int split_cols; size_t split_stride; float scale0; const PG8_LAS float* rs;
    __device__ __forceinline__ void operator()(const f32x4 (&acc)[2][2][4][2], const Unit& u, int ui, int wr, int wc, int fr, int fq) const {
        const int row0 = u.pm * BM + wr * 64 + fr; int colt = u.pn * BM; bf16_t* base = O;
        float sc = 1.f; if (split_cols) { const int t = colt / split_cols; base += (size_t)t * split_stride; colt -= t * split_cols; if (t == 0) sc = scale0; }
        const int col0 = colt + wc * 32 + 8 * fq;
        const PG8_LAS float* rsu = rs + (ui & 3) * 256 + wr * 64 + fr;
#pragma unroll
        for (int ai = 0; ai < 2; ++ai)
#pragma unroll
            for (int m = 0; m < 4; ++m) { bf16_t* rowp = base + (size_t)(row0 + ai * HALF + m * 16) * ldc + col0; const float s = rsu[ai * HALF + m * 16] * sc;
#pragma unroll
                for (int bj = 0; bj < 2; ++bj) { const f32x4 v0 = acc[ai][bj][m][0] * s, v1 = acc[ai][bj][m][1] * s;
                    u32x4 w; w.x = cvt_pk_bf16(v0[0], v0[1]); w.y = cvt_pk_bf16(v0[2], v0[3]); w.z = cvt_pk_bf16(v1[0], v1[1]); w.w = cvt_pk_bf16(v1[2], v1[3]);
                    *(u32x4*)(rowp + bj * HALF) = w; } }
    }
};
__device__ __forceinline__ float bf_lo(unsigned w) { return __builtin_bit_cast(float, w << 16); }
__device__ __forceinline__ float bf_hi(unsigned w) { return __builtin_bit_cast(float, w & 0xffff0000u); }
struct EpiResid {
    static constexpr bool PERM = true, AFTER_DRAIN = false;
    const bf16_t* hb_in; bf16_t* hb; float* ssp; int nrows;
    __device__ __forceinline__ void operator()(const f32x4 (&acc)[2][2][4][2], const Unit& u, int ui, int wr, int wc, int fr, int fq) const {
        const int col0 = u.pn * BM + wc * 32 + 8 * fq;
#pragma unroll
        for (int ai = 0; ai < 2; ++ai)
#pragma unroll
            for (int m = 0; m < 4; ++m) { const int row = u.pm * BM + ai * HALF + wr * 64 + m * 16 + fr; const size_t off = (size_t)row * 1024 + col0; float ss = 0.f;
#pragma unroll
                for (int bj = 0; bj < 2; ++bj) { const u32x4 rw = *(const u32x4*)(hb_in + off + bj * HALF);
                    const f32x4 r0 = {bf_lo(rw.x), bf_hi(rw.x), bf_lo(rw.y), bf_hi(rw.y)}, r1 = {bf_lo(rw.z), bf_hi(rw.z), bf_lo(rw.w), bf_hi(rw.w)};
                    const f32x4 v0 = acc[ai][bj][m][0] + r0, v1 = acc[ai][bj][m][1] + r1;
                    ss += (v0[0] * v0[0] + v0[1] * v0[1]) + (v0[2] * v0[2] + v0[3] * v0[3]) + (v1[0] * v1[0] + v1[1] * v1[1]) + (v1[2] * v1[2] + v1[3] * v1[3]);
                    u32x4 w; w.x = cvt_pk_bf16(v0[0], v0[1]); w.y = cvt_pk_bf16(v0[2], v0[3]); w.z = cvt_pk_bf16(v1[0], v1[1]); w.w = cvt_pk_bf16(v1[2], v1[3]);
                    *(u32x4*)(hb + off + bj * HALF) = w; }
                ss += __shfl_xor(ss, 16); ss += __shfl_xor(ss, 32);
                if (fq == 0) ssp[(size_t)(u.pn * 4 + wc) * nrows + row] = ss;
                asm volatile("" ::: "memory"); }
    }
};
template <class Epi, class Sched, bool ALIGN_EPI = false, bool SP2 = false>
__device__ __forceinline__ void gemm_phase(PG8_LAS unsigned char* lds, const Gemm g, const Sched& S, const Epi& E) {
    const int tid = threadIdx.x, wid = __builtin_amdgcn_readfirstlane(tid >> 6), lane = tid & 63, wr = wid >> 2, wc = wid & 3, fr = lane & 15, fq = lane >> 4;
    const int K = g.K, nt = K / BK;
    unsigned voffA[2], voffB[2];
#pragma unroll
    for (int i = 0; i < 2; ++i) { int R, C; stage_rc(tid * 16 + i * 8192, R, C); const int Rb = Epi::PERM ? ((R & ~31) + perm32(R & 31)) : R;
        voffA[i] = (unsigned)(R * K + C) * 2u; voffB[i] = (unsigned)(Rb * K + C) * 2u; }
    const size_t kstep = (size_t)(BK * 2);
    const size_t hstep = (size_t)HALF * K * 2;
    const size_t tstep = 2 * hstep;
    const unsigned ldsw = (unsigned)wid * 1024u;
    const int aoff = lds_byte(wr * 64 + fr, fq * 8), boff = lds_byte(wc * 32 + fr, fq * 8);
#define PG8_SA(b, h) (((b) * 2 + (h)) * HTB)
#define PG8_SB(b, h) ((4 + (b) * 2 + (h)) * HTB)
#define PG8_STAGE(bufoff, gbase, voff) do { _Pragma("unroll") for (int _i = 0; _i < 2; ++_i) \
        __builtin_amdgcn_global_load_lds((const unsigned*)((const char*)(gbase) + (voff)[_i]), (PG8_LAS unsigned*)(lds + (bufoff) + ldsw + _i * 8192), 16, 0, 0); } while (0)
#define PG8_LDA(dst, b, h) do { _Pragma("unroll") for (int m = 0; m < 4; ++m) _Pragma("unroll") for (int k = 0; k < 2; ++k) dst[m][k] = *(const PG8_LAS bf16x8*)(lds + PG8_SA(b, h) + aoff + m * 2048 + k * 1024); } while (0)
#define PG8_LDB(dst, b, h) do { _Pragma("unroll") for (int n = 0; n < 2; ++n) _Pragma("unroll") for (int k = 0; k < 2; ++k) dst[n][k] = *(const PG8_LAS bf16x8*)(lds + PG8_SB(b, h) + boff + n * 2048 + k * 1024); } while (0)
#define PG8_MMA(ai, bj, At, Bt) do { __builtin_amdgcn_s_setprio(1); _Pragma("unroll") for (int m = 0; m < 4; ++m) _Pragma("unroll") for (int n = 0; n < 2; ++n) _Pragma("unroll") for (int k = 0; k < 2; ++k) \
        acc[ai][bj][m][n] = __builtin_amdgcn_mfma_f32_16x16x32_bf16(Bt[n][k], At[m][k], acc[ai][bj][m][n], 0, 0, 0); __builtin_amdgcn_s_setprio(0); } while (0)
#define PG8_WAIT_V(n) asm volatile("s_waitcnt vmcnt(" #n ")" ::: "memory")
#define PG8_WAIT_L(n) asm volatile("s_waitcnt lgkmcnt(" #n ")" ::: "memory")
#define PG8_BAR __builtin_amdgcn_s_barrier()
#define PG8_SCHED __builtin_amdgcn_sched_barrier(0)
    Unit cur, nxt; int ui = 0;
    if (!S.next(0, cur)) return;
    f32x4 acc[2][2][4][2];
#pragma unroll
    for (int a = 0; a < 2; ++a)
#pragma unroll
        for (int b = 0; b < 2; ++b)
#pragma unroll
            for (int m = 0; m < 4; ++m)
#pragma unroll
                for (int n = 0; n < 2; ++n) acc[a][b][m][n] = (f32x4){0.f, 0.f, 0.f, 0.f};
    bf16x8 At[4][2], B0[2][2], B1[2][2];
    const char* cA = (const char*)g.A + (size_t)cur.pm * tstep; const char* cB = (const char*)g.Bt + (size_t)cur.pn * tstep;
    S.a_ready(cur);
    if constexpr (SP2) {
        PG8_STAGE(PG8_SB(0, 0), cB, voffB); PG8_STAGE(PG8_SB(0, 1), cB + hstep, voffB); PG8_STAGE(PG8_SA(0, 0), cA, voffA); PG8_STAGE(PG8_SA(0, 1), cA + hstep, voffA);
        if (wr == 1) PG8_BAR;
        PG8_WAIT_V(2); PG8_BAR;
        PG8_STAGE(PG8_SB(1, 0), cB + kstep, voffB); PG8_STAGE(PG8_SA(1, 0), cA + kstep, voffA); PG8_STAGE(PG8_SB(1, 1), cB + hstep + kstep, voffB);
        PG8_WAIT_V(6); PG8_BAR;
    } else {
        PG8_STAGE(PG8_SB(0, 0), cB, voffB); PG8_STAGE(PG8_SA(0, 0), cA, voffA); PG8_STAGE(PG8_SB(0, 1), cB + hstep, voffB); PG8_STAGE(PG8_SA(0, 1), cA + hstep, voffA);
        if (wr == 1) PG8_BAR;
        PG8_WAIT_V(4); PG8_BAR;
        PG8_STAGE(PG8_SB(1, 0), cB + kstep, voffB); PG8_STAGE(PG8_SA(1, 0), cA + kstep, voffA); PG8_STAGE(PG8_SB(1, 1), cB + hstep + kstep, voffB);
        PG8_WAIT_V(6); PG8_BAR;
    }
    for (;;) {
        const bool has_next = S.next(ui + 1, nxt);
        const char* nA = has_next ? (const char*)g.A + (size_t)nxt.pm * tstep : cA; const char* nB = has_next ? (const char*)g.Bt + (size_t)nxt.pn * tstep : cB;
        for (int t = 0; t < nt; t += 2) {
            const bool last = (t == nt - 2);
            const char* a1 = cA + (size_t)(t + 1) * kstep;
            const char* a2 = last ? nA : cA + (size_t)(t + 2) * kstep; const char* b2 = last ? nB : cB + (size_t)(t + 2) * kstep;
            const char* a3 = a2 + kstep; const char* b3 = b2 + kstep;
            if (last && has_next) S.a_ready(nxt);
            if constexpr (SP2) {
            PG8_LDB(B0, 0, 0); PG8_LDB(B1, 0, 1); PG8_SCHED; PG8_LDA(At, 0, 0); PG8_STAGE(PG8_SA(1, 1), a1 + hstep, voffA);
            PG8_WAIT_V(8); PG8_WAIT_L(0); PG8_BAR; PG8_MMA(0, 0, At, B0); PG8_MMA(0, 1, At, B1); PG8_BAR; PG8_SCHED;
            PG8_LDA(At, 0, 1); PG8_STAGE(PG8_SB(0, 0), b2, voffB); PG8_STAGE(PG8_SB(0, 1), b2 + hstep, voffB); PG8_STAGE(PG8_SA(0, 0), a2, voffA);
            PG8_WAIT_V(8); PG8_WAIT_L(0); PG8_BAR; PG8_MMA(1, 0, At, B0); PG8_MMA(1, 1, At, B1); PG8_BAR; PG8_SCHED;
            PG8_LDB(B0, 1, 0); PG8_LDB(B1, 1, 1); PG8_SCHED; PG8_LDA(At, 1, 0); PG8_STAGE(PG8_SA(0, 1), a2 + hstep, voffA);
            PG8_WAIT_V(8); PG8_WAIT_L(0); PG8_BAR; PG8_MMA(0, 0, At, B0); PG8_MMA(0, 1, At, B1); PG8_BAR; PG8_SCHED;
            PG8_LDA(At, 1, 1); PG8_STAGE(PG8_SB(1, 0), b3, voffB); PG8_STAGE(PG8_SB(1, 1), b3 + hstep, voffB); PG8_STAGE(PG8_SA(1, 0), a3, voffA);
            PG8_WAIT_V(8); PG8_WAIT_L(0); PG8_BAR; PG8_MMA(1, 0, At, B0); PG8_MMA(1, 1, At, B1); PG8_BAR; PG8_SCHED;
            } else {
            PG8_LDB(B0, 0, 0); PG8_SCHED; PG8_LDA(At, 0, 0); PG8_STAGE(PG8_SA(1, 1), a1 + hstep, voffA);
            PG8_WAIT_L(8); PG8_BAR; PG8_WAIT_L(0); PG8_MMA(0, 0, At, B0); PG8_BAR; PG8_SCHED;
            PG8_LDB(B1, 0, 1); PG8_STAGE(PG8_SB(0, 0), b2, voffB);
            PG8_BAR; PG8_WAIT_L(0); PG8_MMA(0, 1, At, B1); PG8_BAR;
            PG8_LDA(At, 0, 1); PG8_STAGE(PG8_SA(0, 0), a2, voffA);
            PG8_BAR; PG8_WAIT_L(0); PG8_MMA(1, 0, At, B0); PG8_BAR; PG8_SCHED;
            PG8_STAGE(PG8_SB(0, 1), b2 + hstep, voffB);
            PG8_WAIT_V(6); PG8_BAR; PG8_MMA(1, 1, At, B1); PG8_BAR;
            PG8_LDB(B0, 1, 0); PG8_SCHED; PG8_LDA(At, 1, 0); PG8_STAGE(PG8_SA(0, 1), a2 + hstep, voffA);
            PG8_WAIT_L(8); PG8_BAR; PG8_WAIT_L(0); PG8_MMA(0, 0, At, B0); PG8_BAR; PG8_SCHED;
            PG8_LDB(B1, 1, 1); PG8_STAGE(PG8_SB(1, 0), b3, voffB);
            PG8_BAR; PG8_WAIT_L(0); PG8_MMA(0, 1, At, B1); PG8_BAR;
            PG8_LDA(At, 1, 1); PG8_STAGE(PG8_SA(1, 0), a3, voffA);
            PG8_BAR; PG8_WAIT_L(0); PG8_MMA(1, 0, At, B0); PG8_BAR; PG8_SCHED;
            PG8_STAGE(PG8_SB(1, 1), b3 + hstep, voffB);
            PG8_WAIT_V(6); PG8_BAR; PG8_MMA(1, 1, At, B1); PG8_BAR;
            }
        }
        if constexpr (ALIGN_EPI) { if (wr == 0) PG8_BAR; }
        if constexpr (!Epi::AFTER_DRAIN) { E(acc, cur, ui, wr, wc, fr, fq); S.done(cur); }
        if (!has_next) break;
#pragma unroll
        for (int a = 0; a < 2; ++a)
#pragma unroll
            for (int b = 0; b < 2; ++b)
#pragma unroll
                for (int m = 0; m < 4; ++m)
#pragma unroll
                    for (int n = 0; n < 2; ++n) acc[a][b][m][n] = (f32x4){0.f, 0.f, 0.f, 0.f};
        cur = nxt; cA = nA; cB = nB; ++ui;
        if constexpr (ALIGN_EPI) { if (wr == 1) PG8_BAR; }
    }
    PG8_WAIT_V(0);
    if constexpr (!ALIGN_EPI) { if (wr == 0) PG8_BAR; }
    PG8_BAR;
    if constexpr (Epi::AFTER_DRAIN) { E.fused(acc, cur, wr, wc, fr, fq, lds, wid, lane); S.done(cur); }
#undef PG8_SA
#undef PG8_SB
#undef PG8_STAGE
#undef PG8_LDA
#undef PG8_LDB
#undef PG8_MMA
#undef PG8_WAIT_V
#undef PG8_WAIT_L
#undef PG8_BAR
#undef PG8_SCHED
}
}

#define GAS __attribute__((address_space(1)))
#define LAS __attribute__((address_space(3)))
typedef unsigned short bf16;
typedef unsigned v4u __attribute__((ext_vector_type(4)));
typedef float f32x4 __attribute__((ext_vector_type(4)));
typedef float f32x2 __attribute__((ext_vector_type(2)));
typedef float f32x16 __attribute__((ext_vector_type(16)));
typedef short bf16x8 __attribute__((ext_vector_type(8)));
typedef GAS unsigned gu32;
#define RLX_AGENT __ATOMIC_RELAXED, __HIP_MEMORY_SCOPE_AGENT
#define LDS_WAIT() asm volatile("s_waitcnt lgkmcnt(0)" ::: "memory")
#define VM_WAIT() asm volatile("s_waitcnt vmcnt(0)" ::: "memory")
__device__ __forceinline__ unsigned f2bf(float f) { unsigned u = __builtin_bit_cast(unsigned, f); return (u + 0x7fffu + ((u >> 16) & 1u)) >> 16; }
__device__ __forceinline__ unsigned pk2(float lo, float hi) { return f2bf(lo) | (f2bf(hi) << 16); }
__device__ __forceinline__ float bf2f(unsigned short b) { return __builtin_bit_cast(float, (unsigned)b << 16); }
__device__ __forceinline__ float bflo(unsigned w) { return __builtin_bit_cast(float, w << 16); }
__device__ __forceinline__ float bfhi(unsigned w) { return __builtin_bit_cast(float, w & 0xffff0000u); }
__device__ __forceinline__ float wave_sum(float v) {
#pragma unroll
    for (int o = 1; o < 64; o <<= 1) v += __shfl_xor(v, o);
    return v;
}
__device__ __forceinline__ float wave_max(float v) {
#pragma unroll
    for (int o = 1; o < 64; o <<= 1) v = fmaxf(v, __shfl_xor(v, o));
    return v;
}

#define XB_TMO      128
#define XB_XCNT(j)  (256  + 64 * (j))
#define XB_XSUB(j)  (1280 + 64 * (j))
#define XB_XGEN(j)  (2304 + 64 * (j))
#define XB_TOP      3328
#define XB_TOPGEN   3392
#define XCD_BAR_WORDS 3456
#define XB_SPIN_CAP (1u << 18)

__device__ __forceinline__ unsigned xb_ld(unsigned* p)              { return __hip_atomic_load(p, __ATOMIC_RELAXED, __HIP_MEMORY_SCOPE_AGENT); }
__device__ __forceinline__ unsigned xb_add(unsigned* p, unsigned v) { return __hip_atomic_fetch_add(p, v, __ATOMIC_RELAXED, __HIP_MEMORY_SCOPE_AGENT); }
__device__ __forceinline__ unsigned xb_xcc_id() { return (unsigned)__builtin_amdgcn_s_getreg((3 << 11) | 20) & 0xFu; }
#define XB_SPIN(cond, bar) do { unsigned _sp = 0; while (cond) { __builtin_amdgcn_s_sleep(1); \
    if ((++_sp & 255u) == 0u) { if (xb_ld(&(bar)[XB_TMO])) break; if (_sp > XB_SPIN_CAP) { atomicAdd(&(bar)[XB_TMO], 1u); break; } } } } while (0)

struct XcdBarrier {
    unsigned* bar; unsigned x;
    volatile LAS unsigned* st;
};

__device__ __forceinline__ XcdBarrier xcd_barrier_post(unsigned* bar, volatile LAS unsigned* st) {
    XcdBarrier b; b.bar = bar; b.x = xb_xcc_id(); b.st = st;
    if (threadIdx.x == 0) (void)xb_add(&bar[XB_XCNT(b.x)], 1u);
    return b;
}
__device__ __forceinline__ void xcd_barrier_complete(unsigned* bar, unsigned x, unsigned& nloc, unsigned& nx) {
    const unsigned G = gridDim.x * gridDim.y * gridDim.z;
    unsigned sum, cnt, mine, sp = 0u;
    for (;;) {
        sum = 0u; cnt = 0u; mine = 0u;
#pragma unroll
        for (unsigned j = 0; j < 16; ++j) { const unsigned c = xb_ld(&bar[XB_XCNT(j)]); sum += c; cnt += (c > 0u) ? 1u : 0u; mine = (j == x) ? c : mine; }
        if (sum == G) break;
        __builtin_amdgcn_s_sleep(1);
        if ((++sp & 255u) == 0u) { if (xb_ld(&bar[XB_TMO])) break; if (sp > XB_SPIN_CAP) { atomicAdd(&bar[XB_TMO], 1u); break; } }
    }
    nloc = mine > 0u ? mine : 1u; nx = cnt > 0u ? cnt : 1u;
}

__device__ __forceinline__ void xcd_barrier(const XcdBarrier& b) {
    asm volatile("s_waitcnt vmcnt(0)" ::: "memory");
    __syncthreads();
    if (threadIdx.x == 0) {
        unsigned* bar = b.bar;
        __builtin_amdgcn_s_waitcnt(0);
        unsigned nloc = b.st[0], nx = b.st[1];
        if (nloc == 0u) { xcd_barrier_complete(bar, b.x, nloc, nx); b.st[0] = nloc; b.st[1] = nx; }
        const unsigned old = xb_add(&bar[XB_XSUB(b.x)], 1u);
        const unsigned gen = old / nloc;
        if (old + 1u == (gen + 1u) * nloc) {
            __builtin_amdgcn_fence(__ATOMIC_RELEASE, "agent");
            asm volatile("s_waitcnt vmcnt(0)" ::: "memory");
            const unsigned og = xb_add(&bar[XB_TOP], 1u);
            const unsigned tg = og / nx;
            if (og + 1u == (tg + 1u) * nx) xb_add(&bar[XB_TOPGEN], 1u);
            else XB_SPIN(xb_ld(&bar[XB_TOPGEN]) == tg, bar);
            __builtin_amdgcn_fence(__ATOMIC_ACQUIRE, "agent");
            xb_add(&bar[XB_XGEN(b.x)], 1u);
            asm volatile("s_waitcnt vmcnt(0)" ::: "memory");
        } else {
            XB_SPIN(xb_ld(&bar[XB_XGEN(b.x)]) == gen, bar);
            __builtin_amdgcn_fence(__ATOMIC_ACQUIRE, "agent");
            asm volatile("s_waitcnt vmcnt(0)" ::: "memory");
        }
    }
    __syncthreads();
}

constexpr int NWAVES = 8;
constexpr int RING_BYTES = 131072;
constexpr int RS_OFF = RING_BYTES;
constexpr int MISC_OFF = RS_OFF + 4096;
constexpr int LDS_BYTES = 147456;
constexpr int CW_BAR = 4096;

struct Args { const float* in[15]; float* out; unsigned char* ws; unsigned mask; int li; unsigned rep; int pad; };

__device__ __forceinline__ void p0_transpose_item(const float* W, const float* gain, int K, int N, bf16* WT, LAS float* scr, int item, int lane) {
    const int nblk = N / 32, kb = item / nblk, nb = item % nblk, k0 = 64 * kb, n0 = 32 * nb;
#pragma unroll 8
    for (int i = 0; i < 32; ++i) { const int kk = 2 * i + (lane >> 5); float w = W[(size_t)(k0 + kk) * N + n0 + (lane & 31)]; if (gain) w *= gain[k0 + kk]; scr[kk * 33 + (lane & 31)] = w; }
    LDS_WAIT(); asm volatile("" ::: "memory");
    const int c = lane & 7;
#pragma unroll
    for (int j = 0; j < 4; ++j) { const int n = (lane >> 3) + 8 * j; const LAS float* s = scr + (8 * c) * 33 + n;
        v4u o; o.x = pk2(s[0 * 33], s[1 * 33]); o.y = pk2(s[2 * 33], s[3 * 33]); o.z = pk2(s[4 * 33], s[5 * 33]); o.w = pk2(s[6 * 33], s[7 * 33]);
        *(v4u*)(WT + (size_t)(n0 + n) * K + k0 + 8 * c) = o; }
    LDS_WAIT(); asm volatile("" ::: "memory");
}
template <int NR> __device__ __forceinline__ void conv_rows_fp8(const float* src, const float* gain, unsigned char* dst, float* inv_scale, int lane) {
    f32x4 v[NR][4]; float am[NR];
#pragma unroll
    for (int i = 0; i < NR; ++i)
#pragma unroll
        for (int j = 0; j < 4; ++j) v[i][j] = *(const f32x4*)(src + (size_t)i * 1024 + lane * 16 + 4 * j);
#pragma unroll
    for (int i = 0; i < NR; ++i) { am[i] = 0.f;
#pragma unroll
        for (int j = 0; j < 4; ++j) { if (gain) v[i][j] = v[i][j] * *(const f32x4*)(gain + lane * 16 + 4 * j);
            am[i] = fmaxf(am[i], fmaxf(fmaxf(fabsf(v[i][j][0]), fabsf(v[i][j][1])), fmaxf(fabsf(v[i][j][2]), fabsf(v[i][j][3])))); } }
#pragma unroll
    for (int o = 1; o < 64; o <<= 1)
#pragma unroll
        for (int i = 0; i < NR; ++i) am[i] = fmaxf(am[i], __shfl_xor(am[i], o));
#pragma unroll
    for (int i = 0; i < NR; ++i) {
        const float sc = am[i] > 0.f ? 224.f / am[i] : 1.f;
        v4u o;
#pragma unroll
        for (int j = 0; j < 4; ++j) { int w = __builtin_amdgcn_cvt_pk_fp8_f32(v[i][j][0] * sc, v[i][j][1] * sc, 0, false); w = __builtin_amdgcn_cvt_pk_fp8_f32(v[i][j][2] * sc, v[i][j][3] * sc, w, true); o[j] = (unsigned)w; }
        *(v4u*)(dst + (size_t)i * 1024 + lane * 16) = o;
        if (lane == 0) inv_scale[i] = am[i] > 0.f ? am[i] * (1.f / 224.f) : 1.f;
    }
}
__device__ __forceinline__ void phase_prep(const Args& a, LAS unsigned char* lds, int gw, int NGW, int wave, int lane) {
    LAS float* scr = (LAS float*)(lds + wave * 16384);
    unsigned char* ws = a.ws;
    constexpr int I0 = 16 * (3072 / 32), I1 = 16 * (1024 / 32), I2 = 16 * (1536 / 32), I3 = I1, I4 = 16 * (2048 / 32), I5 = I4;
    constexpr int NIT = I0 + I1 + I2 + I3 + I4 + I5;
    for (int it = gw; it < NIT; it += NGW) {
        int r = it;
        if (r < I0) { p0_transpose_item(a.in[2], a.in[1], 1024, 3072, (bf16*)(ws + WS_WQKV0), scr, r, lane); continue; } r -= I0;
        if (r < I1) { p0_transpose_item(a.in[3], nullptr, 1024, 1024, (bf16*)(ws + WS_WO0), scr, r, lane); continue; } r -= I1;
        if (r < I2) { p0_transpose_item(a.in[5], a.in[4], 1024, 1536, (bf16*)(ws + WS_WQKV1), scr, r, lane); continue; } r -= I2;
        if (r < I3) { p0_transpose_item(a.in[9], nullptr, 1024, 1024, (bf16*)(ws + WS_WO1), scr, r, lane); continue; } r -= I3;
        if (r < I4) { p0_transpose_item(a.in[11], a.in[10], 1024, 2048, (bf16*)(ws + WS_WPQ0), scr, r, lane); continue; } r -= I4;
        p0_transpose_item(a.in[11] + (size_t)1024 * 2048, a.in[10] + 1024, 1024, 2048, (bf16*)(ws + WS_WPQ1), scr, r, lane);
    }
    for (int it = gw; it < 1024; it += NGW) {
        const float* s = a.in[12] + (size_t)it * 512 + lane * 8; const f32x4 a0 = *(const f32x4*)s, a1 = *(const f32x4*)(s + 4);
        v4u o; o.x = pk2(a0[0], a0[1]); o.y = pk2(a0[2], a0[3]); o.z = pk2(a1[0], a1[1]); o.w = pk2(a1[2], a1[3]);
        *(v4u*)((bf16*)(ws + WS_SUBK) + (size_t)it * 512 + lane * 8) = o;
    }
    for (int r4 = gw; r4 < 16384; r4 += NGW) {
        const int r = r4 * 4, tb = r >> 15, row = r & 32767;
        const float* src = (tb ? a.in[14] : a.in[13]) + (size_t)row * 1024;
        const float* gain = tb ? nullptr : a.in[10] + (row >> 14) * 1024;
        conv_rows_fp8<4>(src, gain, ws + (tb ? WS_V8 : WS_U8) + (size_t)row * 1024, (float*)(ws + (tb ? WS_ISV : WS_ISU)) + row, lane);
    }
    for (int t2 = gw; t2 < T / 2; t2 += NGW) {
        f32x4 v[2][4]; float ss[2];
#pragma unroll
        for (int i = 0; i < 2; ++i)
#pragma unroll
            for (int j = 0; j < 4; ++j) v[i][j] = *(const f32x4*)(a.in[0] + (size_t)(2 * t2 + i) * 1024 + lane * 16 + 4 * j);
#pragma unroll
        for (int i = 0; i < 2; ++i) { ss[i] = 0.f;
#pragma unroll
            for (int j = 0; j < 4; ++j) ss[i] += (v[i][j][0] * v[i][j][0] + v[i][j][1] * v[i][j][1]) + (v[i][j][2] * v[i][j][2] + v[i][j][3] * v[i][j][3]); }
#pragma unroll
        for (int o = 1; o < 64; o <<= 1) { ss[0] += __shfl_xor(ss[0], o); ss[1] += __shfl_xor(ss[1], o); }
#pragma unroll
        for (int i = 0; i < 2; ++i) {
            v4u o0, o1; o0.x = pk2(v[i][0][0], v[i][0][1]); o0.y = pk2(v[i][0][2], v[i][0][3]); o0.z = pk2(v[i][1][0], v[i][1][1]); o0.w = pk2(v[i][1][2], v[i][1][3]);
            o1.x = pk2(v[i][2][0], v[i][2][1]); o1.y = pk2(v[i][2][2], v[i][2][3]); o1.z = pk2(v[i][3][0], v[i][3][1]); o1.w = pk2(v[i][3][2], v[i][3][3]);
            bf16* hb = (bf16*)(ws + WS_HB) + (size_t)(2 * t2 + i) * 1024 + lane * 16;
            *(v4u*)hb = o0; *(v4u*)(hb + 8) = o1;
            if (lane == 0) ((float*)(ws + WS_SSP))[2 * t2 + i] = ss[i];
        }
    }
}
template <class Sched> __device__ __forceinline__ void fill_rs(LAS float* rs, const Sched& So, const float* ssp, int np, int tid) {
    pg8::Unit u;
    for (int ui = 0; ui < 4 && So.next(ui, u); ++ui) {
        if (tid < 256) { const int row = u.pm * 256 + tid; float s = 0.f; for (int p = 0; p < np; ++p) s += ssp[(size_t)p * T + row]; rs[ui * 256 + tid] = rsqrtf(s * (1.f / 1024.f) + 1e-6f); }
    }
    __syncthreads();
}

namespace nv {
__device__ __forceinline__ float softplus(float z) { return fmaxf(z, 0.f) + log1pf(expf(-fabsf(z))); }
__device__ __forceinline__ float gelu_tanh(float x) { const float k = 0.7978845608028654f; return 0.5f * x * (1.f + tanhf(k * (x + 0.044715f * x * x * x))); }

__global__ void __launch_bounds__(256) k_sb_attn_b(const bf16* __restrict__ Q, const bf16* __restrict__ K, const bf16* __restrict__ V, bf16* __restrict__ O) {
    __shared__ float Ks[64][65];
    __shared__ float Vs[64][65];
    __shared__ float qs[4][64];
    const int tid = threadIdx.x, w = tid >> 6, lane = tid & 63;
    const int nblk = S / 4;
    const int bh = blockIdx.x / nblk, t0 = (blockIdx.x % nblk) * 4;
    const int b = bh / 16, h = bh % 16;
    const int t = t0 + w;
    const size_t rowb = (size_t)b * S;
    qs[w][lane] = bf2f(Q[(rowb + t) * 1024 + h * 64 + lane]);
    float acc = 0.f, carry = 0.f;
    const int ntile = (t0 + 3) / 64 + 1;
    for (int tile = ntile - 1; tile >= 0; --tile) {
        const int s0 = tile * 64;
        __syncthreads();
#pragma unroll
        for (int i = 0; i < 16; ++i) {
            const int idx = tid + 256 * i, r = idx >> 6, d = idx & 63;
            const size_t g = (rowb + s0 + r) * 1024 + h * 64 + d;
            Ks[r][d] = bf2f(K[g]); Vs[r][d] = bf2f(V[g]);
        }
        __syncthreads();
        float z = 0.f;
#pragma unroll 16
        for (int d = 0; d < 64; ++d) z = fmaf(qs[w][d], Ks[lane][d], z);
        z *= 0.6931471805599453f;
        const int s = s0 + lane;
        const bool valid = s < t;
        const float sp = softplus(z);
        const float L = valid ? -sp : 0.f;
        float x = L;
#pragma unroll
        for (int off = 1; off < 64; off <<= 1) { const float y = __shfl_down(x, off); if (lane + off < 64) x += y; }
        const float excl = x - L;
        const float total = __shfl(x, 0);
        const float log_a = (z - sp) + carry + excl;
        const float a = valid ? expf(log_a) : 0.f;
        carry += total;
#pragma unroll 16
        for (int j = 0; j < 64; ++j) acc = fmaf(__shfl(a, j), Vs[j][lane], acc);
    }
    O[(rowb + t) * 1024 + h * 64 + lane] = (bf16)f2bf(acc);
}

__global__ void __launch_bounds__(256) k_sw_attn_b(const bf16* __restrict__ qkv, const float* __restrict__ qg, const float* __restrict__ kg,
                                                   const float* __restrict__ sinks, bf16* __restrict__ O) {
    __shared__ float sc[4][128];
    const int tid = threadIdx.x, w = tid >> 6, lane = tid & 63;
    const int gw = blockIdx.x * 4 + w;
    const int h = gw & 15, bt = gw >> 4, t = bt % S, b = bt / S;
    const int kvh = h >> 2;
    const size_t rowb = (size_t)b * S;
    float q = bf2f(qkv[(rowb + t) * 1536 + h * 64 + lane]);
    { const float ss = wave_sum(q * q); q = q * rsqrtf(ss * (1.f / 64.f) + 1e-6f) * qg[lane]; }
    const float kgl = kg[lane];
    const float slope = exp2f(-8.f * (float)(h + 1) / 16.f);
    const int slo = (t - 127) > 0 ? (t - 127) : 0;
    const int nk = t - slo + 1;
    for (int i = 0; i < nk; ++i) {
        const int s = slo + i;
        float kd = bf2f(qkv[(rowb + s) * 1536 + 1024 + kvh * 64 + lane]);
        const float ss = wave_sum(kd * kd);
        kd = kd * rsqrtf(ss * (1.f / 64.f) + 1e-6f) * kgl;
        const float dot = wave_sum(q * kd);
        if (lane == 0) sc[w][i] = dot * 0.125f - slope * (float)(t - s);
    }
    __syncthreads();
    const float sink = sinks[h];
    float m = sink;
    for (int i = lane; i < nk; i += 64) m = fmaxf(m, sc[w][i]);
    m = wave_max(m);
    float den = 0.f;
    for (int i = lane; i < nk; i += 64) { const float p = expf(sc[w][i] - m); sc[w][i] = p; den += p; }
    den = wave_sum(den) + expf(sink - m);
    __syncthreads();
    const float inv = 1.f / den;
    float acc = 0.f;
    for (int i = 0; i < nk; ++i) acc = fmaf(sc[w][i] * inv, bf2f(qkv[(rowb + slo + i) * 1536 + 1280 + kvh * 64 + lane]), acc);
    O[(rowb + t) * 1024 + h * 64 + lane] = (bf16)f2bf(acc);
}

__global__ void __launch_bounds__(256) k_peer_topk_b(const bf16* __restrict__ qp, const bf16* __restrict__ subk, int* __restrict__ eid, float* __restrict__ gate) {
    __shared__ float qs[4][256];
    const int tid = threadIdx.x, w = tid >> 6, lane = tid & 63;
    const int gw = blockIdx.x * 4 + w;
    const int h = gw & 7, t = gw >> 3;
#pragma unroll
    for (int i = 0; i < 4; ++i) qs[w][lane + 64 * i] = bf2f(qp[(size_t)t * 2048 + h * 256 + lane + 64 * i]);
    __syncthreads();
    float ts[2]; int tii[2];
#pragma unroll
    for (int p = 0; p < 2; ++p) {
        const bf16* k0 = subk + ((size_t)(h * 2 + p) * 128 + lane) * 128;
        const bf16* k1 = k0 + 64 * 128;
        float v0 = 0.f, v1 = 0.f;
        for (int c = 0; c < 128; ++c) { const float qq = qs[w][p * 128 + c]; v0 = fmaf(qq, bf2f(k0[c]), v0); v1 = fmaf(qq, bf2f(k1[c]), v1); }
        float mys = 0.f; int myi = 0;
        for (int r = 0; r < 16; ++r) {
            float bv; int bi;
            if (v0 >= v1) { bv = v0; bi = lane; } else { bv = v1; bi = lane + 64; }
#pragma unroll
            for (int off = 1; off < 64; off <<= 1) {
                const float ov = __shfl_xor(bv, off); const int oi = __shfl_xor(bi, off);
                if (ov > bv || (ov == bv && oi < bi)) { bv = ov; bi = oi; }
            }
            if (lane == r) { mys = bv; myi = bi; }
            if (bi == lane) v0 = -INFINITY;
            if (bi == lane + 64) v1 = -INFINITY;
        }
        ts[p] = mys; tii[p] = myi;
    }
    float cv[4];
    {
        const float s0 = __shfl(ts[0], lane >> 2);
#pragma unroll
        for (int c = 0; c < 4; ++c) cv[c] = s0 + __shfl(ts[1], (lane & 3) * 4 + c);
    }
    float cs = 0.f; int cf = 0;
    for (int r = 0; r < 16; ++r) {
        float bv = cv[0]; int bi = lane * 4;
#pragma unroll
        for (int c = 1; c < 4; ++c) if (cv[c] > bv) { bv = cv[c]; bi = lane * 4 + c; }
#pragma unroll
        for (int off = 1; off < 64; off <<= 1) {
            const float ov = __shfl_xor(bv, off); const int oi = __shfl_xor(bi, off);
            if (ov > bv || (ov == bv && oi < bi)) { bv = ov; bi = oi; }
        }
        if (lane == r) { cs = bv; cf = bi; }
#pragma unroll
        for (int c = 0; c < 4; ++c) if (bi == lane * 4 + c) cv[c] = -INFINITY;
    }
    const float mval = wave_max(lane < 16 ? cs : -INFINITY);
    const float ex = lane < 16 ? expf(cs - mval) : 0.f;
    const float den = wave_sum(ex);
    const int i1 = __shfl(tii[0], (cf >> 4) & 15), i2 = __shfl(tii[1], cf & 15);
    if (lane < 16) {
        eid[(size_t)t * 128 + h * 16 + lane] = i1 * 128 + i2;
        gate[(size_t)t * 128 + h * 16 + lane] = ex / den;
    }
}

__global__ void __launch_bounds__(256) k_peer_gather_b(float* h, const float* __restrict__ ssp_in, int np, const unsigned char* __restrict__ U8, const unsigned char* __restrict__ V8,
                                                       const float* __restrict__ isu, const float* __restrict__ isv, const int* __restrict__ eid, const float* __restrict__ gate,
                                                       bf16* __restrict__ hb, float* __restrict__ ssp_out) {
    const int t = blockIdx.x * 4 + (threadIdx.x >> 6), lane = threadIdx.x & 63;
    float x[16], acc[16];
#pragma unroll
    for (int j = 0; j < 4; ++j) { const f32x4 v = *(const f32x4*)(h + (size_t)t * 1024 + lane * 16 + 4 * j); x[4 * j] = v[0]; x[4 * j + 1] = v[1]; x[4 * j + 2] = v[2]; x[4 * j + 3] = v[3]; }
#pragma unroll
    for (int j = 0; j < 16; ++j) acc[j] = 0.f;
    float ssum = 0.f; for (int p = 0; p < np; ++p) ssum += ssp_in[(size_t)p * T + t];
    const float rstd = rsqrtf(ssum * (1.f / 1024.f) + 1e-6f);
    for (int k = 0; k < 128; ++k) {
        const int e = eid[(size_t)t * 128 + k];
        const float g = gate[(size_t)t * 128 + k];
        const v4u uw = *(const v4u*)(U8 + (size_t)e * 1024 + lane * 16);
        float s = 0.f;
#pragma unroll
        for (int j = 0; j < 4; ++j) { const f32x2 a = __builtin_amdgcn_cvt_pk_f32_fp8((int)uw[j], false), c = __builtin_amdgcn_cvt_pk_f32_fp8((int)uw[j], true);
            s += a[0] * x[4 * j] + a[1] * x[4 * j + 1] + c[0] * x[4 * j + 2] + c[1] * x[4 * j + 3]; }
        s = wave_sum(s);
        const float coef = g * gelu_tanh(s * rstd * isu[e]) * isv[e];
        const v4u vw = *(const v4u*)(V8 + (size_t)e * 1024 + lane * 16);
#pragma unroll
        for (int j = 0; j < 4; ++j) { const f32x2 a = __builtin_amdgcn_cvt_pk_f32_fp8((int)vw[j], false), c = __builtin_amdgcn_cvt_pk_f32_fp8((int)vw[j], true);
            acc[4 * j] = fmaf(coef, a[0], acc[4 * j]); acc[4 * j + 1] = fmaf(coef, a[1], acc[4 * j + 1]); acc[4 * j + 2] = fmaf(coef, c[0], acc[4 * j + 2]); acc[4 * j + 3] = fmaf(coef, c[1], acc[4 * j + 3]); }
    }
    float ss = 0.f;
#pragma unroll
    for (int j = 0; j < 16; ++j) { acc[j] += x[j]; ss += acc[j] * acc[j]; }
    ss = wave_sum(ss);
#pragma unroll
    for (int j = 0; j < 4; ++j) { f32x4 o = {acc[4 * j], acc[4 * j + 1], acc[4 * j + 2], acc[4 * j + 3]}; *(f32x4*)(h + (size_t)t * 1024 + lane * 16 + 4 * j) = o; }
    v4u o0, o1; o0.x = pk2(acc[0], acc[1]); o0.y = pk2(acc[2], acc[3]); o0.z = pk2(acc[4], acc[5]); o0.w = pk2(acc[6], acc[7]);
    o1.x = pk2(acc[8], acc[9]); o1.y = pk2(acc[10], acc[11]); o1.z = pk2(acc[12], acc[13]); o1.w = pk2(acc[14], acc[15]);
    *(v4u*)(hb + (size_t)t * 1024 + lane * 16) = o0; *(v4u*)(hb + (size_t)t * 1024 + lane * 16 + 8) = o1;
    if (lane == 0) ssp_out[t] = ss;
}
}

typedef short v4i16_t __attribute__((ext_vector_type(4)));
__device__ __forceinline__ int crow(int r, int hi) { return (r & 3) + 8 * (r >> 2) + 4 * hi; }
__device__ __forceinline__ unsigned cvtpk(float lo, float hi) { typedef __bf16 bf16x2_t __attribute__((ext_vector_type(2))); f32x2 v = {lo, hi}; bf16x2_t b = __builtin_convertvector(v, bf16x2_t); return __builtin_bit_cast(unsigned, b); }
__device__ __forceinline__ bf16x8 mk8(unsigned a, unsigned b, unsigned c, unsigned d) { v4u w = {a, b, c, d}; return __builtin_bit_cast(bf16x8, w); }
__device__ __forceinline__ bf16x8 vfrag(LAS const unsigned char* p) {
    const v4i16_t lo = __builtin_amdgcn_ds_read_tr16_b64_v4i16((LAS v4i16_t*)p), hi = __builtin_amdgcn_ds_read_tr16_b64_v4i16((LAS v4i16_t*)(p + 512));
    return (bf16x8){lo[0], lo[1], lo[2], lo[3], hi[0], hi[1], hi[2], hi[3]};
}
__device__ __forceinline__ void vtile_load(v4u (&vv)[8], const bf16* vp0, int pitch, int lane) {
    const bf16* vp = vp0 + (size_t)(lane >> 3) * pitch + (lane & 7) * 8;
#pragma unroll
    for (int i = 0; i < 8; ++i) vv[i] = *(const v4u*)(vp + (size_t)i * 8 * pitch);
}
__device__ __forceinline__ void vtile_store(const v4u (&vv)[8], LAS unsigned char* wl, int lane) {
    const int c = lane & 7;
#pragma unroll
    for (int i = 0; i < 8; ++i) { const int kv = 8 * i + (lane >> 3); *(LAS v4u*)(wl + (c >> 2) * 4096 + (kv >> 4) * 1024 + (kv & 15) * 64 + (c & 3) * 16) = vv[i]; }
}
__device__ __forceinline__ void otile_store(const f32x16& o0, const f32x16& o1, LAS unsigned char* stg, bf16* Orow0, int pitch, int lane) {
    const int r32 = lane & 31, hi = lane >> 5;
    LAS unsigned short* s16 = (LAS unsigned short*)stg;
#pragma unroll
    for (int r = 0; r < 16; ++r) { const int orow = crow(r, hi); s16[orow * 64 + r32] = (unsigned short)f2bf(o0[r]); s16[orow * 64 + 32 + r32] = (unsigned short)f2bf(o1[r]); }
#pragma unroll
    for (int i = 0; i < 4; ++i) { const int row = i * 8 + (lane >> 3), ch = lane & 7; const v4u v = *(LAS const v4u*)(stg + row * 128 + ch * 16); *(v4u*)(Orow0 + (size_t)row * pitch + ch * 8) = v; }
}
#define MFMA32(A, B, C) __builtin_amdgcn_mfma_f32_32x32x16_bf16((A), (B), (C), 0, 0, 0)

__device__ __forceinline__ void sb_unit(const bf16* Q, const bf16* K, const bf16* V, bf16* O, int b, int h, int t0, LAS unsigned char* wl, int lane,
                                        const bf16x8 tri0, const bf16x8 tri1, const bf16x8 ones) {
    const int r32 = lane & 31, hi = lane >> 5;
    const size_t rowb = (size_t)b * S;
    const bf16* qp = Q + (rowb + t0 + r32) * 1024 + h * 64 + hi * 8;
    bf16x8 qf[4];
#pragma unroll
    for (int d0 = 0; d0 < 4; ++d0) qf[d0] = *(const bf16x8*)(qp + d0 * 16);
    f32x16 o0 = {}, o1 = {};
    float carry = 0.f;
    const int tdiag = t0 >> 6;
    LAS const unsigned char* vb = wl + ((lane >> 4) & 1) * 32 + (lane & 3) * 8 + (4 * hi + ((lane & 15) >> 2)) * 64;
    bf16x8 kf[8]; v4u vv[8];
#define SB_LOADK(tl) do { const bf16* kp_ = K + (rowb + (tl) * 64 + r32) * 1024 + h * 64 + hi * 8; \
        _Pragma("unroll") for (int d0 = 0; d0 < 4; ++d0) { kf[2 * d0] = *(const bf16x8*)(kp_ + d0 * 16); kf[2 * d0 + 1] = *(const bf16x8*)(kp_ + 32 * 1024 + d0 * 16); } } while (0)
    SB_LOADK(tdiag); vtile_load(vv, V + (rowb + tdiag * 64) * 1024 + h * 64, 1024, lane);
    for (int tile = tdiag; tile >= 0; --tile) {
        const int s0 = tile * 64, tn = tile > 0 ? tile - 1 : 0;
        f32x16 p0 = {}, p1 = {};
#pragma unroll
        for (int d0 = 0; d0 < 4; ++d0) { p0 = MFMA32(kf[2 * d0], qf[d0], p0); p1 = MFMA32(kf[2 * d0 + 1], qf[d0], p1); }
        SB_LOADK(tn);
        vtile_store(vv, wl, lane);
        vtile_load(vv, V + (rowb + tn * 64) * 1024 + h * 64, 1024, lane);
        const int lim = t0 + r32 - s0;
        unsigned lw[16]; float sumL = 0.f;
#pragma unroll
        for (int r = 0; r < 16; r += 2) {
            float La[2], Lb[2];
#pragma unroll
            for (int q = 0; q < 2; ++q) {
                { const float zc = fminf(p0[r + q], 126.f); const float sp = __builtin_amdgcn_logf(1.f + __builtin_amdgcn_exp2f(zc)); const bool ok = crow(r + q, hi) < lim;
                  La[q] = ok ? -sp : 0.f; p0[r + q] = ok ? zc - sp : -INFINITY; }
                { const float zc = fminf(p1[r + q], 126.f); const float sp = __builtin_amdgcn_logf(1.f + __builtin_amdgcn_exp2f(zc)); const bool ok = crow(r + q, hi) + 32 < lim;
                  Lb[q] = ok ? -sp : 0.f; p1[r + q] = ok ? zc - sp : -INFINITY; }
            }
            sumL += (La[0] + La[1]) + (Lb[0] + Lb[1]);
            lw[r >> 1] = cvtpk(La[0], La[1]); lw[8 + (r >> 1)] = cvtpk(Lb[0], Lb[1]);
        }
        f32x16 cinit;
#pragma unroll
        for (int r = 0; r < 16; ++r) cinit[r] = carry;
        const bf16x8 x00 = mk8(lw[0], lw[1], lw[2], lw[3]), x01 = mk8(lw[4], lw[5], lw[6], lw[7]), x10 = mk8(lw[8], lw[9], lw[10], lw[11]), x11 = mk8(lw[12], lw[13], lw[14], lw[15]);
        f32x16 y0 = MFMA32(tri0, x00, cinit); y0 = MFMA32(tri1, x01, y0); y0 = MFMA32(ones, x10, y0); y0 = MFMA32(ones, x11, y0);
        f32x16 y1 = MFMA32(tri0, x10, cinit); y1 = MFMA32(tri1, x11, y1);
        unsigned aw[16];
#pragma unroll
        for (int r = 0; r < 16; r += 2) {
            const float a0 = __builtin_amdgcn_exp2f(p0[r] + y0[r]), a1 = __builtin_amdgcn_exp2f(p0[r + 1] + y0[r + 1]);
            const float c0 = __builtin_amdgcn_exp2f(p1[r] + y1[r]), c1 = __builtin_amdgcn_exp2f(p1[r + 1] + y1[r + 1]);
            aw[r >> 1] = cvtpk(a0, a1); aw[8 + (r >> 1)] = cvtpk(c0, c1);
        }
#pragma unroll
        for (int ks = 0; ks < 4; ++ks) {
            const bf16x8 pa = mk8(aw[4 * ks], aw[4 * ks + 1], aw[4 * ks + 2], aw[4 * ks + 3]);
            o0 = MFMA32(pa, vfrag(vb + ks * 1024), o0);
            o1 = MFMA32(pa, vfrag(vb + 4096 + ks * 1024), o1);
        }
        { const auto rr = __builtin_amdgcn_permlane32_swap(__float_as_uint(sumL), __float_as_uint(sumL), false, false); carry += __uint_as_float(rr[0]) + __uint_as_float(rr[1]); }
        if (__all(carry < -160.f)) break;
    }
#undef SB_LOADK
    otile_store(o0, o1, wl + 8192, O + (rowb + t0) * 1024 + h * 64, 1024, lane);
}
__device__ __forceinline__ void phase_sbatt(const bf16* Q, const bf16* K, const bf16* V, bf16* O, LAS unsigned char* lds, int vcu, int G, int wave, int lane) {
    const int r32 = lane & 31, hi = lane >> 5;
    unsigned t0w[4], t1w[4];
#pragma unroll
    for (int j = 0; j < 8; ++j) {
        const int kv0 = 8 * (j >> 2) + 4 * hi + (j & 3);
        const unsigned b0 = (kv0 > r32) ? 0x3F80u : 0u, b1 = (kv0 + 16 > r32) ? 0x3F80u : 0u;
        if (j & 1) { t0w[j >> 1] |= b0 << 16; t1w[j >> 1] |= b1 << 16; } else { t0w[j >> 1] = b0; t1w[j >> 1] = b1; }
    }
    const bf16x8 tri0 = mk8(t0w[0], t0w[1], t0w[2], t0w[3]), tri1 = mk8(t1w[0], t1w[1], t1w[2], t1w[3]), ones = mk8(0x3F803F80u, 0x3F803F80u, 0x3F803F80u, 0x3F803F80u);
    LAS unsigned char* wl = lds + wave * 12288;
    const int nunits = NB * 16 * (S / 32);
    for (int it = 0; ; ++it) {
        const int u = (it * G + vcu) * NWAVES + wave;
        if (u >= nunits) break;
        const int bh = u >> 7, qb = u & 127;
        sb_unit(Q, K, V, O, bh >> 4, bh & 15, qb * 32, wl, lane, tri0, tri1, ones);
    }
}

__device__ __forceinline__ void sw_unit(const bf16* QKV, const float* qg, const float* kg, float sink2, float slope2, bf16* O, int b, int h, int t0, LAS unsigned char* wl, int lane) {
    const int r32 = lane & 31, hi = lane >> 5, kvh = h >> 2;
    const size_t rowb = (size_t)b * S;
    LAS float* wsf = (LAS float*)(wl + 12288);
    bf16x8 qf[4];
    {
        const bf16* qp = QKV + (rowb + t0 + r32) * 1536 + h * 64 + hi * 8;
        v4u raw[4]; float ss = 0.f;
#pragma unroll
        for (int d0 = 0; d0 < 4; ++d0) { raw[d0] = *(const v4u*)(qp + d0 * 16);
#pragma unroll
            for (int w = 0; w < 4; ++w) { const float a = bflo(raw[d0][w]), c = bfhi(raw[d0][w]); ss += a * a + c * c; } }
        { const auto rr = __builtin_amdgcn_permlane32_swap(__float_as_uint(ss), __float_as_uint(ss), false, false); ss = __uint_as_float(rr[0]) + __uint_as_float(rr[1]); }
        const float rq = rsqrtf(ss * (1.f / 64.f) + 1e-6f) * C2;
#pragma unroll
        for (int d0 = 0; d0 < 4; ++d0) { const f32x4 g0 = *(const f32x4*)(qg + d0 * 16 + hi * 8) * *(const f32x4*)(kg + d0 * 16 + hi * 8), g1 = *(const f32x4*)(qg + d0 * 16 + hi * 8 + 4) * *(const f32x4*)(kg + d0 * 16 + hi * 8 + 4);
            qf[d0] = mk8(cvtpk(bflo(raw[d0][0]) * rq * g0[0], bfhi(raw[d0][0]) * rq * g0[1]), cvtpk(bflo(raw[d0][1]) * rq * g0[2], bfhi(raw[d0][1]) * rq * g0[3]),
                         cvtpk(bflo(raw[d0][2]) * rq * g1[0], bfhi(raw[d0][2]) * rq * g1[1]), cvtpk(bflo(raw[d0][3]) * rq * g1[2], bfhi(raw[d0][3]) * rq * g1[3])); }
    }
    float m = sink2, l = 1.f;
    f32x16 o0 = {}, o1 = {};
    LAS const unsigned char* vb = wl + ((lane >> 4) & 1) * 32 + (lane & 3) * 8 + (4 * hi + ((lane & 15) >> 2)) * 64;
    const int thi = t0 >> 6, tlo = (t0 >= 127) ? ((t0 - 127) >> 6) : 0;
    v4u kf[8], vv[8];
#define SW_LOADK(tl) do { _Pragma("unroll") for (int half = 0; half < 2; ++half) { const bf16* kp_ = QKV + (rowb + (tl) * 64 + 32 * half + r32) * 1536 + 1024 + kvh * 64 + hi * 8; \
        _Pragma("unroll") for (int d0 = 0; d0 < 4; ++d0) kf[2 * d0 + half] = *(const v4u*)(kp_ + d0 * 16); } } while (0)
    SW_LOADK(thi); vtile_load(vv, QKV + (rowb + thi * 64) * 1536 + 1280 + kvh * 64, 1536, lane);
    for (int tile = thi; tile >= tlo; --tile) {
        const int s0 = tile * 64, tn = tile > tlo ? tile - 1 : tlo;
#pragma unroll
        for (int half = 0; half < 2; ++half) {
            float ss = 0.f;
#pragma unroll
            for (int d0 = 0; d0 < 4; ++d0)
#pragma unroll
                for (int w = 0; w < 4; ++w) { const float a = bflo(kf[2 * d0 + half][w]), c = bfhi(kf[2 * d0 + half][w]); ss += a * a + c * c; }
            { const auto rr = __builtin_amdgcn_permlane32_swap(__float_as_uint(ss), __float_as_uint(ss), false, false); ss = __uint_as_float(rr[0]) + __uint_as_float(rr[1]); }
            if (hi == half) wsf[32 * half + r32] = rsqrtf(ss * (1.f / 64.f) + 1e-6f);
        }
        f32x16 p0 = {}, p1 = {};
#pragma unroll
        for (int d0 = 0; d0 < 4; ++d0) { p0 = MFMA32(__builtin_bit_cast(bf16x8, kf[2 * d0]), qf[d0], p0); p1 = MFMA32(__builtin_bit_cast(bf16x8, kf[2 * d0 + 1]), qf[d0], p1); }
        SW_LOADK(tn);
        vtile_store(vv, wl, lane);
        vtile_load(vv, QKV + (rowb + tn * 64) * 1536 + 1280 + kvh * 64, 1536, lane);
        const int dq = t0 + r32 - s0;
        float rmax = -INFINITY;
#pragma unroll
        for (int g = 0; g < 4; ++g) {
            const f32x4 rk0 = *(LAS const f32x4*)(wsf + 8 * g + 4 * hi), rk1 = *(LAS const f32x4*)(wsf + 32 + 8 * g + 4 * hi);
#pragma unroll
            for (int j = 0; j < 4; ++j) { const int r = 4 * g + j;
                { const int dist = dq - crow(r, hi); const bool ok = dist >= 0 && dist < 128; p0[r] = ok ? p0[r] * rk0[j] - slope2 * (float)dist : -INFINITY; rmax = fmaxf(rmax, p0[r]); }
                { const int dist = dq - crow(r, hi) - 32; const bool ok = dist >= 0 && dist < 128; p1[r] = ok ? p1[r] * rk1[j] - slope2 * (float)dist : -INFINITY; rmax = fmaxf(rmax, p1[r]); } }
        }
        { const auto rr = __builtin_amdgcn_permlane32_swap(__float_as_uint(rmax), __float_as_uint(rmax), false, false); rmax = fmaxf(__uint_as_float(rr[0]), __uint_as_float(rr[1])); }
        const float mn = fmaxf(m, rmax);
        const float alpha = __builtin_amdgcn_exp2f(m - mn);
        m = mn;
        float rsum = 0.f; unsigned aw[16];
#pragma unroll
        for (int r = 0; r < 16; r += 2) {
            const float a0 = __builtin_amdgcn_exp2f(p0[r] - mn), a1 = __builtin_amdgcn_exp2f(p0[r + 1] - mn), c0 = __builtin_amdgcn_exp2f(p1[r] - mn), c1 = __builtin_amdgcn_exp2f(p1[r + 1] - mn);
            rsum += (a0 + a1) + (c0 + c1);
            aw[r >> 1] = cvtpk(a0, a1); aw[8 + (r >> 1)] = cvtpk(c0, c1);
        }
        { const auto rr = __builtin_amdgcn_permlane32_swap(__float_as_uint(rsum), __float_as_uint(rsum), false, false); rsum = __uint_as_float(rr[0]) + __uint_as_float(rr[1]); }
        l = l * alpha + rsum;
        if (hi == 0) wsf[64 + r32] = alpha;
#pragma unroll
        for (int g = 0; g < 4; ++g) { const f32x4 f = *(LAS const f32x4*)(wsf + 64 + 8 * g + 4 * hi);
#pragma unroll
            for (int j = 0; j < 4; ++j) { o0[4 * g + j] *= f[j]; o1[4 * g + j] *= f[j]; } }
#pragma unroll
        for (int ks = 0; ks < 4; ++ks) {
            const bf16x8 pa = mk8(aw[4 * ks], aw[4 * ks + 1], aw[4 * ks + 2], aw[4 * ks + 3]);
            o0 = MFMA32(pa, vfrag(vb + ks * 1024), o0);
            o1 = MFMA32(pa, vfrag(vb + 4096 + ks * 1024), o1);
        }
    }
#undef SW_LOADK
    if (hi == 0) wsf[64 + r32] = 1.f / l;
#pragma unroll
    for (int g = 0; g < 4; ++g) { const f32x4 f = *(LAS const f32x4*)(wsf + 64 + 8 * g + 4 * hi);
#pragma unroll
        for (int j = 0; j < 4; ++j) { o0[4 * g + j] *= f[j]; o1[4 * g + j] *= f[j]; } }
    otile_store(o0, o1, wl + 8192, O + (rowb + t0) * 1024 + h * 64, 1024, lane);
}
__device__ __forceinline__ void phase_swatt(const bf16* QKV, const float* qg, const float* kg, const float* sinks, bf16* O, LAS unsigned char* lds, int vcu, int G, int wave, int lane) {
    LAS unsigned char* wl = lds + wave * 12800;
    const int nunits = NB * 16 * (S / 32);
    for (int it = 0; ; ++it) {
        const int u = (it * G + vcu) * NWAVES + wave;
        if (u >= nunits) break;
        const int bh = u >> 7, qb = u & 127, h = bh & 15;
        sw_unit(QKV, qg, kg, sinks[h] * LOG2E, exp2f(-0.5f * (float)(h + 1)) * LOG2E, O, bh >> 4, h, qb * 32, wl, lane);
    }
}

__device__ __forceinline__ void ce_desc(float& a, float& b) { float mx, mn; asm("v_max_f32_e32 %0, %1, %2" : "=v"(mx) : "v"(a), "v"(b)); asm("v_min_f32_e32 %0, %1, %2" : "=v"(mn) : "v"(a), "v"(b)); a = mx; b = mn; }
__device__ __forceinline__ float maxf_raw(float a, float b) { float mx; asm("v_max_f32_e32 %0, %1, %2" : "=v"(mx) : "v"(a), "v"(b)); return mx; }
__device__ __forceinline__ void sort16_desc(float (&v)[16]) {
#pragma unroll
    for (int k = 2; k <= 16; k <<= 1)
#pragma unroll
        for (int j = k >> 1; j > 0; j >>= 1)
#pragma unroll
            for (int i = 0; i < 16; ++i) { const int l = i ^ j; if (l > i) { if ((i & k) == 0) ce_desc(v[i], v[l]); else ce_desc(v[l], v[i]); } }
}
__device__ __forceinline__ void merge16_desc(float (&a)[16], const float (&b)[16]) {
#pragma unroll
    for (int i = 0; i < 16; ++i) a[i] = maxf_raw(a[i], b[15 - i]);
#pragma unroll
    for (int j = 8; j > 0; j >>= 1)
#pragma unroll
        for (int i = 0; i < 16; ++i) { const int l = i ^ j; if (l > i) ce_desc(a[i], a[l]); }
}
__device__ __forceinline__ void top16_of_4x16(float (&g0)[16], float (&g1)[16], float (&g2)[16], float (&g3)[16]) {
    sort16_desc(g0); sort16_desc(g1); sort16_desc(g2); sort16_desc(g3);
    merge16_desc(g0, g1); merge16_desc(g2, g3); merge16_desc(g0, g2);
}
__device__ __forceinline__ float setcode(float v, unsigned clear_mask, unsigned code) { return __uint_as_float((__float_as_uint(v) & clear_mask) | code); }

__device__ __forceinline__ void topk_unit(const bf16* QP, const bf16* SUBK, unsigned short* EID, float* GATE, int tt, int h, int lane) {
    const int r32 = lane & 31, hi = lane >> 5;
    float L[2][16];
#pragma unroll
    for (int p = 0; p < 2; ++p) {
        const bf16* qp = QP + (size_t)(tt * 32 + r32) * 2048 + h * 256 + p * 128 + hi * 8;
        bf16x8 qf[8];
#pragma unroll
        for (int ks = 0; ks < 8; ++ks) qf[ks] = *(const bf16x8*)(qp + ks * 16);
        const bf16* kp = SUBK + ((size_t)(h * 2 + p) * 128 + r32) * 128 + hi * 8;
        float g[4][16];
        bf16x8 afA[8], afB[8];
#define TK_LOAD(af, mt) do { _Pragma("unroll") for (int ks = 0; ks < 8; ++ks) af[ks] = *(const bf16x8*)(kp + (size_t)(mt) * 32 * 128 + ks * 16); } while (0)
#define TK_MMA(af, mt) do { f32x16 acc = {}; _Pragma("unroll") for (int ks = 0; ks < 8; ++ks) acc = MFMA32(af[ks], qf[ks], acc); \
        _Pragma("unroll") for (int r = 0; r < 16; ++r) g[mt][r] = setcode(acc[r], 0xFFFFFF80u, (unsigned)(32 * (mt) + (r & 3) + 8 * (r >> 2))); } while (0)
        TK_LOAD(afA, 0); asm volatile("" ::: "memory");
        TK_LOAD(afB, 1); asm volatile("" ::: "memory"); TK_MMA(afA, 0);
        TK_LOAD(afA, 2); asm volatile("" ::: "memory"); TK_MMA(afB, 1);
        TK_LOAD(afB, 3); asm volatile("" ::: "memory"); TK_MMA(afA, 2);
        TK_MMA(afB, 3);
#undef TK_LOAD
#undef TK_MMA
        top16_of_4x16(g[0], g[1], g[2], g[3]);
        float other[16];
#pragma unroll
        for (int i = 0; i < 16; ++i) {
            g[0][i] = __uint_as_float(__float_as_uint(g[0][i]) | (unsigned)(hi << 2));
            const auto rr = __builtin_amdgcn_permlane32_swap(__float_as_uint(g[0][i]), __float_as_uint(g[0][i]), false, false);
            other[i] = __uint_as_float(hi ? rr[0] : rr[1]);
        }
        merge16_desc(g[0], other);
#pragma unroll
        for (int i = 0; i < 16; ++i) L[p][i] = g[0][i];
    }
    unsigned TA[4], TB[4];
#pragma unroll
    for (int k = 0; k < 16; ++k) {
        const unsigned ca = (__float_as_uint(L[0][k]) & 0x7Fu) << (8 * (k & 3)), cb = (__float_as_uint(L[1][k]) & 0x7Fu) << (8 * (k & 3));
        if ((k & 3) == 0) { TA[k >> 2] = ca; TB[k >> 2] = cb; } else { TA[k >> 2] |= ca; TB[k >> 2] |= cb; }
    }
    float c[4][16];
    {
        int n = 0;
#pragma unroll
        for (int i = 0; i < 16; ++i)
#pragma unroll
            for (int j = 0; j < 16; ++j)
                if ((i + 1) * (j + 1) <= 16) { c[n >> 4][n & 15] = setcode(L[0][i] + L[1][j], 0xFFFFFF00u, (unsigned)(i * 16 + j)); ++n; }
#pragma unroll
        for (int k = 50; k < 64; ++k) c[k >> 4][k & 15] = -INFINITY;
    }
    top16_of_4x16(c[0], c[1], c[2], c[3]);
    float ex[16]; float den = 0.f;
#pragma unroll
    for (int r = 0; r < 16; ++r) { ex[r] = __builtin_amdgcn_exp2f((c[0][r] - c[0][0]) * LOG2E); den += ex[r]; }
    const float inv = 1.f / den;
    unsigned eidv[16];
#pragma unroll
    for (int r = 0; r < 16; ++r) {
        const unsigned code = __float_as_uint(c[0][r]) & 0xFFu, i = code >> 4, j = code & 15u;
        const unsigned sa = (i & 7u) | 0x0C0C0C00u, sb = (j & 7u) | 0x0C0C0C00u;
        const unsigned ia = (i & 8u) ? __builtin_amdgcn_perm(TA[3], TA[2], sa) : __builtin_amdgcn_perm(TA[1], TA[0], sa);
        const unsigned ib = (j & 8u) ? __builtin_amdgcn_perm(TB[3], TB[2], sb) : __builtin_amdgcn_perm(TB[1], TB[0], sb);
        eidv[r] = ia * 128u + ib;
        ex[r] *= inv;
    }
    if (hi == 0) {
        const size_t off = (size_t)(tt * 32 + r32) * 128 + h * 16;
        v4u e0 = {eidv[0] | (eidv[1] << 16), eidv[2] | (eidv[3] << 16), eidv[4] | (eidv[5] << 16), eidv[6] | (eidv[7] << 16)}, e1 = {eidv[8] | (eidv[9] << 16), eidv[10] | (eidv[11] << 16), eidv[12] | (eidv[13] << 16), eidv[14] | (eidv[15] << 16)};
        *(v4u*)(EID + off) = e0; *(v4u*)(EID + off + 8) = e1;
#pragma unroll
        for (int q = 0; q < 4; ++q) { f32x4 g4 = {ex[4 * q], ex[4 * q + 1], ex[4 * q + 2], ex[4 * q + 3]}; *(f32x4*)(GATE + off + 4 * q) = g4; }
    }
}
__device__ __forceinline__ void phase_topk(const bf16* QP, const bf16* SUBK, unsigned short* EID, float* GATE, int vcu, int G, int wave, int lane) {
    const int nunits = (T / 32) * 8;
    for (int it = 0; ; ++it) {
        const int u = (it * G + vcu) * NWAVES + wave;
        if (u >= nunits) break;
        topk_unit(QP, SUBK, EID, GATE, u >> 3, u & 7, lane);
    }
}

__device__ __forceinline__ float gelu_tanh_f(float x) { const float u = 0.7978845608028654f * (x + 0.044715f * x * x * x); const float e = __builtin_amdgcn_exp2f(u * (2.f * LOG2E)); return x * (1.f - __builtin_amdgcn_rcpf(e + 1.f)); }
__device__ __forceinline__ void gather_token(float* h, const float* ssp_in, int np, const unsigned char* U8, const unsigned char* V8, const float* isu, const float* isv,
                                             const int* eid, const float* gate, bf16* hb, float* ssp_out, int t, int lane) {
    float x[16], acc[16];
#pragma unroll
    for (int j = 0; j < 4; ++j) { const f32x4 v = *(const f32x4*)(h + (size_t)t * 1024 + lane * 16 + 4 * j); x[4 * j] = v[0]; x[4 * j + 1] = v[1]; x[4 * j + 2] = v[2]; x[4 * j + 3] = v[3]; }
#pragma unroll
    for (int j = 0; j < 16; ++j) acc[j] = 0.f;
    float ssum = 0.f; for (int p = 0; p < np; ++p) ssum += ssp_in[(size_t)p * T + t];
    const float rstd = rsqrtf(ssum * (1.f / 1024.f) + 1e-6f);
    for (int k = 0; k < 128; ++k) {
        const int e = eid[(size_t)t * 128 + k];
        const float g = gate[(size_t)t * 128 + k];
        const v4u uw = *(const v4u*)(U8 + (size_t)e * 1024 + lane * 16);
        const v4u vw = *(const v4u*)(V8 + (size_t)e * 1024 + lane * 16);
        float s = 0.f;
#pragma unroll
        for (int j = 0; j < 4; ++j) { const f32x2 a = __builtin_amdgcn_cvt_pk_f32_fp8((int)uw[j], false), c = __builtin_amdgcn_cvt_pk_f32_fp8((int)uw[j], true);
            s += a[0] * x[4 * j] + a[1] * x[4 * j + 1] + c[0] * x[4 * j + 2] + c[1] * x[4 * j + 3]; }
        s = wave_sum(s);
        const float coef = g * gelu_tanh_f(s * rstd * isu[e]) * isv[e];
#pragma unroll
        for (int j = 0; j < 4; ++j) { const f32x2 a = __builtin_amdgcn_cvt_pk_f32_fp8((int)vw[j], false), c = __builtin_amdgcn_cvt_pk_f32_fp8((int)vw[j], true);
            acc[4 * j] = fmaf(coef, a[0], acc[4 * j]); acc[4 * j + 1] = fmaf(coef, a[1], acc[4 * j + 1]); acc[4 * j + 2] = fmaf(coef, c[0], acc[4 * j + 2]); acc[4 * j + 3] = fmaf(coef, c[1], acc[4 * j + 3]); }
    }
    float ss = 0.f;
#pragma unroll
    for (int j = 0; j < 16; ++j) { acc[j] += x[j]; ss += acc[j] * acc[j]; }
    ss = wave_sum(ss);
#pragma unroll
    for (int j = 0; j < 4; ++j) { f32x4 o = {acc[4 * j], acc[4 * j + 1], acc[4 * j + 2], acc[4 * j + 3]}; *(f32x4*)(h + (size_t)t * 1024 + lane * 16 + 4 * j) = o; }
    v4u o0, o1; o0.x = pk2(acc[0], acc[1]); o0.y = pk2(acc[2], acc[3]); o0.z = pk2(acc[4], acc[5]); o0.w = pk2(acc[6], acc[7]);
    o1.x = pk2(acc[8], acc[9]); o1.y = pk2(acc[10], acc[11]); o1.z = pk2(acc[12], acc[13]); o1.w = pk2(acc[14], acc[15]);
    *(v4u*)(hb + (size_t)t * 1024 + lane * 16) = o0; *(v4u*)(hb + (size_t)t * 1024 + lane * 16 + 8) = o1;
    if (lane == 0) ssp_out[t] = ss;
}
__device__ __forceinline__ void phase_gather(float* h, const float* ssp_in, int np, const unsigned char* U8, const unsigned char* V8, const float* isu, const float* isv,
                                             const int* eid, const float* gate, bf16* hb, float* ssp_out, int gw, int NGW, int lane) {
    for (int t = gw; t < T; t += NGW) gather_token(h, ssp_in, np, U8, V8, isu, isv, eid, gate, hb, ssp_out, t, lane);
}

#define DPP_ADD(s, CTRL) do { (s) += __builtin_bit_cast(float, __builtin_amdgcn_update_dpp(0, __builtin_bit_cast(int, (s)), (CTRL), 0xF, 0xF, true)); } while (0)
#define DPP_XOR1 0xB1
#define DPP_XOR2 0x4E
#define DPP_HALF_MIRROR 0x141
#define DPP_ROW_MIRROR 0x140
#define DPP_ROW_ROR8 0x128

__device__ __forceinline__ void peer_rows(v4u (&row)[16], const v4u (&ev)[4], const unsigned char* tab, unsigned lane_off) {
#pragma unroll
    for (int j = 0; j < 16; ++j) row[j] = *(const v4u*)(tab + (size_t)(ev[j >> 2][j & 3] + lane_off));
}
__device__ __forceinline__ void fmac_s(float& acc, float a, float b) { asm("v_fmac_f32_e32 %0, %1, %2" : "+v"(acc) : "v"(a), "v"(b)); }
__device__ __forceinline__ float fmul_s(float a, float b) { float r; asm("v_mul_f32_e32 %0, %1, %2" : "=v"(r) : "v"(a), "v"(b)); return r; }
__device__ __forceinline__ float fadd_s(float a, float b) { float r; asm("v_add_f32_e32 %0, %1, %2" : "=v"(r) : "v"(a), "v"(b)); return r; }
#define DPP_ADD_ASM(d, s, CTRL) asm("s_nop 1\n\tv_add_f32_dpp %0, %1, %1 " CTRL " row_mask:0xf bank_mask:0xf" : "=v"(d) : "v"(s))
typedef _Float16 h16x2 __attribute__((ext_vector_type(2)));
__device__ __forceinline__ h16x2 as_h2(unsigned w) { return __builtin_bit_cast(h16x2, w); }
__device__ __forceinline__ unsigned as_u(h16x2 v) { return __builtin_bit_cast(unsigned, v); }
__device__ __forceinline__ void peer_u_token(const v4u (&row)[16], const v4u (&xw)[2], _Float16* hp_t, int r, int c) {
    h16x2 ss[16];
#pragma unroll
    for (int j = 0; j < 16; ++j) {
        h16x2 s0 = {(_Float16)0.f, (_Float16)0.f}, s1 = s0;
#pragma unroll
        for (int w = 0; w < 4; ++w) {
            const h16x2 lo = __builtin_amdgcn_cvt_scalef32_pk_f16_fp8((int)row[j][w], 0.0625f, false), hi = __builtin_amdgcn_cvt_scalef32_pk_f16_fp8((int)row[j][w], 0.0625f, true);
            s0 = __builtin_elementwise_fma(lo, as_h2(xw[w >> 1][(2 * w) & 3]), s0); s1 = __builtin_elementwise_fma(hi, as_h2(xw[w >> 1][(2 * w + 1) & 3]), s1);
        }
        ss[j] = s0 + s1;
    }
    const bool b0 = (c & 1) != 0, b1 = (c & 2) != 0, b2 = (c & 4) != 0;
    h16x2 a[8], b[4], d[2];
#pragma unroll
    for (int j = 0; j < 8; ++j) { const unsigned keep = b0 ? as_u(ss[j + 8]) : as_u(ss[j]), send = b0 ? as_u(ss[j]) : as_u(ss[j + 8]);
        a[j] = as_h2(keep) + as_h2((unsigned)__builtin_amdgcn_update_dpp(0, (int)send, DPP_XOR1, 0xF, 0xF, true)); }
#pragma unroll
    for (int j = 0; j < 4; ++j) { const unsigned keep = b1 ? as_u(a[j + 4]) : as_u(a[j]), send = b1 ? as_u(a[j]) : as_u(a[j + 4]);
        b[j] = as_h2(keep) + as_h2((unsigned)__builtin_amdgcn_update_dpp(0, (int)send, DPP_XOR2, 0xF, 0xF, true)); }
#pragma unroll
    for (int j = 0; j < 2; ++j) { const unsigned keep = b2 ? as_u(b[j + 2]) : as_u(b[j]), send = b2 ? as_u(b[j]) : as_u(b[j + 2]);
        d[j] = as_h2(keep) + as_h2((unsigned)__shfl_xor((int)send, 4)); }
    const float v0 = (float)d[0][0] + (float)d[0][1], v1 = (float)d[1][0] + (float)d[1][1];
    const int rw = 8 * (c & 1) + 4 * ((c >> 1) & 1) + 2 * (c >> 2);
    *(unsigned*)(hp_t + 16 * r + rw) = as_u((h16x2){(_Float16)v0, (_Float16)v1});
}
__device__ __forceinline__ void glds16(const void* gsrc, unsigned lds_dst) { unsigned keep;
    asm volatile("s_mov_b32 %0, m0\n\ts_mov_b32 m0, %2\n\ts_nop 0\n\tglobal_load_lds_dwordx4 %1, off\n\ts_mov_b32 m0, %0" : "=&s"(keep) : "v"(gsrc), "s"(lds_dst) : "memory"); }
#define LDS_ADDR(p) ((unsigned)__builtin_amdgcn_readfirstlane((int)(unsigned)(uintptr_t)(p)))
typedef unsigned u32x2 __attribute__((ext_vector_type(2)));
#define FENCE() asm volatile("" ::: "memory")
#define PEER_SLOT(i) (wl + ((((i) >> 2) & 1) * 4096 + ((i) & 3) * 1024))
__device__ __forceinline__ void phase_peer_u(const bf16* h, const unsigned short* eid, const unsigned char* U8, _Float16* hp, LAS unsigned char* wl, int sl, int m, int nmem, int wave, int lane) {
    const int r = lane >> 3, c = lane & 7;
    const int nw = nmem * NWAVES, t0 = m * NWAVES + wave;
    const unsigned char* tab = U8 + 128 * sl; const unsigned loff16 = 16u * (unsigned)c;
    const int ntok = (T - t0 + nw - 1) / nw;
    _Float16* hp_s = hp + (size_t)sl * T * 128;
#define TOK(i) ((i) < ntok ? t0 + (i) * nw : t0)
#define STG_LD(k, i) do { const int t_ = TOK(i); sE[k] = *(const unsigned*)(eid + (size_t)t_ * 128 + 2 * lane); sX[k] = *(const unsigned*)(h + (size_t)t_ * 1024 + 128 * sl + 2 * lane); } while (0)
#define STG_ST(k, i) do { LAS unsigned char* s_ = PEER_SLOT(i); const u32x2 e2_ = {(sE[k] & 0xFFFFu) << 10, (sE[k] >> 16) << 10}; *(LAS u32x2*)(s_ + 8 * lane) = e2_; \
        *(LAS unsigned*)(s_ + 512 + 4 * lane) = as_u((h16x2){(_Float16)bflo(sX[k]), (_Float16)bfhi(sX[k])}); } while (0)
#define RD_EV(i) do { LAS const unsigned char* s_ = PEER_SLOT(i); _Pragma("unroll") for (int q = 0; q < 4; ++q) ev[q] = *(LAS const v4u*)(s_ + 64 * r + 16 * q); } while (0)
#define RD_X(i) do { LAS const unsigned char* s_ = PEER_SLOT(i); xw[0] = *(LAS const v4u*)(s_ + 512 + 32 * c); xw[1] = *(LAS const v4u*)(s_ + 512 + 32 * c + 16); } while (0)
    v4u ev[4], rA[16], rB[16], xw[2]; unsigned sE[4], sX[4];
#pragma unroll
    for (int k = 0; k < 4; ++k) STG_LD(k, k);
    for (int i0 = 0; i0 < ntok; i0 += 4) {
#pragma unroll
        for (int k = 0; k < 4; ++k) STG_ST(k, i0 + k);
        FENCE();
        RD_EV(i0); peer_rows(rA, ev, tab, loff16); FENCE();
#pragma unroll
        for (int k = 0; k < 4; ++k) STG_LD(k, i0 + 4 + k);
        FENCE();
#pragma unroll
        for (int k = 0; k < 4; k += 2) {
            RD_EV(i0 + k + 1); peer_rows(rB, ev, tab, loff16); FENCE();
            RD_X(i0 + k); peer_u_token(rA, xw, hp_s + (size_t)TOK(i0 + k) * 128, r, c); FENCE();
            if (k + 2 < 4) { RD_EV(i0 + k + 2); peer_rows(rA, ev, tab, loff16); FENCE(); }
            RD_X(i0 + k + 1); peer_u_token(rB, xw, hp_s + (size_t)TOK(i0 + k + 1) * 128, r, c); FENCE();
        }
    }
#undef STG_LD
#undef STG_ST
#undef RD_X
}
__device__ __forceinline__ void phase_peer_coef(const _Float16* hp, const float* ssp_in, int np, const unsigned short* eid, const float* gate, const float* isu, const float* isv, _Float16* coef, int gw, int NGW, int lane) {
    for (int t = gw; t < T; t += NGW) {
        float ssum = 0.f; for (int p = 0; p < np; ++p) ssum += ssp_in[(size_t)p * T + t];
        const float rstd = rsqrtf(ssum * (1.f / 1024.f) + 1e-6f);
#pragma unroll
        for (int half = 0; half < 2; ++half) {
            const int k = lane + 64 * half; float s = 0.f;
#pragma unroll
            for (int s8 = 0; s8 < 8; ++s8) s += (float)hp[((size_t)s8 * T + t) * 128 + k];
            const int e = eid[(size_t)t * 128 + k];
            coef[(size_t)t * 128 + k] = (_Float16)(gate[(size_t)t * 128 + k] * gelu_tanh_f(s * (16.f * rstd) * isu[e]) * (256.f * isv[e]));
        }
    }
}
__device__ __forceinline__ void peer_v_token(const v4u (&row)[16], const v4u (&cw)[2], const f32x2 hold, float* hdst_l, bf16* hb_l, float* ssp_t, int lane) {
    h16x2 ah[8];
#pragma unroll
    for (int i = 0; i < 8; ++i) ah[i] = (h16x2){(_Float16)0.f, (_Float16)0.f};
#pragma unroll
    for (int j = 0; j < 16; ++j) {
        const unsigned cd = cw[j >> 3][(j >> 1) & 3]; const h16x2 ch = __builtin_bit_cast(h16x2, __builtin_amdgcn_perm(cd, cd, (j & 1) ? 0x07060706u : 0x05040504u));
#pragma unroll
        for (int w = 0; w < 4; ++w) {
            const h16x2 lo = __builtin_amdgcn_cvt_scalef32_pk_f16_fp8((int)row[j][w], 0.00390625f, false), hi = __builtin_amdgcn_cvt_scalef32_pk_f16_fp8((int)row[j][w], 0.00390625f, true);
            ah[2 * w] = __builtin_elementwise_fma(lo, ch, ah[2 * w]); ah[2 * w + 1] = __builtin_elementwise_fma(hi, ch, ah[2 * w + 1]);
        }
    }
    h16x2 A[4], Bq[2];
#pragma unroll
    for (int i = 0; i < 4; ++i) { const auto rr = __builtin_amdgcn_permlane32_swap(as_u(ah[i]), as_u(ah[i + 4]), false, false); A[i] = as_h2(rr[0]) + as_h2(rr[1]); }
#pragma unroll
    for (int i = 0; i < 2; ++i) { const auto rr = __builtin_amdgcn_permlane16_swap(as_u(A[i]), as_u(A[i + 2]), false, false); Bq[i] = as_h2(rr[0]) + as_h2(rr[1]); }
    const bool b3 = (lane & 8) != 0;
    const unsigned keep = b3 ? as_u(Bq[1]) : as_u(Bq[0]), send = b3 ? as_u(Bq[0]) : as_u(Bq[1]);
    const h16x2 Cq = as_h2(keep) + as_h2((unsigned)__builtin_amdgcn_update_dpp(0, (int)send, DPP_ROW_ROR8, 0xF, 0xF, true));
    const float n0 = hold[0] + (float)Cq[0], n1 = hold[1] + (float)Cq[1];
    if (hdst_l) { f32x2 o = {n0, n1}; *(f32x2*)hdst_l = o; return; }
    *(unsigned*)hb_l = pk2(n0, n1);
    const float ss = wave_sum(n0 * n0 + n1 * n1);
    if (lane == 0) *ssp_t = ss;
}
#define PEER_SLOTV(i) (wl + ((((i) >> 2) & 1) * 8192 + ((i) & 3) * 2048))
__device__ __forceinline__ void phase_peer_v(const bf16* h, float* hdst, const unsigned short* eid, const _Float16* coef, const unsigned char* V8, bf16* hb, float* ssp_out, float* scratch, LAS unsigned char* wl, int sl, int m, int nmem, int wave, int lane) {
    const int r = lane >> 3, c = lane & 7;
    const int nw = nmem * NWAVES, t0 = m * NWAVES + wave;
    const unsigned char* tab = V8 + 128 * sl; const unsigned loff16 = 16u * (unsigned)c;
    const int ntok = (T - t0 + nw - 1) / nw;
    const size_t loff = 128 * sl + 16 * c + 2 * r; float* ssp_s = ssp_out + (size_t)sl * T;
#define STG_LD(k, i) do { const int t_ = TOK(i); sE[k] = *(const unsigned*)(eid + (size_t)t_ * 128 + 2 * lane); sC[k] = *(const unsigned*)(coef + (size_t)t_ * 128 + 2 * lane); sH[k] = *(const unsigned*)(h + (size_t)t_ * 1024 + 128 * sl + 2 * lane); } while (0)
#define STG_ST(k, i) do { LAS unsigned char* s_ = PEER_SLOTV(i); const u32x2 e2_ = {(sE[k] & 0xFFFFu) << 10, (sE[k] >> 16) << 10}; *(LAS u32x2*)(s_ + 8 * lane) = e2_; *(LAS unsigned*)(s_ + 512 + 4 * lane) = sC[k]; *(LAS unsigned*)(s_ + 1024 + 4 * lane) = sH[k]; } while (0)
#define RD_EVV(i) do { LAS const unsigned char* s_ = PEER_SLOTV(i); _Pragma("unroll") for (int q = 0; q < 4; ++q) ev[q] = *(LAS const v4u*)(s_ + 64 * r + 16 * q); } while (0)
#define RD_C(i) do { LAS const unsigned char* s_ = PEER_SLOTV(i); cv[0] = *(LAS const v4u*)(s_ + 512 + 32 * r); cv[1] = *(LAS const v4u*)(s_ + 512 + 32 * r + 16); { const unsigned hw_ = *(LAS const unsigned*)(s_ + 1024 + (16 * c + 2 * r) * 2); hold = (f32x2){bflo(hw_), bfhi(hw_)}; } } while (0)
#define V_TOK(i, R) do { const bool ok_ = (i) < ntok; const size_t o_ = (size_t)TOK(i) * 1024 + loff; \
        peer_v_token(R, cv, hold, hdst ? (ok_ ? hdst : scratch) + o_ : nullptr, (ok_ ? hb : (bf16*)scratch) + o_, (ok_ ? ssp_s : scratch) + TOK(i), lane); } while (0)
    v4u ev[4], rA[16], rB[16], cv[2]; f32x2 hold; unsigned sE[4], sC[4], sH[4];
#pragma unroll
    for (int k = 0; k < 4; ++k) STG_LD(k, k);
    for (int i0 = 0; i0 < ntok; i0 += 4) {
#pragma unroll
        for (int k = 0; k < 4; ++k) STG_ST(k, i0 + k);
        FENCE();
        RD_EVV(i0); peer_rows(rA, ev, tab, loff16); FENCE();
#pragma unroll
        for (int k = 0; k < 4; ++k) STG_LD(k, i0 + 4 + k);
        FENCE();
#pragma unroll
        for (int k = 0; k < 4; k += 2) {
            RD_EVV(i0 + k + 1); peer_rows(rB, ev, tab, loff16); FENCE();
            RD_C(i0 + k); V_TOK(i0 + k, rA); FENCE();
            if (k + 2 < 4) { RD_EVV(i0 + k + 2); peer_rows(rA, ev, tab, loff16); FENCE(); }
            RD_C(i0 + k + 1); V_TOK(i0 + k + 1, rB); FENCE();
        }
    }
#undef STG_LD
#undef STG_ST
#undef V_TOK
#undef RD_EVV
#undef RD_EV
#undef RD_C
#undef TOK
#undef FENCE
}

#ifndef PROBE_REP
#define PROBE_REP 0x80u
#endif
enum Phase { PH_PREP = 0, PH_QKV0 = 1, PH_SBATT = 2, PH_OPROJ0 = 3, PH_PQ0 = 4, PH_TOPK0 = 5, PH_GATH0 = 6, PH_QKV1 = 7, PH_SWATT = 8, PH_OPROJ1 = 9, PH_PQ1 = 10, PH_TOPK1 = 11, PH_GATH1 = 12, PH_N = 13 };

__global__ void __launch_bounds__(NWAVES * 64, 2) mega(Args a) {
    extern __shared__ __attribute__((aligned(16))) unsigned char lds_raw[];
    LAS unsigned char* lds = (LAS unsigned char*)lds_raw;
    volatile LAS unsigned* MISC = (volatile LAS unsigned*)(lds + MISC_OFF);
    LAS float* rs = (LAS float*)(lds + RS_OFF);
    const int tid = threadIdx.x, lane = tid & 63, wave = __builtin_amdgcn_readfirstlane(tid >> 6);
    const int G = gridDim.x; const int bx = blockIdx.x; const int vcu = (G % 8 == 0) ? (bx % 8) * (G / 8) + bx / 8 : bx;
    const int gw = vcu * NWAVES + wave, NGW = G * NWAVES;
    unsigned char* ws = a.ws;
    gu32* ctl = (gu32*)(ws + WS_CTL);
    for (int u = tid; u < 64; u += NWAVES * 64) ((LAS unsigned*)(lds + MISC_OFF))[u] = 0u;
    __syncthreads();
    XcdBarrier bar = xcd_barrier_post((unsigned*)(ctl + CW_BAR) + a.li * XCD_BAR_WORDS, MISC + 8);
    bool first = true;
#define PHASE_ON(k) ((a.mask >> (k)) & 1u)
#define SEAM() do { if (!first) xcd_barrier(bar); first = false; } while (0)

    bf16* HB = (bf16*)(ws + WS_HB); bf16* QB = (bf16*)(ws + WS_QB); bf16* AO = (bf16*)(ws + WS_AO); bf16* QP = (bf16*)(ws + WS_QP);
    float* SSP0 = (float*)(ws + WS_SSP); float* SSP1 = SSP0 + 16 * T; float* SSP2 = SSP1 + 16 * T; float* SSP3 = SSP2 + 16 * T;

#define NREP(b) (1 + (int)((PROBE_REP >> (b)) & 1u))
    if (PHASE_ON(PH_PREP)) { SEAM(); for (int q = 0; q < NREP(0); ++q) phase_prep(a, lds, gw, NGW, wave, lane); }

    if (PHASE_ON(PH_QKV0)) { SEAM();
        _Pragma("unroll") for (int q = 0; q < NREP(1); ++q) {
        pg8::Gemm g{HB, (const bf16*)(ws + WS_WQKV0), T, 3072, 1024}; pg8::StaticOrder So; So.init(T, 3072, G, bx);
        fill_rs(rs, So, SSP0, 1, tid);
        pg8::EpiScaleBf16 E{QB, 1024, 1024, (size_t)(WS_KB - WS_QB) / 2, C2, rs};
        pg8::gemm_phase<pg8::EpiScaleBf16, pg8::StaticOrder, true, true>(lds, g, So, E); }
    }
    if (PHASE_ON(PH_SBATT)) { SEAM(); for (int q = 0; q < NREP(2); ++q) phase_sbatt(QB, (const bf16*)(ws + WS_KB), (const bf16*)(ws + WS_VB), AO, lds, vcu, G, wave, lane); }
    if (PHASE_ON(PH_OPROJ0)) { SEAM();
        _Pragma("unroll") for (int q = 0; q < NREP(3); ++q) {
        pg8::Gemm g{AO, (const bf16*)(ws + WS_WO0), T, 1024, 1024}; pg8::StaticOrder So; So.init(T, 1024, G, bx);
        pg8::EpiResid E{HB, HB, SSP1, T};
        pg8::gemm_phase<pg8::EpiResid, pg8::StaticOrder, true, true>(lds, g, So, E); }
    }
    if (PHASE_ON(PH_PQ0)) { SEAM();
        _Pragma("unroll") for (int q = 0; q < NREP(4); ++q) {
        pg8::Gemm g{HB, (const bf16*)(ws + WS_WPQ0), T, 2048, 1024}; pg8::StaticOrder So; So.init(T, 2048, G, bx);
        fill_rs(rs, So, SSP1, 16, tid);
        pg8::EpiScaleBf16 E{QP, 2048, 0, 0, 1.f, rs};
        pg8::gemm_phase<pg8::EpiScaleBf16, pg8::StaticOrder, true, true>(lds, g, So, E);
        _Pragma("unroll") for (int q2 = 0; q2 < NREP(5); ++q2) { pg8::Unit u; for (int ui = 0; So.next(ui, u); ++ui) topk_unit(QP, (const bf16*)(ws + WS_SUBK), (unsigned short*)(ws + WS_EID), (float*)(ws + WS_GATE), u.pm * 8 + wave, u.pn, lane); } }
    }
    const int sl = bx & 7, smem = bx >> 3, nmem = (G - 1 - sl) / 8 + 1;
    float* HP = (float*)(ws + WS_HP); _Float16* COEF = (_Float16*)(ws + WS_COEF); const unsigned short* EIDp = (const unsigned short*)(ws + WS_EID); const float* GATEp = (const float*)(ws + WS_GATE);
    if (PHASE_ON(PH_GATH0)) { SEAM();
        _Pragma("unroll") for (int q = 0; q < NREP(6); ++q) phase_peer_u(HB, EIDp, ws + WS_U8, (_Float16*)HP, lds + wave * 16384, sl, smem, nmem, wave, lane);
        xcd_barrier(bar);
        _Pragma("unroll") for (int q = 0; q < NREP(13); ++q) phase_peer_coef((const _Float16*)HP, SSP1, 16, EIDp, GATEp, (const float*)(ws + WS_ISU), (const float*)(ws + WS_ISV), COEF, gw, NGW, lane);
        xcd_barrier(bar);
        if (NREP(14) > 1) phase_peer_v(HB, nullptr, EIDp, COEF, ws + WS_V8, (bf16*)QP, SSP3, HP, lds + wave * 16384, sl, smem, nmem, wave, lane);
        phase_peer_v(HB, nullptr, EIDp, COEF, ws + WS_V8, HB, SSP2, HP, lds + wave * 16384, sl, smem, nmem, wave, lane);
    }
    if (PHASE_ON(PH_QKV1)) { SEAM();
        _Pragma("unroll") for (int q = 0; q < NREP(7); ++q) {
        pg8::Gemm g{HB, (const bf16*)(ws + WS_WQKV1), T, 1536, 1024}; pg8::StaticOrder So; So.init(T, 1536, G, bx);
        fill_rs(rs, So, SSP2, 8, tid);
        pg8::EpiScaleBf16 E{QB, 1536, 0, 0, 1.f, rs};
        pg8::gemm_phase<pg8::EpiScaleBf16, pg8::StaticOrder, true, true>(lds, g, So, E); }
    }
    if (PHASE_ON(PH_SWATT)) { SEAM(); for (int q = 0; q < NREP(8); ++q) phase_swatt(QB, a.in[6], a.in[7], a.in[8], AO, lds, vcu, G, wave, lane); }
    if (PHASE_ON(PH_OPROJ1)) { SEAM();
        _Pragma("unroll") for (int q = NREP(9) - 1; q >= 0; --q) {
        pg8::Gemm g{AO, (const bf16*)(ws + WS_WO1), T, 1024, 1024}; pg8::StaticOrder So; So.init(T, 1024, G, bx);
        pg8::EpiResid E{HB, q ? (bf16*)QP : HB, q ? SSP0 : SSP3, T};
        pg8::gemm_phase<pg8::EpiResid, pg8::StaticOrder, true, true>(lds, g, So, E); }
    }
    if (PHASE_ON(PH_PQ1)) { SEAM();
        _Pragma("unroll") for (int q = 0; q < NREP(10); ++q) {
        pg8::Gemm g{HB, (const bf16*)(ws + WS_WPQ1), T, 2048, 1024}; pg8::StaticOrder So; So.init(T, 2048, G, bx);
        fill_rs(rs, So, SSP3, 16, tid);
        pg8::EpiScaleBf16 E{QP, 2048, 0, 0, 1.f, rs};
        pg8::gemm_phase<pg8::EpiScaleBf16, pg8::StaticOrder, true, true>(lds, g, So, E);
        _Pragma("unroll") for (int q2 = 0; q2 < NREP(11); ++q2) { pg8::Unit u; for (int ui = 0; So.next(ui, u); ++ui) topk_unit(QP, (const bf16*)(ws + WS_SUBK) + (size_t)8 * 2 * 128 * 128, (unsigned short*)(ws + WS_EID), (float*)(ws + WS_GATE), u.pm * 8 + wave, u.pn, lane); } }
    }
    if (PHASE_ON(PH_GATH1)) { SEAM();
        _Pragma("unroll") for (int q = 0; q < NREP(12); ++q) phase_peer_u(HB, EIDp, ws + WS_U8 + (size_t)16384 * 1024, (_Float16*)HP, lds + wave * 16384, sl, smem, nmem, wave, lane);
        xcd_barrier(bar);
        _Pragma("unroll") for (int q = 0; q < NREP(13); ++q) phase_peer_coef((const _Float16*)HP, SSP3, 16, EIDp, GATEp, (const float*)(ws + WS_ISU) + 16384, (const float*)(ws + WS_ISV) + 16384, COEF, gw, NGW, lane);
        xcd_barrier(bar);
        if (NREP(14) > 1) phase_peer_v(HB, HP, EIDp, COEF, ws + WS_V8 + (size_t)16384 * 1024, (bf16*)QP, SSP0, HP, lds + wave * 16384, sl, smem, nmem, wave, lane);
        phase_peer_v(HB, a.out, EIDp, COEF, ws + WS_V8 + (size_t)16384 * 1024, (bf16*)QP, SSP0, HP,
                     lds + wave * 16384, sl, smem, nmem, wave, lane);
    }
    if (NREP(16) > 1) { for (int q = 0; q < 10; ++q) xcd_barrier(bar); }
#undef NREP
#undef PHASE_ON
#undef SEAM
}

static void launch_mega(const Args& a0, unsigned mask, int li, int grid, hipStream_t stream) {
    Args a = a0; a.mask = mask; a.li = li; a.rep = 0u; a.pad = 0;
    void* params[] = {&a};
    hipError_t e = hipLaunchCooperativeKernel((const void*)mega, dim3(grid), dim3(NWAVES * 64), params, LDS_BYTES, stream);
    if (e != hipSuccess) fprintf(stderr, "kernel_launch: cooperative launch failed: %s (grid %d)\n", hipGetErrorString(e), grid);
}

extern "C" void kernel_launch(void* const* d_in, const int* in_sizes, int n_in, void* d_out, int out_size, void* d_ws, size_t ws_size, hipStream_t stream) {
    static int grid = 0;
    if (grid == 0) {
        if (n_in != 15 || out_size != T * D || ws_size < WS_END) { fprintf(stderr, "kernel_launch: unexpected shapes (n_in %d out %d ws %zu)\n", n_in, out_size, ws_size); grid = -1; return; }
        int dev = 0, cus = 0, per_cu = 0;
        if (hipGetDevice(&dev) != hipSuccess || hipDeviceGetAttribute(&cus, hipDeviceAttributeMultiprocessorCount, dev) != hipSuccess) { grid = -1; return; }
        if (hipFuncSetAttribute((const void*)mega, hipFuncAttributeMaxDynamicSharedMemorySize, LDS_BYTES) != hipSuccess) { fprintf(stderr, "kernel_launch: hipFuncSetAttribute failed\n"); grid = -1; return; }
        if (hipOccupancyMaxActiveBlocksPerMultiprocessor(&per_cu, (const void*)mega, NWAVES * 64, LDS_BYTES) != hipSuccess || per_cu < 1) { fprintf(stderr, "kernel_launch: occupancy query says %d blocks per CU\n", per_cu); per_cu = 1; }
        (void)hipGetLastError();
        grid = cus;
        if (grid != 256) fprintf(stderr, "kernel_launch: note: %d CUs (tuned for 256)\n", grid);
    }
    if (grid < 0) return;
    (void)hipMemsetAsync((char*)d_ws + WS_CTL, 0, CTL_ZERO_BYTES, stream);
    Args a{};
    for (int i = 0; i < 15; ++i) a.in[i] = (const float*)d_in[i];
    a.out = (float*)d_out; a.ws = (unsigned char*)d_ws;
    unsigned char* ws = (unsigned char*)d_ws;
    bf16* QB = (bf16*)(ws + WS_QB); bf16* KB = (bf16*)(ws + WS_KB); bf16* VB = (bf16*)(ws + WS_VB); bf16* AO = (bf16*)(ws + WS_AO); bf16* QP = (bf16*)(ws + WS_QP); bf16* HB = (bf16*)(ws + WS_HB);
    float* SSP0 = (float*)(ws + WS_SSP); float* SSP1 = SSP0 + 16 * T; float* SSP2 = SSP1 + 16 * T;  float* SSP3 = SSP2 + 16 * T;
    int* EID = (int*)(ws + WS_EID); float* GATE = (float*)(ws + WS_GATE);
    const unsigned char* U8 = ws + WS_U8; const unsigned char* V8 = ws + WS_V8; const float* ISU = (const float*)(ws + WS_ISU); const float* ISV = (const float*)(ws + WS_ISV);
    const bf16* SUBK = (const bf16*)(ws + WS_SUBK);
#define M(k) (1u << (k))
    launch_mega(a, (1u << PH_N) - 1u, 0, grid, stream);
#undef M
}
```

```cpp
#include <hip/hip_runtime.h>
#include <cstdint>
#include <cstdio>

constexpr int D = 1024, NB = 4, S = 4096, T = NB * S;
constexpr float LOG2E = 1.4426950408889634f;
constexpr float C2 = 0.125f * LOG2E;

constexpr size_t MiB = 1u << 20;
constexpr size_t WS_CTL = 0, CTL_ZERO_BYTES = 1 * MiB;
constexpr size_t WS_WQKV0 = 2 * MiB, WS_WO0 = 8 * MiB, WS_WQKV1 = 10 * MiB, WS_WO1 = 13 * MiB, WS_WPQ0 = 15 * MiB, WS_WPQ1 = 19 * MiB;
constexpr size_t WS_SUBK = 23 * MiB;
constexpr size_t WS_ISU = 24 * MiB;
constexpr size_t WS_SSP = 25 * MiB;
constexpr size_t WS_U8 = 32 * MiB, WS_V8 = 64 * MiB;
constexpr size_t WS_HB = 96 * MiB;
constexpr size_t WS_QB = 128 * MiB, WS_KB = 160 * MiB, WS_VB = 192 * MiB;
constexpr size_t WS_AO = 224 * MiB;
constexpr size_t WS_QP = 256 * MiB;
constexpr size_t WS_EID = 320 * MiB, WS_GATE = 328 * MiB;
constexpr size_t WS_HP = 336 * MiB;
constexpr size_t WS_COEF = 400 * MiB;
constexpr size_t WS_END = 408 * MiB;
namespace pg8 {
#define PG8_LAS __attribute__((address_space(3)))
typedef unsigned short bf16_t;
typedef short bf16x8 __attribute__((ext_vector_type(8)));
typedef float f32x4 __attribute__((ext_vector_type(4)));
typedef unsigned u32x4 __attribute__((ext_vector_type(4)));
constexpr int BM = 256, BK = 64, HALF = 128, HTB = HALF * BK * 2  , STAGE_BYTES = 8 * HTB, NXCD = 8, WGM = 8;

__host__ __device__ __forceinline__ int lds_byte(int r, int c) { const int st = (r >> 4) * 2 + (c >> 5), rr = r & 15, cc = c & 31, ob = rr * 64 + cc * 2; return st * 1024 + (ob ^ (((ob >> 9) & 1) << 5)); }
__host__ __device__ __forceinline__ void stage_rc(int b, int& R, int& C) { const int st = b / 1024, sb = b % 1024, swz = sb ^ (((sb >> 9) & 1) << 5); R = (st >> 1) * 16 + swz / 64; C = (st & 1) * 32 + (swz % 64) / 2; }
__host__ __device__ __forceinline__ int perm32(int rho) { const int n = rho >> 4, i = rho & 15; return 8 * (i >> 2) + 4 * n + (i & 3); }

struct Unit { int pm, pn; };
struct Gemm { const bf16_t* A; const bf16_t* Bt; int M, N, K; };

struct StaticOrder {
    int nM, nN, nwg, G, c;
    __host__ __device__ __forceinline__ void init(int M, int N, int G_, int c_) { nM = M / BM; nN = N / BM; nwg = nM * nN; G = G_; c = c_; }
    __host__ __device__ __forceinline__ bool next(int i, Unit& u) const {
        const long L = (long)i * G + c; if (L >= nwg) return false;
        int wgid = (int)L; { const int q = nwg / NXCD, r = nwg % NXCD, xcd = wgid % NXCD, off = wgid / NXCD; wgid = (xcd < r ? xcd * (q + 1) : r * (q + 1) + (xcd - r) * q) + off; }
        const int nig = WGM * nN, gid = wgid / nig, fm = gid * WGM, gsz = (nM - fm) < WGM ? (nM - fm) : WGM;
        u.pm = fm + ((wgid % nig) % gsz); u.pn = (wgid % nig) / gsz; return true;
    }
    __device__ __forceinline__ void a_ready(const Unit&) const {}
    __device__ __forceinline__ void done(const Unit&) const {}
};


__device__ __forceinline__ unsigned cvt_pk_bf16(float lo, float hi) { unsigned r; asm volatile("v_cvt_pk_bf16_f32 %0, %1, %2" : "=v"(r) : "v"(lo), "v"(hi)); return r; }

struct EpiScaleBf16 {
    static constexpr bool PERM = true, AFTER_DRAIN = false;
    bf16_t* O; int ldc; int split_cols; size_t split_stride; float scale0; const PG8_LAS float* rs;
    __device__ __forceinline__ void operator()(const f32x4 (&acc)[2][2][4][2], const Unit& u, int ui, int wr, int wc, int fr, int fq) const {
        const int row0 = u.pm * BM + wr * 64 + fr; int colt = u.pn * BM; bf16_t* base = O;
        float sc = 1.f; if (split_cols) { const int t = colt / split_cols; base += (size_t)t * split_stride; colt -= t * split_cols; if (t == 0) sc = scale0; }
        const int col0 = colt + wc * 32 + 8 * fq;
        const PG8_LAS float* rsu = rs + (ui & 7) * 256 + wr * 64 + fr;
#pragma unroll
        for (int ai = 0; ai < 2; ++ai)
#pragma unroll
            for (int m = 0; m < 4; ++m) { bf16_t* rowp = base + (size_t)(row0 + ai * HALF + m * 16) * ldc + col0; const float s = rsu[ai * HALF + m * 16] * sc;
#pragma unroll
                for (int bj = 0; bj < 2; ++bj) { const f32x4 v0 = acc[ai][bj][m][0] * s, v1 = acc[ai][bj][m][1] * s;
                    u32x4 w; w.x = cvt_pk_bf16(v0[0], v0[1]); w.y = cvt_pk_bf16(v0[2], v0[3]); w.z = cvt_pk_bf16(v1[0], v1[1]); w.w = cvt_pk_bf16(v1[2], v1[3]);
                    *(u32x4*)(rowp + bj * HALF) = w; } }
    }
};
__device__ __forceinline__ float bf_lo(unsigned w) { return __builtin_bit_cast(float, w << 16); }
__device__ __forceinline__ float bf_hi(unsigned w) { return __builtin_bit_cast(float, w & 0xffff0000u); }
struct EpiResid {
    static constexpr bool PERM = true, AFTER_DRAIN = false;
    const bf16_t* hb_in; bf16_t* hb; float* ssp; int nrows;
    __device__ __forceinline__ void operator()(const f32x4 (&acc)[2][2][4][2], const Unit& u, int ui, int wr, int wc, int fr, int fq) const {
        const int col0 = u.pn * BM + wc * 32 + 8 * fq;
        u32x4 rw[2][4][2];
#pragma unroll
        for (int ai = 0; ai < 2; ++ai)
#pragma unroll
            for (int m = 0; m < 4; ++m) { const int row = u.pm * BM + ai * HALF + wr * 64 + m * 16 + fr; const size_t off = (size_t)row * 1024 + col0;
#pragma unroll
                for (int bj = 0; bj < 2; ++bj) rw[ai][m][bj] = *(const u32x4*)(hb_in + off + bj * HALF); }
        asm volatile("" ::: "memory");
#pragma unroll
        for (int ai = 0; ai < 2; ++ai)
#pragma unroll
            for (int m = 0; m < 4; ++m) { const int row = u.pm * BM + ai * HALF + wr * 64 + m * 16 + fr; const size_t off = (size_t)row * 1024 + col0; float ss = 0.f;
#pragma unroll
                for (int bj = 0; bj < 2; ++bj) { const u32x4 rr = rw[ai][m][bj];
                    const f32x4 r0 = {bf_lo(rr.x), bf_hi(rr.x), bf_lo(rr.y), bf_hi(rr.y)}, r1 = {bf_lo(rr.z), bf_hi(rr.z), bf_lo(rr.w), bf_hi(rr.w)};
                    const f32x4 v0 = acc[ai][bj][m][0] + r0, v1 = acc[ai][bj][m][1] + r1;
                    ss += (v0[0] * v0[0] + v0[1] * v0[1]) + (v0[2] * v0[2] + v0[3] * v0[3]) + (v1[0] * v1[0] + v1[1] * v1[1]) + (v1[2] * v1[2] + v1[3] * v1[3]);
                    u32x4 w; w.x = cvt_pk_bf16(v0[0], v0[1]); w.y = cvt_pk_bf16(v0[2], v0[3]); w.z = cvt_pk_bf16(v1[0], v1[1]); w.w = cvt_pk_bf16(v1[2], v1[3]);
                    *(u32x4*)(hb + off + bj * HALF) = w; }
                ss += __shfl_xor(ss, 16); ss += __shfl_xor(ss, 32);
                if (fq == 0) ssp[(size_t)(u.pn * 4 + wc) * nrows + row] = ss; }
        asm volatile("" ::: "memory");
    }
};
template <class Epi, class Sched, bool ALIGN_EPI = false, bool SP2 = false>
__device__ __forceinline__ void gemm_phase(PG8_LAS unsigned char* lds, const Gemm g, const Sched& S, const Epi& E) {
    const int tid = threadIdx.x, wid = __builtin_amdgcn_readfirstlane(tid >> 6), lane = tid & 63, wr = wid >> 2, wc = wid & 3, fr = lane & 15, fq = lane >> 4;
    const int K = g.K, nt = K / BK;
    unsigned voffA[2], voffB[2];
#pragma unroll
    for (int i = 0; i < 2; ++i) { int R, C; stage_rc(tid * 16 + i * 8192, R, C); const int Rb = Epi::PERM ? ((R & ~31) + perm32(R & 31)) : R;
        voffA[i] = (unsigned)(R * K + C) * 2u; voffB[i] = (unsigned)(Rb * K + C) * 2u; }
    const size_t kstep = (size_t)(BK * 2);
    const size_t hstep = (size_t)HALF * K * 2;
    const size_t tstep = 2 * hstep;
    const unsigned ldsw = (unsigned)wid * 1024u;
    const int aoff = lds_byte(wr * 64 + fr, fq * 8), boff = lds_byte(wc * 32 + fr, fq * 8);
#define PG8_SA(b, h) (((b) * 2 + (h)) * HTB)
#define PG8_SB(b, h) ((4 + (b) * 2 + (h)) * HTB)
#define PG8_STAGE(bufoff, gbase, voff) do { _Pragma("unroll") for (int _i = 0; _i < 2; ++_i) \
        __builtin_amdgcn_global_load_lds((const unsigned*)((const char*)(gbase) + (voff)[_i]), (PG8_LAS unsigned*)(lds + (bufoff) + ldsw + _i * 8192), 16, 0, 0); } while (0)
#define PG8_LDA(dst, b, h) do { _Pragma("unroll") for (int m = 0; m < 4; ++m) _Pragma("unroll") for (int k = 0; k < 2; ++k) dst[m][k] = *(const PG8_LAS bf16x8*)(lds + PG8_SA(b, h) + aoff + m * 2048 + k * 1024); } while (0)
#define PG8_LDB(dst, b, h) do { _Pragma("unroll") for (int n = 0; n < 2; ++n) _Pragma("unroll") for (int k = 0; k < 2; ++k) dst[n][k] = *(const PG8_LAS bf16x8*)(lds + PG8_SB(b, h) + boff + n * 2048 + k * 1024); } while (0)
#define PG8_MMA(ai, bj, At, Bt) do { __builtin_amdgcn_s_setprio(1); _Pragma("unroll") for (int m = 0; m < 4; ++m) _Pragma("unroll") for (int n = 0; n < 2; ++n) _Pragma("unroll") for (int k = 0; k < 2; ++k) \
        acc[ai][bj][m][n] = __builtin_amdgcn_mfma_f32_16x16x32_bf16(Bt[n][k], At[m][k], acc[ai][bj][m][n], 0, 0, 0); __builtin_amdgcn_s_setprio(0); } while (0)
#define PG8_WAIT_V(n) asm volatile("s_waitcnt vmcnt(" #n ")" ::: "memory")
#define PG8_WAIT_L(n) asm volatile("s_waitcnt lgkmcnt(" #n ")" ::: "memory")
#define PG8_BAR __builtin_amdgcn_s_barrier()
#define PG8_SCHED __builtin_amdgcn_sched_barrier(0)
    Unit cur, nxt; int ui = 0;
    if (!S.next(0, cur)) return;
    f32x4 acc[2][2][4][2];
#pragma unroll
    for (int a = 0; a < 2; ++a)
#pragma unroll
        for (int b = 0; b < 2; ++b)
#pragma unroll
            for (int m = 0; m < 4; ++m)
#pragma unroll
                for (int n = 0; n < 2; ++n) acc[a][b][m][n] = (f32x4){0.f, 0.f, 0.f, 0.f};
    bf16x8 At[4][2], B0[2][2], B1[2][2];
    const char* cA = (const char*)g.A + (size_t)cur.pm * tstep; const char* cB = (const char*)g.Bt + (size_t)cur.pn * tstep;
    S.a_ready(cur);
    if constexpr (SP2) {
        PG8_STAGE(PG8_SB(0, 0), cB, voffB); PG8_STAGE(PG8_SB(0, 1), cB + hstep, voffB); PG8_STAGE(PG8_SA(0, 0), cA, voffA); PG8_STAGE(PG8_SA(0, 1), cA + hstep, voffA);
        if (wr == 1) PG8_BAR;
        PG8_WAIT_V(2); PG8_BAR;
        PG8_STAGE(PG8_SB(1, 0), cB + kstep, voffB); PG8_STAGE(PG8_SA(1, 0), cA + kstep, voffA); PG8_STAGE(PG8_SB(1, 1), cB + hstep + kstep, voffB);
        PG8_WAIT_V(6); PG8_BAR;
    } else {
        PG8_STAGE(PG8_SB(0, 0), cB, voffB); PG8_STAGE(PG8_SA(0, 0), cA, voffA); PG8_STAGE(PG8_SB(0, 1), cB + hstep, voffB); PG8_STAGE(PG8_SA(0, 1), cA + hstep, voffA);
        if (wr == 1) PG8_BAR;
        PG8_WAIT_V(4); PG8_BAR;
        PG8_STAGE(PG8_SB(1, 0), cB + kstep, voffB); PG8_STAGE(PG8_SA(1, 0), cA + kstep, voffA); PG8_STAGE(PG8_SB(1, 1), cB + hstep + kstep, voffB);
        PG8_WAIT_V(6); PG8_BAR;
    }
    for (;;) {
        const bool has_next = S.next(ui + 1, nxt);
        const char* nA = has_next ? (const char*)g.A + (size_t)nxt.pm * tstep : cA; const char* nB = has_next ? (const char*)g.Bt + (size_t)nxt.pn * tstep : cB;
        for (int t = 0; t < nt; t += 2) {
            const bool last = (t == nt - 2);
            const char* a1 = cA + (size_t)(t + 1) * kstep;
            const char* a2 = last ? nA : cA + (size_t)(t + 2) * kstep; const char* b2 = last ? nB : cB + (size_t)(t + 2) * kstep;
            const char* a3 = a2 + kstep; const char* b3 = b2 + kstep;
            if (last && has_next) S.a_ready(nxt);
            if constexpr (SP2) {
            PG8_LDB(B0, 0, 0); PG8_LDB(B1, 0, 1); PG8_SCHED; PG8_LDA(At, 0, 0); PG8_STAGE(PG8_SA(1, 1), a1 + hstep, voffA);
            PG8_WAIT_V(8); PG8_WAIT_L(0); PG8_BAR; PG8_MMA(0, 0, At, B0); PG8_MMA(0, 1, At, B1); PG8_BAR; PG8_SCHED;
            PG8_LDA(At, 0, 1); PG8_STAGE(PG8_SB(0, 0), b2, voffB); PG8_STAGE(PG8_SB(0, 1), b2 + hstep, voffB); PG8_STAGE(PG8_SA(0, 0), a2, voffA);
            PG8_WAIT_V(8); PG8_WAIT_L(0); PG8_BAR; PG8_MMA(1, 0, At, B0); PG8_MMA(1, 1, At, B1); PG8_BAR; PG8_SCHED;
            PG8_LDB(B0, 1, 0); PG8_LDB(B1, 1, 1); PG8_SCHED; PG8_LDA(At, 1, 0); PG8_STAGE(PG8_SA(0, 1), a2 + hstep, voffA);
            PG8_WAIT_V(8); PG8_WAIT_L(0); PG8_BAR; PG8_MMA(0, 0, At, B0); PG8_MMA(0, 1, At, B1); PG8_BAR; PG8_SCHED;
            PG8_LDA(At, 1, 1); PG8_STAGE(PG8_SB(1, 0), b3, voffB); PG8_STAGE(PG8_SB(1, 1), b3 + hstep, voffB); PG8_STAGE(PG8_SA(1, 0), a3, voffA);
            PG8_WAIT_V(8); PG8_WAIT_L(0); PG8_BAR; PG8_MMA(1, 0, At, B0); PG8_MMA(1, 1, At, B1); PG8_BAR; PG8_SCHED;
            } else {
            PG8_LDB(B0, 0, 0); PG8_SCHED; PG8_LDA(At, 0, 0); PG8_STAGE(PG8_SA(1, 1), a1 + hstep, voffA);
            PG8_WAIT_L(8); PG8_BAR; PG8_WAIT_L(0); PG8_MMA(0, 0, At, B0); PG8_BAR; PG8_SCHED;
            PG8_LDB(B1, 0, 1); PG8_STAGE(PG8_SB(0, 0), b2, voffB);
            PG8_BAR; PG8_WAIT_L(0); PG8_MMA(0, 1, At, B1); PG8_BAR;
            PG8_LDA(At, 0, 1); PG8_STAGE(PG8_SA(0, 0), a2, voffA);
            PG8_BAR; PG8_WAIT_L(0); PG8_MMA(1, 0, At, B0); PG8_BAR; PG8_SCHED;
            PG8_STAGE(PG8_SB(0, 1), b2 + hstep, voffB);
            PG8_WAIT_V(6); PG8_BAR; PG8_MMA(1, 1, At, B1); PG8_BAR;
            PG8_LDB(B0, 1, 0); PG8_SCHED; PG8_LDA(At, 1, 0); PG8_STAGE(PG8_SA(0, 1), a2 + hstep, voffA);
            PG8_WAIT_L(8); PG8_BAR; PG8_WAIT_L(0); PG8_MMA(0, 0, At, B0); PG8_BAR; PG8_SCHED;
            PG8_LDB(B1, 1, 1); PG8_STAGE(PG8_SB(1, 0), b3, voffB);
            PG8_BAR; PG8_WAIT_L(0); PG8_MMA(0, 1, At, B1); PG8_BAR;
            PG8_LDA(At, 1, 1); PG8_STAGE(PG8_SA(1, 0), a3, voffA);
            PG8_BAR; PG8_WAIT_L(0); PG8_MMA(1, 0, At, B0); PG8_BAR; PG8_SCHED;
            PG8_STAGE(PG8_SB(1, 1), b3 + hstep, voffB);
            PG8_WAIT_V(6); PG8_BAR; PG8_MMA(1, 1, At, B1); PG8_BAR;
            }
        }
        if constexpr (ALIGN_EPI) { if (wr == 0) PG8_BAR; }
        if constexpr (!Epi::AFTER_DRAIN) { E(acc, cur, ui, wr, wc, fr, fq); S.done(cur); }
        if (!has_next) break;
#pragma unroll
        for (int a = 0; a < 2; ++a)
#pragma unroll
            for (int b = 0; b < 2; ++b)
#pragma unroll
                for (int m = 0; m < 4; ++m)
#pragma unroll
                    for (int n = 0; n < 2; ++n) acc[a][b][m][n] = (f32x4){0.f, 0.f, 0.f, 0.f};
        cur = nxt; cA = nA; cB = nB; ++ui;
        if constexpr (ALIGN_EPI) { if (wr == 1) PG8_BAR; }
    }
    PG8_WAIT_V(0);
    if constexpr (!ALIGN_EPI) { if (wr == 0) PG8_BAR; }
    PG8_BAR;
    if constexpr (Epi::AFTER_DRAIN) { E.fused(acc, cur, wr, wc, fr, fq, lds, wid, lane); S.done(cur); }
#undef PG8_SA
#undef PG8_SB
#undef PG8_STAGE
#undef PG8_LDA
#undef PG8_LDB
#undef PG8_MMA
#undef PG8_WAIT_V
#undef PG8_WAIT_L
#undef PG8_BAR
#undef PG8_SCHED
}
}

#define GAS __attribute__((address_space(1)))
#define LAS __attribute__((address_space(3)))
typedef unsigned short bf16;
typedef unsigned v4u __attribute__((ext_vector_type(4)));
typedef unsigned u32x2p __attribute__((ext_vector_type(2)));
typedef float f32x4 __attribute__((ext_vector_type(4)));
typedef float f32x2 __attribute__((ext_vector_type(2)));
typedef float f32x16 __attribute__((ext_vector_type(16)));
typedef short bf16x8 __attribute__((ext_vector_type(8)));
typedef GAS unsigned gu32;
#define RLX_AGENT __ATOMIC_RELAXED, __HIP_MEMORY_SCOPE_AGENT
#define LDS_WAIT() asm volatile("s_waitcnt lgkmcnt(0)" ::: "memory")
#define VM_WAIT() asm volatile("s_waitcnt vmcnt(0)" ::: "memory")
__device__ __forceinline__ unsigned f2bf(float f) { unsigned u = __builtin_bit_cast(unsigned, f); return (u + 0x7fffu + ((u >> 16) & 1u)) >> 16; }
__device__ __forceinline__ unsigned pk2(float lo, float hi) { return f2bf(lo) | (f2bf(hi) << 16); }
__device__ __forceinline__ float bf2f(unsigned short b) { return __builtin_bit_cast(float, (unsigned)b << 16); }
__device__ __forceinline__ float bflo(unsigned w) { return __builtin_bit_cast(float, w << 16); }
__device__ __forceinline__ float bfhi(unsigned w) { return __builtin_bit_cast(float, w & 0xffff0000u); }
__device__ __forceinline__ float wave_sum(float v) {
#pragma unroll
    for (int o = 1; o < 64; o <<= 1) v += __shfl_xor(v, o);
    return v;
}
__device__ __forceinline__ float wave_max(float v) {
#pragma unroll
    for (int o = 1; o < 64; o <<= 1) v = fmaxf(v, __shfl_xor(v, o));
    return v;
}

#define XB_TMO      128
#define XB_XCNT(j)  (256  + 64 * (j))
#define XB_XSUB(j)  (1280 + 64 * (j))
#define XB_XGEN(j)  (2304 + 64 * (j))
#define XB_TOP      3328
#define XB_TOPGEN   3392
#define XCD_BAR_WORDS 3456
#define XB_SPIN_CAP (1u << 18)

__device__ __forceinline__ unsigned xb_ld(unsigned* p)              { return __hip_atomic_load(p, __ATOMIC_RELAXED, __HIP_MEMORY_SCOPE_AGENT); }
__device__ __forceinline__ unsigned xb_add(unsigned* p, unsigned v) { return __hip_atomic_fetch_add(p, v, __ATOMIC_RELAXED, __HIP_MEMORY_SCOPE_AGENT); }
__device__ __forceinline__ unsigned xb_xcc_id() { return (unsigned)__builtin_amdgcn_s_getreg((3 << 11) | 20) & 0xFu; }
#define XB_SPIN(cond, bar) do { unsigned _sp = 0; while (cond) { __builtin_amdgcn_s_sleep(1); \
    if ((++_sp & 255u) == 0u) { if (xb_ld(&(bar)[XB_TMO])) break; if (_sp > XB_SPIN_CAP) { atomicAdd(&(bar)[XB_TMO], 1u); break; } } } } while (0)

struct XcdBarrier {
    unsigned* bar; unsigned x;
    volatile LAS unsigned* st;
};

__device__ __forceinline__ XcdBarrier xcd_barrier_post(unsigned* bar, volatile LAS unsigned* st) {
    XcdBarrier b; b.bar = bar; b.x = xb_xcc_id(); b.st = st;
    if (threadIdx.x == 0) (void)xb_add(&bar[XB_XCNT(b.x)], 1u);
    return b;
}
__device__ __forceinline__ void xcd_barrier_complete(unsigned* bar, unsigned x, unsigned& nloc, unsigned& nx) {
    const unsigned G = gridDim.x * gridDim.y * gridDim.z;
    unsigned sum, cnt, mine, sp = 0u;
    for (;;) {
        sum = 0u; cnt = 0u; mine = 0u;
#pragma unroll
        for (unsigned j = 0; j < 16; ++j) { const unsigned c = xb_ld(&bar[XB_XCNT(j)]); sum += c; cnt += (c > 0u) ? 1u : 0u; mine = (j == x) ? c : mine; }
        if (sum == G) break;
        __builtin_amdgcn_s_sleep(1);
        if ((++sp & 255u) == 0u) { if (xb_ld(&bar[XB_TMO])) break; if (sp > XB_SPIN_CAP) { atomicAdd(&bar[XB_TMO], 1u); break; } }
    }
    nloc = mine > 0u ? mine : 1u; nx = cnt > 0u ? cnt : 1u;
}

__device__ __forceinline__ void xcd_barrier(const XcdBarrier& b) {
    asm volatile("s_waitcnt vmcnt(0)" ::: "memory");
    __syncthreads();
    if (threadIdx.x == 0) {
        unsigned* bar = b.bar;
        __builtin_amdgcn_s_waitcnt(0);
        unsigned nloc = b.st[0], nx = b.st[1];
        if (nloc == 0u) { xcd_barrier_complete(bar, b.x, nloc, nx); b.st[0] = nloc; b.st[1] = nx; }
        const unsigned old = xb_add(&bar[XB_XSUB(b.x)], 1u);
        const unsigned gen = old / nloc;
        if (old + 1u == (gen + 1u) * nloc) {
            __builtin_amdgcn_fence(__ATOMIC_RELEASE, "agent");
            asm volatile("s_waitcnt vmcnt(0)" ::: "memory");
            const unsigned og = xb_add(&bar[XB_TOP], 1u);
            const unsigned tg = og / nx;
            if (og + 1u == (tg + 1u) * nx) xb_add(&bar[XB_TOPGEN], 1u);
            else XB_SPIN(xb_ld(&bar[XB_TOPGEN]) == tg, bar);
            __builtin_amdgcn_fence(__ATOMIC_ACQUIRE, "agent");
            asm volatile("s_waitcnt vmcnt(0)" ::: "memory");
        } else {
            XB_SPIN(xb_ld(&bar[XB_TOPGEN]) == gen, bar);
            __builtin_amdgcn_fence(__ATOMIC_ACQUIRE, "agent");
            asm volatile("s_waitcnt vmcnt(0)" ::: "memory");
        }
    }
    __syncthreads();
}

constexpr int NWAVES = 8;
constexpr int RING_BYTES = 131072;
constexpr int RS_OFF = RING_BYTES;
constexpr int MISC_OFF = RS_OFF + 8192;
constexpr int LDS_BYTES = 147456;
constexpr int CW_BAR = 4096;

struct Args { const float* in[15]; float* out; unsigned char* ws; unsigned mask; int li; unsigned rep; int pad; };

#define DPP_ADD(s, CTRL) do { (s) += __builtin_bit_cast(float, __builtin_amdgcn_update_dpp(0, __builtin_bit_cast(int, (s)), (CTRL), 0xF, 0xF, true)); } while (0)
#define DPP_MAX(s, CTRL) do { (s) = fmaxf((s), __builtin_bit_cast(float, __builtin_amdgcn_update_dpp(0, __builtin_bit_cast(int, (s)), (CTRL), 0xF, 0xF, true))); } while (0)
#define DPP_XOR1 0xB1
#define DPP_XOR2 0x4E
#define DPP_HALF_MIRROR 0x141
#define DPP_ROW_MIRROR 0x140
#define DPP_ROW_ROR8 0x128
__device__ __forceinline__ float wave_max_dpp(float v) {
    DPP_MAX(v, DPP_XOR1); DPP_MAX(v, DPP_XOR2); DPP_MAX(v, DPP_HALF_MIRROR); DPP_MAX(v, DPP_ROW_MIRROR);
    { const auto rr = __builtin_amdgcn_permlane16_swap(__float_as_uint(v), __float_as_uint(v), false, false); v = fmaxf(__uint_as_float(rr[0]), __uint_as_float(rr[1])); }
    { const auto rr = __builtin_amdgcn_permlane32_swap(__float_as_uint(v), __float_as_uint(v), false, false); v = fmaxf(__uint_as_float(rr[0]), __uint_as_float(rr[1])); }
    return v;
}
__device__ __forceinline__ void p0_transpose_item(const float* W, const float* gain, int K, int N, bf16* WT, LAS float* scr, int item, int lane) {
    const int nblk = N / 32, kb = item / nblk, nb = item % nblk, k0 = 64 * kb, n0 = 32 * nb;
    const int kr = lane >> 3, n4 = 4 * (lane & 7);
    f32x4 w4[8]; float gk[8];
#pragma unroll
    for (int i = 0; i < 8; ++i) { w4[i] = *(const f32x4*)(W + (size_t)(k0 + 8 * i + kr) * N + n0 + n4); gk[i] = gain ? gain[k0 + 8 * i + kr] : 1.f; }
#pragma unroll
    for (int i = 0; i < 8; ++i) { LAS float* d = scr + (8 * i + kr) * 33 + n4; d[0] = w4[i][0] * gk[i]; d[1] = w4[i][1] * gk[i]; d[2] = w4[i][2] * gk[i]; d[3] = w4[i][3] * gk[i]; }
    LDS_WAIT(); asm volatile("" ::: "memory");
    const int c = lane & 7;
#pragma unroll
    for (int j = 0; j < 4; ++j) { const int n = (lane >> 3) + 8 * j; const LAS float* s = scr + (8 * c) * 33 + n;
        v4u o; o.x = pk2(s[0 * 33], s[1 * 33]); o.y = pk2(s[2 * 33], s[3 * 33]); o.z = pk2(s[4 * 33], s[5 * 33]); o.w = pk2(s[6 * 33], s[7 * 33]);
        *(v4u*)(WT + (size_t)(n0 + n) * K + k0 + 8 * c) = o; }
    LDS_WAIT(); asm volatile("" ::: "memory");
}
template <int NR> __device__ __forceinline__ void conv_rows_load(f32x4 (&v)[NR][4], const float* src, int lane) {
#pragma unroll
    for (int i = 0; i < NR; ++i)
#pragma unroll
        for (int j = 0; j < 4; ++j) v[i][j] = *(const f32x4*)(src + (size_t)i * 1024 + lane * 16 + 4 * j);
}
template <int NR> __device__ __forceinline__ void conv_rows_finish_fp4(f32x4 (&v)[NR][4], const float* gain, unsigned char* dst, float* inv_scale, int lane) {
    float am[NR];
#pragma unroll
    for (int i = 0; i < NR; ++i) { am[i] = 0.f;
#pragma unroll
        for (int j = 0; j < 4; ++j) { if (gain) v[i][j] = v[i][j] * *(const f32x4*)(gain + lane * 16 + 4 * j); am[i] = fmaxf(am[i], fmaxf(fmaxf(fabsf(v[i][j][0]), fabsf(v[i][j][1])), fmaxf(fabsf(v[i][j][2]), fabsf(v[i][j][3])))); } }
#pragma unroll
    for (int i = 0; i < NR; ++i) am[i] = wave_max_dpp(am[i]);
#pragma unroll
    for (int i = 0; i < NR; ++i) {
        const float sc = am[i] > 0.f ? 6.f / am[i] : 1.f;
        unsigned w[2];
#pragma unroll
        for (int d = 0; d < 2; ++d) { unsigned q = 0u;
            q = __builtin_amdgcn_cvt_scalef32_pk_fp4_f32(q, v[i][2 * d][0] * sc, v[i][2 * d][1] * sc, 1.0f, 0); q = __builtin_amdgcn_cvt_scalef32_pk_fp4_f32(q, v[i][2 * d][2] * sc, v[i][2 * d][3] * sc, 1.0f, 1);
            q = __builtin_amdgcn_cvt_scalef32_pk_fp4_f32(q, v[i][2 * d + 1][0] * sc, v[i][2 * d + 1][1] * sc, 1.0f, 2); q = __builtin_amdgcn_cvt_scalef32_pk_fp4_f32(q, v[i][2 * d + 1][2] * sc, v[i][2 * d + 1][3] * sc, 1.0f, 3);
            w[d] = q; }
        *(u32x2p*)(dst + (size_t)(lane >> 4) * (16384 * 128) + (size_t)i * 128 + (lane & 15) * 8) = (u32x2p){w[0], w[1]};
        if (lane == 0) inv_scale[2 * i] = am[i] > 0.f ? am[i] * (1.f / 6.f) : 1.f;
    }
}
template <int NR> __device__ __forceinline__ void conv_rows_finish_i4(f32x4 (&v)[NR][4], const float* gain, unsigned char* dst, float* inv_scale, int lane) {
    float am[NR];
#pragma unroll
    for (int i = 0; i < NR; ++i) { am[i] = 0.f;
#pragma unroll
        for (int j = 0; j < 4; ++j) { v[i][j] = v[i][j] * *(const f32x4*)(gain + lane * 16 + 4 * j);
            am[i] = fmaxf(am[i], fmaxf(fmaxf(fabsf(v[i][j][0]), fabsf(v[i][j][1])), fmaxf(fabsf(v[i][j][2]), fabsf(v[i][j][3])))); } }
#pragma unroll
    for (int i = 0; i < NR; ++i) am[i] = wave_max_dpp(am[i]);
#pragma unroll
    for (int i = 0; i < NR; ++i) {
        const float sc = am[i] > 0.f ? 7.f / am[i] : 1.f;
        unsigned w[2];
#pragma unroll
        for (int d = 0; d < 2; ++d) { unsigned q = 0u;
#pragma unroll
            for (int e = 0; e < 8; ++e) { const unsigned u = __float_as_uint(__builtin_fmaf(v[i][2 * d + (e >> 2)][e & 3], sc, 12582912.f)); q |= (u & 15u) << (4 * e); }
            w[d] = q; }
        *(u32x2p*)(dst + (size_t)(lane >> 4) * (16384 * 128) + (size_t)i * 128 + (lane & 15) * 8) = (u32x2p){w[0], w[1]};
        if (lane == 0) inv_scale[2 * i] = am[i] > 0.f ? am[i] * (1.f / 7.f) : 1.f;
    }
}
__device__ __forceinline__ void transpose_weights(const Args& a, int layer, int mask, LAS float* scr, int worker, int nworkers, int lane) {
    unsigned char* ws = a.ws;
    const int nq = layer ? 1536 : 3072;
    const int J0 = (mask & 1) ? 16 * (nq / 32) : 0, J1 = (mask & 2) ? 16 * (1024 / 32) : 0, J2 = (mask & 4) ? 16 * (2048 / 32) : 0;
    for (int it = worker; it < J0 + J1 + J2; it += nworkers) {
        int r = it;
        if (r < J0) { if (layer) p0_transpose_item(a.in[5], a.in[4], 1024, 1536, (bf16*)(ws + WS_WQKV1), scr, r, lane); else p0_transpose_item(a.in[2], a.in[1], 1024, 3072, (bf16*)(ws + WS_WQKV0), scr, r, lane); continue; } r -= J0;
        if (r < J1) { p0_transpose_item(layer ? a.in[9] : a.in[3], nullptr, 1024, 1024, (bf16*)(ws + (layer ? WS_WO1 : WS_WO0)), scr, r, lane); continue; } r -= J1;
        p0_transpose_item(a.in[11] + (size_t)layer * 1024 * 2048, a.in[10] + layer * 1024, 1024, 2048, (bf16*)(ws + (layer ? WS_WPQ1 : WS_WPQ0)), scr, r, lane);
    }
}
__device__ __forceinline__ void convert_tables(const Args& a, int layer, int g0, int g1, int worker, int nworkers, int lane) {
    unsigned char* ws = a.ws;
#define TBL_SRC(g) (((g) >> 12 ? a.in[14] : a.in[13]) + ((size_t)layer * 16384 + (size_t)((g) & 4095) * 4) * 1024)
#define TBL_FIN(v, g) do { const int tb_ = (g) >> 12, e_ = ((g) & 4095) * 4, row_ = layer * 16384 + e_; \
        if (tb_) conv_rows_finish_fp4<4>(v, nullptr, ws + WS_V8 + (size_t)layer * (16384 * 512) + (size_t)e_ * 128, (float*)(ws + WS_ISU) + 2 * row_ + 1, lane); \
        else conv_rows_finish_i4<4>(v, a.in[10] + layer * 1024, ws + WS_U8 + (size_t)layer * (16384 * 512) + (size_t)e_ * 128, (float*)(ws + WS_ISU) + 2 * row_, lane); } while (0)
    f32x4 va[4][4], vb[4][4];
    int g = g0 + worker;
    if (g < g1) conv_rows_load<4>(va, TBL_SRC(g), lane);
    for (; g < g1; g += 2 * nworkers) {
        const int gb = g + nworkers, gc = g + 2 * nworkers;
        if (gb < g1) conv_rows_load<4>(vb, TBL_SRC(gb), lane);
        TBL_FIN(va, g);
        if (gc < g1) conv_rows_load<4>(va, TBL_SRC(gc), lane);
        if (gb < g1) TBL_FIN(vb, gb);
    }
#undef TBL_SRC
#undef TBL_FIN
}
__device__ __forceinline__ void phase_prep(const Args& a, LAS unsigned char* lds, int gw, int NGW, int wave, int lane) {
    LAS float* scr = (LAS float*)(lds + wave * 16384);
    unsigned char* ws = a.ws;
    { const int w0 = wave * (NGW / NWAVES) + (gw / NWAVES);
      transpose_weights(a, 0, 1, scr, w0, NGW, lane); }
    for (int it = gw; it < 1024; it += NGW) {
        const float* s = a.in[12] + (size_t)it * 512 + lane * 8; const f32x4 a0 = *(const f32x4*)s, a1 = *(const f32x4*)(s + 4);
        v4u o; o.x = pk2(a0[0], a0[1]); o.y = pk2(a0[2], a0[3]); o.z = pk2(a1[0], a1[1]); o.w = pk2(a1[2], a1[3]);
        *(v4u*)((bf16*)(ws + WS_SUBK) + (size_t)it * 512 + lane * 8) = o;
    }
    for (int t2 = gw; t2 < T / 2; t2 += NGW) {
        f32x4 v[2][4]; float ss[2];
#pragma unroll
        for (int i = 0; i < 2; ++i)
#pragma unroll
            for (int j = 0; j < 4; ++j) v[i][j] = *(const f32x4*)(a.in[0] + (size_t)(2 * t2 + i) * 1024 + lane * 16 + 4 * j);
#pragma unroll
        for (int i = 0; i < 2; ++i) { ss[i] = 0.f;
#pragma unroll
            for (int j = 0; j < 4; ++j) ss[i] += (v[i][j][0] * v[i][j][0] + v[i][j][1] * v[i][j][1]) + (v[i][j][2] * v[i][j][2] + v[i][j][3] * v[i][j][3]); }
#pragma unroll
        for (int o = 1; o < 64; o <<= 1) { ss[0] += __shfl_xor(ss[0], o); ss[1] += __shfl_xor(ss[1], o); }
#pragma unroll
        for (int i = 0; i < 2; ++i) {
            v4u o0, o1; o0.x = pk2(v[i][0][0], v[i][0][1]); o0.y = pk2(v[i][0][2], v[i][0][3]); o0.z = pk2(v[i][1][0], v[i][1][1]); o0.w = pk2(v[i][1][2], v[i][1][3]);
            o1.x = pk2(v[i][2][0], v[i][2][1]); o1.y = pk2(v[i][2][2], v[i][2][3]); o1.z = pk2(v[i][3][0], v[i][3][1]); o1.w = pk2(v[i][3][2], v[i][3][3]);
            bf16* hb = (bf16*)(ws + WS_HB) + (size_t)(2 * t2 + i) * 1024 + lane * 16;
            *(v4u*)hb = o0; *(v4u*)(hb + 8) = o1;
            if (lane == 0) ((float*)(ws + WS_SSP))[2 * t2 + i] = ss[i];
        }
    }
}
template <class Sched> __device__ __forceinline__ void fill_rs(LAS float* rs, const Sched& So, const float* ssp, int np, int tid) {
    pg8::Unit u;
    for (int ui = 0; ui < 8 && So.next(ui, u); ++ui) {
        if (tid < 256) { const int row = u.pm * 256 + tid; float s = 0.f; for (int p = 0; p < np; ++p) s += ssp[(size_t)p * T + row]; rs[ui * 256 + tid] = rsqrtf(s * (1.f / 1024.f) + 1e-6f); }
    }
    __syncthreads();
}

typedef short v4i16_t __attribute__((ext_vector_type(4)));
__device__ __forceinline__ int crow(int r, int hi) { return (r & 3) + 8 * (r >> 2) + 4 * hi; }
__device__ __forceinline__ unsigned cvtpk(float lo, float hi) { typedef __bf16 bf16x2_t __attribute__((ext_vector_type(2))); f32x2 v = {lo, hi}; bf16x2_t b = __builtin_convertvector(v, bf16x2_t); return __builtin_bit_cast(unsigned, b); }
__device__ __forceinline__ bf16x8 mk8(unsigned a, unsigned b, unsigned c, unsigned d) { v4u w = {a, b, c, d}; return __builtin_bit_cast(bf16x8, w); }
__device__ __forceinline__ bf16x8 vfrag(LAS const unsigned char* p) {
    const v4i16_t lo = __builtin_amdgcn_ds_read_tr16_b64_v4i16((LAS v4i16_t*)p), hi = __builtin_amdgcn_ds_read_tr16_b64_v4i16((LAS v4i16_t*)(p + 512));
    return (bf16x8){lo[0], lo[1], lo[2], lo[3], hi[0], hi[1], hi[2], hi[3]};
}
__device__ __forceinline__ void vtile_load(v4u (&vv)[8], const bf16* vp0, int pitch, int lane) {
    const bf16* vp = vp0 + (size_t)(lane >> 3) * pitch + (lane & 7) * 8;
#pragma unroll
    for (int i = 0; i < 8; ++i) vv[i] = *(const v4u*)(vp + (size_t)i * 8 * pitch);
}
__device__ __forceinline__ void vtile_store(const v4u (&vv)[8], LAS unsigned char* wl, int lane) {
    const int c = lane & 7;
#pragma unroll
    for (int i = 0; i < 8; ++i) { const int kv = 8 * i + (lane >> 3); *(LAS v4u*)(wl + (c >> 2) * 4096 + (kv >> 4) * 1024 + (kv & 15) * 64 + (c & 3) * 16) = vv[i]; }
}
__device__ __forceinline__ void otile_store(const f32x16& o0, const f32x16& o1, LAS unsigned char* stg, bf16* Orow0, int pitch, int lane) {
    const int r32 = lane & 31, hi = lane >> 5;
    LAS unsigned short* s16 = (LAS unsigned short*)stg;
#pragma unroll
    for (int r = 0; r < 16; ++r) { const int orow = crow(r, hi); s16[orow * 64 + r32] = (unsigned short)f2bf(o0[r]); s16[orow * 64 + 32 + r32] = (unsigned short)f2bf(o1[r]); }
#pragma unroll
    for (int i = 0; i < 4; ++i) { const int row = i * 8 + (lane >> 3), ch = lane & 7; const v4u v = *(LAS const v4u*)(stg + row * 128 + ch * 16); *(v4u*)(Orow0 + (size_t)row * pitch + ch * 8) = v; }
}
#define MFMA32(A, B, C) __builtin_amdgcn_mfma_f32_32x32x16_bf16((A), (B), (C), 0, 0, 0)
#define MFMA_SETTLE(a, b) asm volatile("s_nop 7\n\ts_nop 7\n\ts_nop 3" : "+v"(a), "+v"(b))
__device__ __forceinline__ float fma_s(float a, float b, float c) { float r; asm("v_fma_f32 %0, %1, %2, %3" : "=v"(r) : "v"(a), "v"(b), "v"(c)); return r; }
__device__ __forceinline__ float fadd_r(float a, float b) { float r; asm("v_add_f32_e32 %0, %1, %2" : "=v"(r) : "v"(a), "v"(b)); return r; }
__device__ __forceinline__ float minf_raw(float a, float b) { float mn; asm("v_min_f32_e32 %0, %1, %2" : "=v"(mn) : "v"(a), "v"(b)); return mn; }

__device__ __forceinline__ void sb_unit(const bf16* Q, const bf16* K, const bf16* V, bf16* O, int b, int h, int t0, LAS unsigned char* wl, int lane,
                                        const bf16x8 tri0, const bf16x8 tri1, const bf16x8 ones) {
    const int r32 = lane & 31, hi = lane >> 5;
    const size_t rowb = (size_t)b * S;
    const bf16* qp = Q + (rowb + t0 + r32) * 1024 + h * 64 + hi * 8;
    bf16x8 qf[4];
#pragma unroll
    for (int d0 = 0; d0 < 4; ++d0) qf[d0] = *(const bf16x8*)(qp + d0 * 16);
    f32x16 o0 = {}, o1 = {};
    float carry = 0.f;
    const int tdiag = t0 >> 6;
    LAS const unsigned char* vb = wl + ((lane >> 4) & 1) * 32 + (lane & 3) * 8 + (4 * hi + ((lane & 15) >> 2)) * 64;
    v4u kk[8], vv[8];
    LAS unsigned char* kimg = wl + 8192;
    LAS const unsigned char* kfp = kimg + r32 * 144 + hi * 16;
    vtile_load(kk, K + (rowb + tdiag * 64) * 1024 + h * 64, 1024, lane); vtile_load(vv, V + (rowb + tdiag * 64) * 1024 + h * 64, 1024, lane);
    for (int tile = tdiag; tile >= 0; --tile) {
        const int s0 = tile * 64, tn = tile > 0 ? tile - 1 : 0;
#pragma unroll
        for (int i = 0; i < 8; ++i) *(LAS v4u*)(kimg + (8 * i + (lane >> 3)) * 144 + (lane & 7) * 16) = kk[i];
        vtile_store(vv, wl, lane);
        vtile_load(kk, K + (rowb + tn * 64) * 1024 + h * 64, 1024, lane);
        vtile_load(vv, V + (rowb + tn * 64) * 1024 + h * 64, 1024, lane);
        f32x16 p0 = {}, p1 = {};
#pragma unroll
        for (int d0 = 0; d0 < 4; ++d0) { p0 = MFMA32(*(LAS const bf16x8*)(kfp + d0 * 32), qf[d0], p0); p1 = MFMA32(*(LAS const bf16x8*)(kfp + 32 * 144 + d0 * 32), qf[d0], p1); }
        const int lim = t0 + r32 - s0;
        unsigned lw[16]; float sumL = 0.f;
#pragma unroll
        for (int r = 0; r < 16; r += 2) {
            float La[2], Lb[2];
#pragma unroll
            for (int q = 0; q < 2; ++q) {
                { const float zc = minf_raw(crow(r + q, hi) < lim ? p0[r + q] : -INFINITY, 126.f); const float sp = __builtin_amdgcn_logf(1.f + __builtin_amdgcn_exp2f(zc)); La[q] = sp; p0[r + q] = zc - sp; }
                { const float zc = minf_raw(crow(r + q, hi) + 32 < lim ? p1[r + q] : -INFINITY, 126.f); const float sp = __builtin_amdgcn_logf(1.f + __builtin_amdgcn_exp2f(zc)); Lb[q] = sp; p1[r + q] = zc - sp; }
            }
            sumL += (La[0] + La[1]) + (Lb[0] + Lb[1]);
            lw[r >> 1] = cvtpk(La[0], La[1]); lw[8 + (r >> 1)] = cvtpk(Lb[0], Lb[1]);
        }
        f32x16 cinit;
#pragma unroll
        for (int r = 0; r < 16; ++r) cinit[r] = carry;
        const bf16x8 x00 = mk8(lw[0], lw[1], lw[2], lw[3]), x01 = mk8(lw[4], lw[5], lw[6], lw[7]), x10 = mk8(lw[8], lw[9], lw[10], lw[11]), x11 = mk8(lw[12], lw[13], lw[14], lw[15]);
        f32x16 y0 = MFMA32(tri0, x00, cinit); y0 = MFMA32(tri1, x01, y0); y0 = MFMA32(ones, x10, y0); y0 = MFMA32(ones, x11, y0);
        f32x16 y1 = MFMA32(tri0, x10, cinit); y1 = MFMA32(tri1, x11, y1);
        unsigned aw[16];
#pragma unroll
        for (int r = 0; r < 16; r += 2) {
            const float a0 = __builtin_amdgcn_exp2f(p0[r] - y0[r]), a1 = __builtin_amdgcn_exp2f(p0[r + 1] - y0[r + 1]);
            const float c0 = __builtin_amdgcn_exp2f(p1[r] - y1[r]), c1 = __builtin_amdgcn_exp2f(p1[r + 1] - y1[r + 1]);
            aw[r >> 1] = cvtpk(a0, a1); aw[8 + (r >> 1)] = cvtpk(c0, c1);
        }
#pragma unroll
        for (int ks = 0; ks < 4; ++ks) {
            const bf16x8 pa = mk8(aw[4 * ks], aw[4 * ks + 1], aw[4 * ks + 2], aw[4 * ks + 3]);
            o0 = MFMA32(pa, vfrag(vb + ks * 1024), o0);
            o1 = MFMA32(pa, vfrag(vb + 4096 + ks * 1024), o1);
        }
        { const auto rr = __builtin_amdgcn_permlane32_swap(__float_as_uint(sumL), __float_as_uint(sumL), false, false); carry += __uint_as_float(rr[0]) + __uint_as_float(rr[1]); }
        if (__all(carry > 64.f)) break;
    }
    otile_store(o0, o1, wl + 8192, O + (rowb + t0) * 1024 + h * 64, 1024, lane);
}
__device__ __forceinline__ void phase_sbatt(const bf16* Q, const bf16* K, const bf16* V, bf16* O, LAS unsigned char* lds, int vcu, int G, int wave, int nwv, int lane) {
    const int r32 = lane & 31, hi = lane >> 5;
    unsigned t0w[4], t1w[4];
#pragma unroll
    for (int j = 0; j < 8; ++j) {
        const int kv0 = 8 * (j >> 2) + 4 * hi + (j & 3);
        const unsigned b0 = (kv0 > r32) ? 0x3F80u : 0u, b1 = (kv0 + 16 > r32) ? 0x3F80u : 0u;
        if (j & 1) { t0w[j >> 1] |= b0 << 16; t1w[j >> 1] |= b1 << 16; } else { t0w[j >> 1] = b0; t1w[j >> 1] = b1; }
    }
    const bf16x8 tri0 = mk8(t0w[0], t0w[1], t0w[2], t0w[3]), tri1 = mk8(t1w[0], t1w[1], t1w[2], t1w[3]), ones = mk8(0x3F803F80u, 0x3F803F80u, 0x3F803F80u, 0x3F803F80u);
    LAS unsigned char* wl = lds + wave * 17408;
    const int nunits = NB * 16 * (S / 32);
    if (G % 8 == 0) {
        const int gx = G / 8, x = vcu / gx, vl = vcu % gx, nux = nunits / 8;
        for (int it = 0; ; ++it) {
            const int j = (it * gx + vl) * nwv + wave;
            if (j >= nux) break;
            sb_unit(Q, K, V, O, x >> 1, j >> 6, (64 * (x & 1) + (j & 63)) * 32, wl, lane, tri0, tri1, ones);
        }
    } else
    for (int it = 0; ; ++it) {
        const int u = (it * G + vcu) * nwv + wave;
        if (u >= nunits) break;
        const int bh = u >> 7, qb = u & 127;
        sb_unit(Q, K, V, O, bh >> 4, bh & 15, qb * 32, wl, lane, tri0, tri1, ones);
    }
}


constexpr int SW_KP = 144, SW_K_OFF = 0, SW_V_OFF = 384 * SW_KP, SW_RK_OFF = SW_V_OFF + 6 * 8192, SW_WV_OFF = SW_RK_OFF + 384 * 4;
static_assert(SW_WV_OFF + 8 * 4096 <= RS_OFF + 8192, "SW attention LDS image overruns the control words");
__device__ __forceinline__ void sw_stage(const bf16* QKV, size_t rowb, int kbase, int g, LAS unsigned char* lds, int tid) {
    v4u kk[6], vv[6];
#pragma unroll
    for (int n = 0; n < 6; ++n) { const int i = tid + 512 * n, row = i >> 3, ch = i & 7; const int key = kbase + row;
        if (key >= 0) { const bf16* src = QKV + (rowb + key) * 1536 + 1024 + g * 64 + ch * 8; kk[n] = *(const v4u*)src; vv[n] = *(const v4u*)(src + 256); } else { kk[n] = (v4u){0u, 0u, 0u, 0u}; vv[n] = kk[n]; } }
#pragma unroll
    for (int n = 0; n < 6; ++n) { const int i = tid + 512 * n, row = i >> 3, ch = i & 7;
        *(LAS v4u*)(lds + SW_K_OFF + row * SW_KP + ch * 16) = kk[n];
        const int tile = row >> 6, kv = row & 63;
        *(LAS v4u*)(lds + SW_V_OFF + tile * 8192 + (ch >> 2) * 4096 + (kv >> 4) * 1024 + (kv & 15) * 64 + (ch & 3) * 16) = vv[n];
        float ss = 0.f;
#pragma unroll
        for (int w = 0; w < 4; ++w) { const float a = bflo(kk[n][w]), c = bfhi(kk[n][w]); ss += a * a + c * c; }
        DPP_ADD(ss, DPP_XOR1); DPP_ADD(ss, DPP_XOR2); DPP_ADD(ss, DPP_HALF_MIRROR);
        if (ch == 0) ((LAS float*)(lds + SW_RK_OFF))[row] = rsqrtf(ss * (1.f / 64.f) + 1e-6f);
    }
}
__device__ __forceinline__ void sw_qload(v4u (&raw)[4], const bf16* QKV, size_t row, int h, int hi) {
    const bf16* qp = QKV + row * 1536 + h * 64 + hi * 8;
#pragma unroll
    for (int d0 = 0; d0 < 4; ++d0) raw[d0] = *(const v4u*)(qp + d0 * 16);
}
__device__ __forceinline__ void sw_unit(const v4u (&raw)[4], const float* qg, const float* kg, float sink2, float slope2, bf16* Orow0, int t0, int tbase, LAS unsigned char* lds, LAS unsigned char* wst, int lane) {
    const int r32 = lane & 31, hi = lane >> 5;
    LAS float* wsf = (LAS float*)wst;
    bf16x8 qf[4];
    {
        float ss = 0.f;
#pragma unroll
        for (int d0 = 0; d0 < 4; ++d0)
#pragma unroll
            for (int w = 0; w < 4; ++w) { const float a = bflo(raw[d0][w]), c = bfhi(raw[d0][w]); ss += a * a + c * c; }
        { const auto rr = __builtin_amdgcn_permlane32_swap(__float_as_uint(ss), __float_as_uint(ss), false, false); ss = __uint_as_float(rr[0]) + __uint_as_float(rr[1]); }
        const float rq = rsqrtf(ss * (1.f / 64.f) + 1e-6f) * C2;
#pragma unroll
        for (int d0 = 0; d0 < 4; ++d0) { const f32x4 g0 = *(const f32x4*)(qg + d0 * 16 + hi * 8) * *(const f32x4*)(kg + d0 * 16 + hi * 8), g1 = *(const f32x4*)(qg + d0 * 16 + hi * 8 + 4) * *(const f32x4*)(kg + d0 * 16 + hi * 8 + 4);
            qf[d0] = mk8(cvtpk(bflo(raw[d0][0]) * rq * g0[0], bfhi(raw[d0][0]) * rq * g0[1]), cvtpk(bflo(raw[d0][1]) * rq * g0[2], bfhi(raw[d0][1]) * rq * g0[3]),
                         cvtpk(bflo(raw[d0][2]) * rq * g1[0], bfhi(raw[d0][2]) * rq * g1[1]), cvtpk(bflo(raw[d0][3]) * rq * g1[2], bfhi(raw[d0][3]) * rq * g1[3])); }
    }
    float m = sink2, l = 1.f;
    f32x16 o0 = {}, o1 = {};
    const float sj[4] = {0.f, slope2, 2.f * slope2, 3.f * slope2};
    const int vlane = ((lane >> 4) & 1) * 32 + (lane & 3) * 8 + (4 * hi + ((lane & 15) >> 2)) * 64;
    const int thi = t0 >> 6, tlo = (t0 >= 127) ? ((t0 - 127) >> 6) : 0;
    for (int tile = thi; tile >= tlo; --tile) {
        const int s0 = tile * 64, trel = tile - tbase;
        LAS const unsigned char* kp = lds + SW_K_OFF + (trel * 64 + r32) * SW_KP + hi * 16;
        LAS const unsigned char* vb = lds + SW_V_OFF + trel * 8192 + vlane;
        LAS const float* rk = (LAS const float*)(lds + SW_RK_OFF) + trel * 64;
        f32x16 p0 = {}, p1 = {};
#pragma unroll
        for (int d0 = 0; d0 < 4; ++d0) { p0 = MFMA32(*(LAS const bf16x8*)(kp + d0 * 32), qf[d0], p0); p1 = MFMA32(*(LAS const bf16x8*)(kp + 32 * SW_KP + d0 * 32), qf[d0], p1); }
        const int dq4 = t0 + r32 - s0 - 4 * hi;
        const float nb = -slope2 * (float)dq4;
        float rmax = -INFINITY;
#pragma unroll
        for (int g = 0; g < 4; ++g) {
            const f32x4 rk0 = *(LAS const f32x4*)(rk + 8 * g + 4 * hi), rk1 = *(LAS const f32x4*)(rk + 32 + 8 * g + 4 * hi);
            const float b0 = nb + slope2 * (float)(8 * g), b1 = nb + slope2 * (float)(8 * g + 32);
#pragma unroll
            for (int j = 0; j < 4; ++j) { const int r = 4 * g + j, kc = 8 * g + j;
                { const float v = __builtin_fmaf(p0[r], rk0[j], fadd_r(b0, sj[j])); p0[r] = (unsigned)(dq4 - kc) < 128u ? v : -INFINITY; rmax = fmaxf(rmax, p0[r]); }
                { const float v = __builtin_fmaf(p1[r], rk1[j], fadd_r(b1, sj[j])); p1[r] = (unsigned)(dq4 - kc - 32) < 128u ? v : -INFINITY; rmax = fmaxf(rmax, p1[r]); } }
        }
        { const auto rr = __builtin_amdgcn_permlane32_swap(__float_as_uint(rmax), __float_as_uint(rmax), false, false); rmax = fmaxf(__uint_as_float(rr[0]), __uint_as_float(rr[1])); }
        const float mn = fmaxf(m, rmax);
        const float alpha = __builtin_amdgcn_exp2f(m - mn);
        m = mn;
        float rsum = 0.f; unsigned aw[16];
#pragma unroll
        for (int r = 0; r < 16; r += 2) {
            const float a0 = __builtin_amdgcn_exp2f(p0[r] - mn), a1 = __builtin_amdgcn_exp2f(p0[r + 1] - mn), c0 = __builtin_amdgcn_exp2f(p1[r] - mn), c1 = __builtin_amdgcn_exp2f(p1[r + 1] - mn);
            rsum += (a0 + a1) + (c0 + c1);
            aw[r >> 1] = cvtpk(a0, a1); aw[8 + (r >> 1)] = cvtpk(c0, c1);
        }
        { const auto rr = __builtin_amdgcn_permlane32_swap(__float_as_uint(rsum), __float_as_uint(rsum), false, false); rsum = __uint_as_float(rr[0]) + __uint_as_float(rr[1]); }
        l = l * alpha + rsum;
        if (hi == 0) wsf[r32] = alpha;
#pragma unroll
        for (int g = 0; g < 4; ++g) { const f32x4 f = *(LAS const f32x4*)(wsf + 8 * g + 4 * hi);
#pragma unroll
            for (int j = 0; j < 4; ++j) { o0[4 * g + j] *= f[j]; o1[4 * g + j] *= f[j]; } }
#pragma unroll
        for (int ks = 0; ks < 4; ++ks) {
            const bf16x8 pa = mk8(aw[4 * ks], aw[4 * ks + 1], aw[4 * ks + 2], aw[4 * ks + 3]);
            o0 = MFMA32(pa, vfrag(vb + ks * 1024), o0);
            o1 = MFMA32(pa, vfrag(vb + 4096 + ks * 1024), o1);
        }
    }
    if (hi == 0) wsf[r32] = 1.f / l;
#pragma unroll
    for (int g = 0; g < 4; ++g) { const f32x4 f = *(LAS const f32x4*)(wsf + 8 * g + 4 * hi);
#pragma unroll
        for (int j = 0; j < 4; ++j) { o0[4 * g + j] *= f[j]; o1[4 * g + j] *= f[j]; } }
    otile_store(o0, o1, wst, Orow0, 1024, lane);
}
__device__ __forceinline__ void phase_swatt(const bf16* QKV, const float* qg, const float* kg, const float* sinks, bf16* O, LAS unsigned char* lds, int vcu, int G, int wave, int lane) {
    const int tid = wave * 64 + lane, hi = lane >> 5, r32 = lane & 31;
    LAS unsigned char* wst = lds + SW_WV_OFF + wave * 4096;
    constexpr int NTASK = NB * (S / 256) * 4;
    for (int task = vcu; task < NTASK; task += G) {
        const int g = task & 3, qblk = (task >> 2) & 15, b = task >> 6;
        const size_t rowb = (size_t)b * S; const int q0 = qblk * 256, t0 = q0 + 32 * wave;
        v4u rawA[4], rawB[4];
        sw_qload(rawA, QKV, rowb + t0 + r32, 4 * g, hi);
        __syncthreads();
        sw_stage(QKV, rowb, q0 - 128, g, lds, tid);
        __syncthreads();
#pragma unroll
        for (int hh = 0; hh < 4; hh += 2) {
            { const int h = 4 * g + hh; sw_qload(rawB, QKV, rowb + t0 + r32, h + 1, hi);
              sw_unit(rawA, qg, kg, sinks[h] * LOG2E, exp2f(-0.5f * (float)(h + 1)) * LOG2E, O + (rowb + t0) * 1024 + h * 64, t0, (q0 >> 6) - 2, lds, wst, lane); }
            { const int h = 4 * g + hh + 1; if (hh + 2 < 4) sw_qload(rawA, QKV, rowb + t0 + r32, h + 1, hi);
              sw_unit(rawB, qg, kg, sinks[h] * LOG2E, exp2f(-0.5f * (float)(h + 1)) * LOG2E, O + (rowb + t0) * 1024 + h * 64, t0, (q0 >> 6) - 2, lds, wst, lane); }
        }
    }
}

__device__ __forceinline__ void ce_desc(float& a, float& b) { float mx, mn; asm("v_max_f32_e32 %0, %1, %2" : "=v"(mx) : "v"(a), "v"(b)); asm("v_min_f32_e32 %0, %1, %2" : "=v"(mn) : "v"(a), "v"(b)); a = mx; b = mn; }
__device__ __forceinline__ float maxf_raw(float a, float b) { float mx; asm("v_max_f32_e32 %0, %1, %2" : "=v"(mx) : "v"(a), "v"(b)); return mx; }
__device__ __forceinline__ void sort16_desc(float (&v)[16]) {
#define CE_(a, b) ce_desc(v[a], v[b])
    CE_(0,13); CE_(1,12); CE_(2,15); CE_(3,14); CE_(4,8); CE_(5,6); CE_(7,11); CE_(9,10);
    CE_(0,5); CE_(1,7); CE_(2,9); CE_(3,4); CE_(6,13); CE_(8,14); CE_(10,15); CE_(11,12);
    CE_(0,1); CE_(2,3); CE_(4,5); CE_(6,8); CE_(7,9); CE_(10,11); CE_(12,13); CE_(14,15);
    CE_(0,2); CE_(1,3); CE_(4,10); CE_(5,11); CE_(6,7); CE_(8,9); CE_(12,14); CE_(13,15);
    CE_(1,2); CE_(3,12); CE_(4,6); CE_(5,7); CE_(8,10); CE_(9,11); CE_(13,14);
    CE_(1,4); CE_(2,6); CE_(5,8); CE_(7,10); CE_(9,13); CE_(11,14);
    CE_(2,4); CE_(3,6); CE_(9,12); CE_(11,13);
    CE_(3,5); CE_(6,8); CE_(7,9); CE_(10,12);
    CE_(3,4); CE_(5,6); CE_(7,8); CE_(9,10); CE_(11,12);
    CE_(6,7); CE_(8,9);
#undef CE_
}
__device__ __forceinline__ void merge16_desc(float (&a)[16], const float (&b)[16]) {
#pragma unroll
    for (int i = 0; i < 16; ++i) a[i] = maxf_raw(a[i], b[15 - i]);
#pragma unroll
    for (int j = 8; j > 0; j >>= 1)
#pragma unroll
        for (int i = 0; i < 16; ++i) { const int l = i ^ j; if (l > i) ce_desc(a[i], a[l]); }
}
__device__ __forceinline__ void top16_of_4x16(float (&g0)[16], float (&g1)[16], float (&g2)[16], float (&g3)[16]) {
    sort16_desc(g0); sort16_desc(g1); sort16_desc(g2); sort16_desc(g3);
    merge16_desc(g0, g1); merge16_desc(g2, g3); merge16_desc(g0, g2);
}
__device__ __forceinline__ float setcode(float v, unsigned clear_mask, unsigned code) { return __uint_as_float((__float_as_uint(v) & clear_mask) | code); }

__device__ __forceinline__ void topk_unit(const bf16* QP, LAS const unsigned char* SK, unsigned short* EID, float* GATE, int tt, int h, int lane) {
    const int r32 = lane & 31, hi = lane >> 5;
    float L[2][16];
#pragma unroll
    for (int p = 0; p < 2; ++p) {
        const bf16* qp = QP + (size_t)(tt * 32 + r32) * 2048 + h * 256 + p * 128 + hi * 8;
        bf16x8 qf[8];
#pragma unroll
        for (int ks = 0; ks < 8; ++ks) qf[ks] = *(const bf16x8*)(qp + ks * 16);
        LAS const unsigned char* kp = SK + (p * 128 + r32) * 272 + hi * 16;
        float g[4][16];
        bf16x8 afA[8], afB[8];
#define TK_LOAD(af, mt) do { _Pragma("unroll") for (int ks = 0; ks < 8; ++ks) af[ks] = *(LAS const bf16x8*)(kp + (mt) * 32 * 272 + ks * 32); } while (0)
#define TK_MMA(af, mt) do { f32x16 acc = {}; _Pragma("unroll") for (int ks = 0; ks < 8; ++ks) acc = MFMA32(af[ks], qf[ks], acc); \
        _Pragma("unroll") for (int r = 0; r < 16; ++r) g[mt][r] = setcode(acc[r], 0xFFFFFF80u, (unsigned)(32 * (mt) + (r & 3) + 8 * (r >> 2))); } while (0)
        TK_LOAD(afA, 0); asm volatile("" ::: "memory");
        TK_LOAD(afB, 1); asm volatile("" ::: "memory"); TK_MMA(afA, 0);
        TK_LOAD(afA, 2); asm volatile("" ::: "memory"); TK_MMA(afB, 1);
        TK_LOAD(afB, 3); asm volatile("" ::: "memory"); TK_MMA(afA, 2);
        TK_MMA(afB, 3);
#undef TK_LOAD
#undef TK_MMA
        top16_of_4x16(g[0], g[1], g[2], g[3]);
        float other[16];
#pragma unroll
        for (int i = 0; i < 16; ++i) {
            g[0][i] = __uint_as_float(__float_as_uint(g[0][i]) | (unsigned)(hi << 2));
            const auto rr = __builtin_amdgcn_permlane32_swap(__float_as_uint(g[0][i]), __float_as_uint(g[0][i]), false, false);
            other[i] = __uint_as_float(hi ? rr[0] : rr[1]);
        }
        merge16_desc(g[0], other);
#pragma unroll
        for (int i = 0; i < 16; ++i) L[p][i] = g[0][i];
    }
    unsigned TA[4], TB[4];
#pragma unroll
    for (int k = 0; k < 16; ++k) {
        const unsigned ca = (__float_as_uint(L[0][k]) & 0x7Fu) << (8 * (k & 3)), cb = (__float_as_uint(L[1][k]) & 0x7Fu) << (8 * (k & 3));
        if ((k & 3) == 0) { TA[k >> 2] = ca; TB[k >> 2] = cb; } else { TA[k >> 2] |= ca; TB[k >> 2] |= cb; }
    }
    float c[4][16];
    {
        int n = 0;
#pragma unroll
        for (int i = 0; i < 16; ++i)
#pragma unroll
            for (int j = 0; j < 16; ++j)
                if ((i + 1) * (j + 1) <= 16) { c[n >> 4][n & 15] = setcode(L[0][i] + L[1][j], 0xFFFFFF00u, (unsigned)(i * 16 + j)); ++n; }
#pragma unroll
        for (int k = 50; k < 64; ++k) c[k >> 4][k & 15] = -INFINITY;
    }
    {
        float x0[16], x1[16], other[16];
#pragma unroll
        for (int i = 0; i < 16; ++i) { x0[i] = hi ? c[2][i] : c[0][i]; x1[i] = hi ? c[3][i] : c[1][i]; }
        sort16_desc(x0); sort16_desc(x1); merge16_desc(x0, x1);
#pragma unroll
        for (int i = 0; i < 16; ++i) { const auto rr = __builtin_amdgcn_permlane32_swap(__float_as_uint(x0[i]), __float_as_uint(x0[i]), false, false); other[i] = __uint_as_float(hi ? rr[0] : rr[1]); }
        merge16_desc(x0, other);
#pragma unroll
        for (int i = 0; i < 16; ++i) c[0][i] = x0[i];
    }
    float ex[16]; float den = 0.f;
#pragma unroll
    for (int r = 0; r < 16; ++r) { ex[r] = __builtin_amdgcn_exp2f((c[0][r] - c[0][0]) * LOG2E); den += ex[r]; }
    const float inv = 1.f / den;
    unsigned eidv[16];
#pragma unroll
    for (int r = 0; r < 16; ++r) {
        const unsigned code = __float_as_uint(c[0][r]) & 0xFFu, i = code >> 4, j = code & 15u;
        const unsigned sa = (i & 7u) | 0x0C0C0C00u, sb = (j & 7u) | 0x0C0C0C00u;
        const unsigned ia = (i & 8u) ? __builtin_amdgcn_perm(TA[3], TA[2], sa) : __builtin_amdgcn_perm(TA[1], TA[0], sa);
        const unsigned ib = (j & 8u) ? __builtin_amdgcn_perm(TB[3], TB[2], sb) : __builtin_amdgcn_perm(TB[1], TB[0], sb);
        eidv[r] = ia * 128u + ib;
        ex[r] *= inv;
    }
    if (hi == 0) {
        const size_t off = (size_t)(tt * 32 + r32) * 128 + h * 16;
        v4u e0 = {eidv[0] | (eidv[1] << 16), eidv[2] | (eidv[3] << 16), eidv[4] | (eidv[5] << 16), eidv[6] | (eidv[7] << 16)}, e1 = {eidv[8] | (eidv[9] << 16), eidv[10] | (eidv[11] << 16), eidv[12] | (eidv[13] << 16), eidv[14] | (eidv[15] << 16)};
        *(v4u*)(EID + off) = e0; *(v4u*)(EID + off + 8) = e1;
#pragma unroll
        for (int q = 0; q < 4; ++q) { f32x4 g4 = {ex[4 * q], ex[4 * q + 1], ex[4 * q + 2], ex[4 * q + 3]}; *(f32x4*)(GATE + off + 4 * q) = g4; }
    }
}
__device__ __forceinline__ float gelu_tanh_f(float x) { const float u = 0.7978845608028654f * (x + 0.044715f * x * x * x); const float e = __builtin_amdgcn_exp2f(u * (2.f * LOG2E)); return x * (1.f - __builtin_amdgcn_rcpf(e + 1.f)); }

__device__ __forceinline__ void peer_rows(v4u (&row)[16], const v4u (&ev)[4], const unsigned char* tab, unsigned lane_off) {
#pragma unroll
    for (int j = 0; j < 16; ++j) row[j] = *(const v4u*)(tab + (size_t)(ev[j >> 2][j & 3] + lane_off));
}
__device__ __forceinline__ void fmac_s(float& acc, float a, float b) { asm("v_fmac_f32_e32 %0, %1, %2" : "+v"(acc) : "v"(a), "v"(b)); }
__device__ __forceinline__ float fmul_s(float a, float b) { float r; asm("v_mul_f32_e32 %0, %1, %2" : "=v"(r) : "v"(a), "v"(b)); return r; }
__device__ __forceinline__ float fadd_s(float a, float b) { float r; asm("v_add_f32_e32 %0, %1, %2" : "=v"(r) : "v"(a), "v"(b)); return r; }
#define DPP_ADD_ASM(d, s, CTRL) asm("s_nop 1\n\tv_add_f32_dpp %0, %1, %1 " CTRL " row_mask:0xf bank_mask:0xf" : "=v"(d) : "v"(s))
typedef _Float16 h16x2 __attribute__((ext_vector_type(2)));
__device__ __forceinline__ h16x2 as_h2(unsigned w) { return __builtin_bit_cast(h16x2, w); }
__device__ __forceinline__ unsigned as_u(h16x2 v) { return __builtin_bit_cast(unsigned, v); }
__device__ __forceinline__ void peer_u_token(const v4u (&row)[16], const v4u& xh, const v4u& xl, float xs, _Float16* hp_t, int r, int c) {
    float ss[16];
#pragma unroll
    for (int j = 0; j < 16; ++j) {
        int ah = 0, al = 0;
#pragma unroll
        for (int w = 0; w < 4; ++w) { ah = __builtin_amdgcn_sdot8((int)row[j][w], (int)xh[w], ah, false); al = __builtin_amdgcn_sdot8((int)row[j][w], (int)xl[w], al, false); }
        ss[j] = (float)(16 * ah + al);
    }
    const bool b0 = (c & 1) != 0, b1 = (c & 2) != 0, b2 = (c & 4) != 0;
    float a[8], b[4], d[2];
#pragma unroll
    for (int j = 0; j < 8; ++j) { const float keep = b0 ? ss[j + 8] : ss[j], send = b0 ? ss[j] : ss[j + 8];
        a[j] = keep + __builtin_bit_cast(float, __builtin_amdgcn_update_dpp(0, __builtin_bit_cast(int, send), DPP_XOR1, 0xF, 0xF, true)); }
#pragma unroll
    for (int j = 0; j < 4; ++j) { const float keep = b1 ? a[j + 4] : a[j], send = b1 ? a[j] : a[j + 4];
        b[j] = keep + __builtin_bit_cast(float, __builtin_amdgcn_update_dpp(0, __builtin_bit_cast(int, send), DPP_XOR2, 0xF, 0xF, true)); }
#pragma unroll
    for (int j = 0; j < 2; ++j) { const float keep = b2 ? b[j + 2] : b[j], send = b2 ? b[j] : b[j + 2];
        d[j] = keep + __shfl_xor(send, 4); }
    const int rw = 8 * (c & 1) + 4 * ((c >> 1) & 1) + 2 * (c >> 2);
    *(unsigned*)(hp_t + 16 * r + rw) = as_u((h16x2){(_Float16)(d[0] * xs), (_Float16)(d[1] * xs)});
}
typedef unsigned u32x2 __attribute__((ext_vector_type(2)));
#define FENCE() asm volatile("" ::: "memory")
#define PEER_SLOT(i) (wl + ((((i) >> 2) & 1) * 4096 + ((i) & 3) * 1024))
__device__ __forceinline__ void phase_peer_u(const bf16* h, const unsigned short* eid, const unsigned char* U8, _Float16* hp, LAS unsigned char* wl, int sl, int m, int nmem, int wave, int nwv, int lane) {
    const int r = lane >> 3, c = lane & 7;
    const int cw = (((T + nmem - 1) / nmem) + 3) >> 2;
    const int cq = cw / nwv, crem = cw % nwv;
    const int ntokw = 4 * (cq + (wave < crem ? 1 : 0));
    const int base = 4 * (m * cw + wave * cq + (wave < crem ? wave : crem));
    const unsigned char* tab = U8 + (size_t)sl * (16384 * 128); const unsigned loff16 = 16u * (unsigned)c;
    _Float16* hp_s = hp + (size_t)sl * T * 128;
    const int lk = lane >> 4, lj = lane & 15, lk2 = lane >> 5, lj2 = lane & 31;
#define TCH(i0) ((base + (i0) + 4 <= T) ? base + (i0) : T - 4)
#define STG_LD(i0) do { const int t_ = TCH(i0); sE = *(const v4u*)(eid + (size_t)t_ * 128 + 8 * lane); \
        sX0 = *(const v4u*)(h + (size_t)(t_ + lk2) * 1024 + 256 * sl + 8 * lj2); sX1 = *(const v4u*)(h + (size_t)(t_ + 2 + lk2) * 1024 + 256 * sl + 8 * lj2); } while (0)
#define XQ_ST(sX, tokslot) do { float xf_[8]; float am_ = 0.f; \
        _Pragma("unroll") for (int q = 0; q < 4; ++q) { xf_[2 * q] = bflo(sX[q]); xf_[2 * q + 1] = bfhi(sX[q]); am_ = fmaxf(am_, fmaxf(fabsf(xf_[2 * q]), fabsf(xf_[2 * q + 1]))); } \
        DPP_MAX(am_, DPP_XOR1); DPP_MAX(am_, DPP_XOR2); DPP_MAX(am_, DPP_HALF_MIRROR); DPP_MAX(am_, DPP_ROW_MIRROR); am_ = fmaxf(am_, __shfl_xor(am_, 16));     \
        const float inv_ = am_ > 0.f ? 119.f / am_ : 0.f; unsigned wh_ = 0u, wl_ = 0u; \
        _Pragma("unroll") for (int e = 0; e < 8; ++e) { const int xq_ = (int)__builtin_rintf(xf_[e] * inv_), hi_ = (xq_ + 8) >> 4, lo_ = xq_ - 16 * hi_; wh_ |= ((unsigned)hi_ & 15u) << (4 * e); wl_ |= ((unsigned)lo_ & 15u) << (4 * e); } \
        LAS unsigned char* xs_ = PEER_SLOT(tokslot); *(LAS unsigned*)(xs_ + 512 + 4 * lj2) = wh_; *(LAS unsigned*)(xs_ + 640 + 4 * lj2) = wl_; if (lj2 == 0) *(LAS float*)(xs_ + 768) = am_ * (1.f / 119.f); } while (0)
#define STG_ST(i0) do { LAS unsigned char* s_ = PEER_SLOT((i0) + lk); \
        const v4u e0_ = {(sE[0] & 0xFFFFu) << 7, (sE[0] >> 16) << 7, (sE[1] & 0xFFFFu) << 7, (sE[1] >> 16) << 7}, e1_ = {(sE[2] & 0xFFFFu) << 7, (sE[2] >> 16) << 7, (sE[3] & 0xFFFFu) << 7, (sE[3] >> 16) << 7}; \
        *(LAS v4u*)(s_ + 32 * lj) = e0_; *(LAS v4u*)(s_ + 32 * lj + 16) = e1_; \
        XQ_ST(sX0, (i0) + lk2); XQ_ST(sX1, (i0) + 2 + lk2); } while (0)
#define RD_EV(i) do { LAS const unsigned char* s_ = PEER_SLOT(i); _Pragma("unroll") for (int q = 0; q < 4; ++q) ev[q] = *(LAS const v4u*)(s_ + 64 * r + 16 * q); } while (0)
#define RD_X(i) do { LAS const unsigned char* s_ = PEER_SLOT(i); xh = *(LAS const v4u*)(s_ + 512 + 16 * c); xl = *(LAS const v4u*)(s_ + 640 + 16 * c); xs = *(LAS const float*)(s_ + 768); } while (0)
    v4u ev[4], rA[16], rB[16], xh, xl, sE, sX0, sX1; float xs;
    STG_LD(0);
    for (int i0 = 0; i0 < ntokw; i0 += 4) {
        const int tch = TCH(i0);
        STG_ST(i0); FENCE();
        RD_EV(i0); peer_rows(rA, ev, tab, loff16); FENCE();
        STG_LD(i0 + 4); FENCE();
#pragma unroll
        for (int k = 0; k < 4; k += 2) {
            RD_EV(i0 + k + 1); peer_rows(rB, ev, tab, loff16); FENCE();
            RD_X(i0 + k); peer_u_token(rA, xh, xl, xs, hp_s + (size_t)(tch + k) * 128, r, c); FENCE();
            if (k + 2 < 4) { RD_EV(i0 + k + 2); peer_rows(rA, ev, tab, loff16); FENCE(); }
            RD_X(i0 + k + 1); peer_u_token(rB, xh, xl, xs, hp_s + (size_t)(tch + k + 1) * 128, r, c); FENCE();
        }
    }
#undef STG_LD
#undef STG_ST
#undef XQ_ST
#undef RD_X
#undef TCH
}
__device__ __forceinline__ void phase_peer_coef(const _Float16* hp, const float* ssp_in, const unsigned short* eid, const float* gate, const f32x2* isuv, _Float16* coef, int gw, int NGW, int lane) {
    for (int tb = gw; tb < T; tb += 4 * NGW) {
        unsigned e[4], h[4][4]; f32x2 g[4], s0[4], s1[4]; float sp[4];
#pragma unroll
        for (int i = 0; i < 4; ++i) { const int t = (tb + i * NGW < T) ? tb + i * NGW : T - 1; e[i] = *(const unsigned*)(eid + (size_t)t * 128 + 2 * lane); }
#pragma unroll
        for (int i = 0; i < 4; ++i) { const int t = (tb + i * NGW < T) ? tb + i * NGW : T - 1;
#pragma unroll
            for (int s8 = 0; s8 < 4; ++s8) h[i][s8] = *(const unsigned*)(hp + ((size_t)s8 * T + t) * 128 + 2 * lane);
            g[i] = *(const f32x2*)(gate + (size_t)t * 128 + 2 * lane);
            sp[i] = ssp_in[(size_t)(lane & 15) * T + t]; }
#pragma unroll
        for (int i = 0; i < 4; ++i) { s0[i] = isuv[e[i] & 0xFFFFu]; s1[i] = isuv[e[i] >> 16]; }
#pragma unroll
        for (int i = 0; i < 4; ++i) {
            float ss = sp[i]; DPP_ADD(ss, DPP_XOR1); DPP_ADD(ss, DPP_XOR2); DPP_ADD(ss, DPP_HALF_MIRROR); DPP_ADD(ss, DPP_ROW_MIRROR);
            const float r16 = rsqrtf(ss * (1.f / 1024.f) + 1e-6f);
            float a0 = 0.f, a1 = 0.f;
#pragma unroll
            for (int s8 = 0; s8 < 4; ++s8) { const h16x2 v = as_h2(h[i][s8]); a0 += (float)v[0]; a1 += (float)v[1]; }
            const float c0 = g[i][0] * gelu_tanh_f(a0 * r16 * s0[i][0]) * (256.f * s0[i][1]);
            const float c1 = g[i][1] * gelu_tanh_f(a1 * r16 * s1[i][0]) * (256.f * s1[i][1]);
            if (tb + i * NGW < T) *(unsigned*)(coef + (size_t)(tb + i * NGW) * 128 + 2 * lane) = as_u((h16x2){(_Float16)c0, (_Float16)c1});
        }
    }
}
__device__ __forceinline__ float peer_v_token(const v4u (&row)[16], const v4u (&cw)[2], const f32x4 hold, float* hdst_l, bf16* hb_l, int lane) {
    h16x2 ah[16];
#pragma unroll
    for (int i = 0; i < 16; ++i) ah[i] = (h16x2){(_Float16)0.f, (_Float16)0.f};
#pragma unroll
    for (int j = 0; j < 16; ++j) {
        const h16x2 cp_ = as_h2(cw[j >> 3][(j >> 1) & 3]); const _Float16 c1_ = cp_[j & 1]; const h16x2 ch = {c1_, c1_};
#define V4_ACC(w, b) ah[4 * (w) + (b)] = __builtin_elementwise_fma(__builtin_bit_cast(h16x2, __builtin_amdgcn_cvt_scalef32_pk_f16_fp4(row[j][w], 0.00390625f, b)), ch, ah[4 * (w) + (b)])
#pragma unroll
        for (int w = 0; w < 4; ++w) { V4_ACC(w, 0); V4_ACC(w, 1); V4_ACC(w, 2); V4_ACC(w, 3); }
#undef V4_ACC
    }
    h16x2 A[8], Bq[4], Cq[2];
#pragma unroll
    for (int i = 0; i < 8; ++i) { const auto rr = __builtin_amdgcn_permlane32_swap(as_u(ah[i]), as_u(ah[i + 8]), false, false); A[i] = as_h2(rr[0]) + as_h2(rr[1]); }
#pragma unroll
    for (int i = 0; i < 4; ++i) { const auto rr = __builtin_amdgcn_permlane16_swap(as_u(A[i]), as_u(A[i + 4]), false, false); Bq[i] = as_h2(rr[0]) + as_h2(rr[1]); }
    const bool b3 = (lane & 8) != 0;
#pragma unroll
    for (int i = 0; i < 2; ++i) { const unsigned keep = b3 ? as_u(Bq[i + 2]) : as_u(Bq[i]), send = b3 ? as_u(Bq[i]) : as_u(Bq[i + 2]);
        Cq[i] = as_h2(keep) + as_h2((unsigned)__builtin_amdgcn_update_dpp(0, (int)send, DPP_ROW_ROR8, 0xF, 0xF, true)); }
    const float n0 = hold[0] + (float)Cq[0][0], n1 = hold[1] + (float)Cq[0][1], n2 = hold[2] + (float)Cq[1][0], n3 = hold[3] + (float)Cq[1][1];
    if (hdst_l) { f32x4 o = {n0, n1, n2, n3}; *(f32x4*)hdst_l = o; return 0.f; }
    *(u32x2p*)hb_l = (u32x2p){pk2(n0, n1), pk2(n2, n3)};
    return wave_sum((n0 * n0 + n1 * n1) + (n2 * n2 + n3 * n3));
}
#define PEER_SLOTV(i) (wl + ((((i) >> 2) & 1) * 8192 + ((i) & 3) * 2048))
__device__ __forceinline__ void phase_peer_v(const bf16* h, float* hdst, const unsigned short* eid, const _Float16* coef, const unsigned char* V4, bf16* hb, float* ssp_out, float* scratch, LAS unsigned char* wl, int sl, int m, int nmem, int wave, int nwv, int tailc, int lane) {
    const int r = lane >> 3, c = lane & 7;
    const int cw = (((T + nmem - 1) / nmem) + 3) >> 2;
    const int cd = cw - tailc, cq = cd / nwv, crem = cd % nwv;
    const int ntokw = wave == nwv ? 4 * tailc : 4 * (cq + (wave < crem ? 1 : 0));
    const int base = wave == nwv ? 4 * (m * cw + cd) : 4 * (m * cw + wave * cq + (wave < crem ? wave : crem));
    const unsigned char* tab = V4 + (size_t)sl * (16384 * 128); const unsigned loff16 = 16u * (unsigned)c;
    const size_t loff = 256 * sl + 32 * c + 4 * r; float* ssp_s = ssp_out + (size_t)sl * T;
    const int lk = lane >> 4, lj = lane & 15, lk2 = lane >> 5, lj2 = lane & 31;
#define TCH(i0) ((base + (i0) + 4 <= T) ? base + (i0) : T - 4)
#define STG_LD(i0) do { const int t_ = TCH(i0); sE = *(const v4u*)(eid + (size_t)t_ * 128 + 8 * lane); sC = *(const v4u*)(coef + (size_t)t_ * 128 + 8 * lane); \
        sH0 = *(const v4u*)(h + (size_t)(t_ + lk2) * 1024 + 256 * sl + 8 * lj2); sH1 = *(const v4u*)(h + (size_t)(t_ + 2 + lk2) * 1024 + 256 * sl + 8 * lj2); } while (0)
#define STG_ST(i0) do { LAS unsigned char* s_ = PEER_SLOTV((i0) + lk); \
        const v4u e0_ = {(sE[0] & 0xFFFFu) << 7, (sE[0] >> 16) << 7, (sE[1] & 0xFFFFu) << 7, (sE[1] >> 16) << 7}, e1_ = {(sE[2] & 0xFFFFu) << 7, (sE[2] >> 16) << 7, (sE[3] & 0xFFFFu) << 7, (sE[3] >> 16) << 7}; \
        *(LAS v4u*)(s_ + 32 * lj) = e0_; *(LAS v4u*)(s_ + 32 * lj + 16) = e1_; *(LAS v4u*)(s_ + 512 + 16 * lj) = sC; \
        *(LAS v4u*)(PEER_SLOTV((i0) + lk2) + 1024 + 16 * lj2) = sH0; *(LAS v4u*)(PEER_SLOTV((i0) + 2 + lk2) + 1024 + 16 * lj2) = sH1; } while (0)
#define RD_EVV(i) do { LAS const unsigned char* s_ = PEER_SLOTV(i); _Pragma("unroll") for (int q = 0; q < 4; ++q) ev[q] = *(LAS const v4u*)(s_ + 64 * r + 16 * q); } while (0)
#define RD_C(i) do { LAS const unsigned char* s_ = PEER_SLOTV(i); cv[0] = *(LAS const v4u*)(s_ + 512 + 32 * r); cv[1] = *(LAS const v4u*)(s_ + 512 + 32 * r + 16); \
        { const u32x2p hw_ = *(LAS const u32x2p*)(s_ + 1024 + (32 * c + 4 * r) * 2); hold = (f32x4){bflo(hw_[0]), bfhi(hw_[0]), bflo(hw_[1]), bfhi(hw_[1])}; } } while (0)
#define V_TOK(k, R) do { const size_t o_ = (size_t)(tch + (k)) * 1024 + loff; \
        ssq[k] = peer_v_token(R, cv, hold, hdst ? (ok_ ? hdst : scratch) + o_ : nullptr, (ok_ ? hb : (bf16*)scratch) + o_, lane); } while (0)
    v4u ev[4], rA[16], rB[16], cv[2], sE, sC, sH0, sH1; f32x4 hold; float ssq[4];
    STG_LD(0);
    for (int i0 = 0; i0 < ntokw; i0 += 4) {
        const int tch = TCH(i0); const bool ok_ = base + i0 + 4 <= T;
        STG_ST(i0); FENCE();
        RD_EVV(i0); peer_rows(rA, ev, tab, loff16); FENCE();
        STG_LD(i0 + 4); FENCE();
#pragma unroll
        for (int k = 0; k < 4; k += 2) {
            RD_EVV(i0 + k + 1); peer_rows(rB, ev, tab, loff16); FENCE();
            RD_C(i0 + k); V_TOK(k, rA); FENCE();
            if (k + 2 < 4) { RD_EVV(i0 + k + 2); peer_rows(rA, ev, tab, loff16); FENCE(); }
            RD_C(i0 + k + 1); V_TOK(k + 1, rB); FENCE();
        }
        if (!hdst && lane < 4) { const float sv = lane == 0 ? ssq[0] : lane == 1 ? ssq[1] : lane == 2 ? ssq[2] : ssq[3]; (ok_ ? ssp_s : scratch)[tch + lane] = sv; }
    }
#undef STG_LD
#undef STG_ST
#undef V_TOK
#undef RD_EVV
#undef RD_EV
#undef RD_C
#undef TCH
#undef FENCE
}

#ifndef PROBE_REP
#define PROBE_REP 0u
#endif
enum Phase { PH_PREP = 0, PH_QKV0 = 1, PH_SBATT = 2, PH_OPROJ0 = 3, PH_PQ0 = 4, PH_TOPK0 = 5, PH_GATH0 = 6, PH_QKV1 = 7, PH_SWATT = 8, PH_OPROJ1 = 9, PH_PQ1 = 10, PH_TOPK1 = 11, PH_GATH1 = 12, PH_N = 13 };

__global__ void __launch_bounds__(NWAVES * 64, 2) mega(Args a) {
    extern __shared__ __attribute__((aligned(16))) unsigned char lds_raw[];
    LAS unsigned char* lds = (LAS unsigned char*)lds_raw;
    volatile LAS unsigned* MISC = (volatile LAS unsigned*)(lds + MISC_OFF);
    LAS float* rs = (LAS float*)(lds + RS_OFF);
    const int tid = threadIdx.x, lane = tid & 63, wave = __builtin_amdgcn_readfirstlane(tid >> 6);
    const int G = gridDim.x; const int bx = blockIdx.x; const int vcu = (G % 8 == 0) ? (bx % 8) * (G / 8) + bx / 8 : bx;
    const int gw = vcu * NWAVES + wave, NGW = G * NWAVES;
    unsigned char* ws = a.ws;
    gu32* ctl = (gu32*)(ws + WS_CTL);
    for (int u = tid; u < 64; u += NWAVES * 64) ((LAS unsigned*)(lds + MISC_OFF))[u] = 0u;
    __syncthreads();
    XcdBarrier bar = xcd_barrier_post((unsigned*)(ctl + CW_BAR) + a.li * XCD_BAR_WORDS, MISC + 8);
    bool first = true;
#define PHASE_ON(k) ((a.mask >> (k)) & 1u)
#define SEAM() do { if (!first) xcd_barrier(bar); first = false; } while (0)

    bf16* HB = (bf16*)(ws + WS_HB); bf16* QB = (bf16*)(ws + WS_QB); bf16* AO = (bf16*)(ws + WS_AO); bf16* QP = (bf16*)(ws + WS_QP);
    float* SSP0 = (float*)(ws + WS_SSP); float* SSP1 = SSP0 + 16 * T; float* SSP2 = SSP1 + 16 * T; float* SSP3 = SSP2 + 16 * T;

#define NREP(b) (1 + (int)((PROBE_REP >> (b)) & 1u))
    if (PHASE_ON(PH_PREP)) { SEAM(); for (int q = 0; q < NREP(0); ++q) phase_prep(a, lds, gw, NGW, wave, lane); }

    if (PHASE_ON(PH_QKV0)) { SEAM();
        _Pragma("unroll") for (int q = 0; q < NREP(1); ++q) {
        pg8::Gemm g{HB, (const bf16*)(ws + WS_WQKV0), T, 3072, 1024}; pg8::StaticOrder So; So.init(T, 3072, G, bx);
        fill_rs(rs, So, SSP0, 1, tid);
        pg8::EpiScaleBf16 E{QB, 1024, 1024, (size_t)(WS_KB - WS_QB) / 2, C2, rs};
        pg8::gemm_phase<pg8::EpiScaleBf16, pg8::StaticOrder, true, true>(lds, g, So, E); }
    }
    if (PHASE_ON(PH_SBATT)) { SEAM(); for (int q = 0; q < NREP(2); ++q) { if (wave >= NWAVES - 2) { convert_tables(a, 0, wave == NWAVES - 1 ? 4096 : 0, wave == NWAVES - 1 ? 8192 : 4096, bx, G, lane); transpose_weights(a, 0, wave == NWAVES - 1 ? 4 : 2, (LAS float*)(lds + wave * 17408), bx, G, lane); }
          else phase_sbatt(QB, (const bf16*)(ws + WS_KB), (const bf16*)(ws + WS_VB), AO, lds, vcu, G, wave, NWAVES - 2, lane); } }
    if (PHASE_ON(PH_OPROJ0)) { SEAM();
        _Pragma("unroll") for (int q = 0; q < NREP(3); ++q) {
        pg8::Gemm g{AO, (const bf16*)(ws + WS_WO0), T, 1024, 1024}; pg8::StaticOrder So; So.init(T, 1024, G, bx);
        pg8::EpiResid E{HB, HB, SSP1, T};
        pg8::gemm_phase<pg8::EpiResid, pg8::StaticOrder, true, true>(lds, g, So, E); }
    }
    if (PHASE_ON(PH_PQ0)) { SEAM();
        _Pragma("unroll") for (int q = 0; q < NREP(4); ++q) {
        pg8::Gemm g{HB, (const bf16*)(ws + WS_WPQ0), T, 2048, 1024}; pg8::StaticOrder So; So.init(T, 2048, G, bx);
        fill_rs(rs, So, SSP1, 16, tid);
        pg8::EpiScaleBf16 E{QP, 2048, 0, 0, 1.f, rs};
        pg8::gemm_phase<pg8::EpiScaleBf16, pg8::StaticOrder, true, true>(lds, g, So, E);
        _Pragma("unroll") for (int q2 = 0; q2 < NREP(5); ++q2) { pg8::Unit u, u2; for (int ui = 0; So.next(ui, u); ui += 2) {
            const bool two = So.next(ui + 1, u2);
            __syncthreads();
            { const bf16* sk_ = ((const bf16*)(ws + WS_SUBK)) + (size_t)u.pn * 2 * 128 * 128; const bf16* sk2_ = ((const bf16*)(ws + WS_SUBK)) + (size_t)(two ? u2.pn : u.pn) * 2 * 128 * 128;
              v4u st_[16];
              _Pragma("unroll") for (int n_ = 0; n_ < 8; ++n_) { const int i_ = tid + 512 * n_, row_ = i_ >> 4, ch_ = i_ & 15; st_[n_] = *(const v4u*)(sk_ + row_ * 128 + ch_ * 8); st_[8 + n_] = *(const v4u*)(sk2_ + row_ * 128 + ch_ * 8); }
              _Pragma("unroll") for (int n_ = 0; n_ < 8; ++n_) { const int i_ = tid + 512 * n_, row_ = i_ >> 4, ch_ = i_ & 15; *(LAS v4u*)(lds + row_ * 272 + ch_ * 16) = st_[n_]; *(LAS v4u*)(lds + 69632 + row_ * 272 + ch_ * 16) = st_[8 + n_]; } }
            __syncthreads();
            topk_unit(QP, lds, (unsigned short*)(ws + WS_EID), (float*)(ws + WS_GATE), u.pm * 8 + wave, u.pn, lane);
            if (two) topk_unit(QP, lds + 69632, (unsigned short*)(ws + WS_EID), (float*)(ws + WS_GATE), u2.pm * 8 + wave, u2.pn, lane); } } }
    }
    const int sl4 = bx & 3, smem4 = bx >> 2, nmem4 = (G - 1 - sl4) / 4 + 1;
    float* HP = (float*)(ws + WS_HP); _Float16* COEF = (_Float16*)(ws + WS_COEF); const unsigned short* EIDp = (const unsigned short*)(ws + WS_EID); const float* GATEp = (const float*)(ws + WS_GATE);
    if (PHASE_ON(PH_GATH0)) { SEAM();
        _Pragma("unroll") for (int q = 0; q < NREP(6); ++q) phase_peer_u(HB, EIDp, ws + WS_U8, (_Float16*)HP, lds + wave * 16384, sl4, smem4, nmem4, wave, NWAVES, lane);
        xcd_barrier(bar);
        _Pragma("unroll") for (int q = 0; q < NREP(13); ++q) phase_peer_coef((const _Float16*)HP, SSP1, EIDp, GATEp, (const f32x2*)(ws + WS_ISU), COEF, gw, NGW, lane);
        transpose_weights(a, 1, 7, (LAS float*)(lds + wave * 16384), wave * (NGW / NWAVES) + (gw / NWAVES), NGW, lane);
        xcd_barrier(bar);
        if (wave == NWAVES - 1) convert_tables(a, 1, 0, 8192, bx, G, lane);
        phase_peer_v(HB, nullptr, EIDp, COEF, ws + WS_V8, HB, SSP2, HP, lds + wave * 16384, sl4, smem4, nmem4, wave, NWAVES - 1, 1, lane);
    }
    if (PHASE_ON(PH_QKV1)) { SEAM();
        _Pragma("unroll") for (int q = 0; q < NREP(7); ++q) {
        pg8::Gemm g{HB, (const bf16*)(ws + WS_WQKV1), T, 1536, 1024}; pg8::StaticOrder So; So.init(T, 1536, G, bx);
        fill_rs(rs, So, SSP2, 4, tid);
        pg8::EpiScaleBf16 E{QB, 1536, 0, 0, 1.f, rs};
        pg8::gemm_phase<pg8::EpiScaleBf16, pg8::StaticOrder, true, true>(lds, g, So, E); }
    }
    if (PHASE_ON(PH_SWATT)) { SEAM(); for (int q = 0; q < NREP(8); ++q) phase_swatt(QB, a.in[6], a.in[7], a.in[8], AO, lds, vcu, G, wave, lane); }
    if (PHASE_ON(PH_OPROJ1)) { SEAM();
        _Pragma("unroll") for (int q = NREP(9) - 1; q >= 0; --q) {
        pg8::Gemm g{AO, (const bf16*)(ws + WS_WO1), T, 1024, 1024}; pg8::StaticOrder So; So.init(T, 1024, G, bx);
        pg8::EpiResid E{HB, q ? (bf16*)QP : HB, q ? SSP0 : SSP3, T};
        pg8::gemm_phase<pg8::EpiResid, pg8::StaticOrder, true, true>(lds, g, So, E); }
    }
    if (PHASE_ON(PH_PQ1)) { SEAM();
        _Pragma("unroll") for (int q = 0; q < NREP(10); ++q) {
        pg8::Gemm g{HB, (const bf16*)(ws + WS_WPQ1), T, 2048, 1024}; pg8::StaticOrder So; So.init(T, 2048, G, bx);
        fill_rs(rs, So, SSP3, 16, tid);
        pg8::EpiScaleBf16 E{QP, 2048, 0, 0, 1.f, rs};
        pg8::gemm_phase<pg8::EpiScaleBf16, pg8::StaticOrder, true, true>(lds, g, So, E);
        _Pragma("unroll") for (int q2 = 0; q2 < NREP(11); ++q2) { pg8::Unit u, u2; for (int ui = 0; So.next(ui, u); ui += 2) {
            const bool two = So.next(ui + 1, u2);
            __syncthreads();
            { const bf16* sk_ = ((const bf16*)(ws + WS_SUBK) + (size_t)8 * 2 * 128 * 128) + (size_t)u.pn * 2 * 128 * 128; const bf16* sk2_ = ((const bf16*)(ws + WS_SUBK) + (size_t)8 * 2 * 128 * 128) + (size_t)(two ? u2.pn : u.pn) * 2 * 128 * 128;
              v4u st_[16];
              _Pragma("unroll") for (int n_ = 0; n_ < 8; ++n_) { const int i_ = tid + 512 * n_, row_ = i_ >> 4, ch_ = i_ & 15; st_[n_] = *(const v4u*)(sk_ + row_ * 128 + ch_ * 8); st_[8 + n_] = *(const v4u*)(sk2_ + row_ * 128 + ch_ * 8); }
              _Pragma("unroll") for (int n_ = 0; n_ < 8; ++n_) { const int i_ = tid + 512 * n_, row_ = i_ >> 4, ch_ = i_ & 15; *(LAS v4u*)(lds + row_ * 272 + ch_ * 16) = st_[n_]; *(LAS v4u*)(lds + 69632 + row_ * 272 + ch_ * 16) = st_[8 + n_]; } }
            __syncthreads();
            topk_unit(QP, lds, (unsigned short*)(ws + WS_EID), (float*)(ws + WS_GATE), u.pm * 8 + wave, u.pn, lane);
            if (two) topk_unit(QP, lds + 69632, (unsigned short*)(ws + WS_EID), (float*)(ws + WS_GATE), u2.pm * 8 + wave, u2.pn, lane); } } }
    }
    if (PHASE_ON(PH_GATH1)) { SEAM();
        _Pragma("unroll") for (int q = 0; q < NREP(12); ++q) phase_peer_u(HB, EIDp, ws + WS_U8 + (size_t)16384 * 512, (_Float16*)HP, lds + wave * 16384, sl4, smem4, nmem4, wave, NWAVES, lane);
        xcd_barrier(bar);
        _Pragma("unroll") for (int q = 0; q < NREP(13); ++q) phase_peer_coef((const _Float16*)HP, SSP3, EIDp, GATEp, (const f32x2*)(ws + WS_ISU) + 16384, COEF, gw, NGW, lane);
        xcd_barrier(bar);
        phase_peer_v(HB, a.out, EIDp, COEF, ws + WS_V8 + (size_t)16384 * 512, (bf16*)QP, SSP0, HP,
                     lds + wave * 16384, sl4, smem4, nmem4, wave, NWAVES, 0, lane);
    }
    if (NREP(16) > 1) { for (int q = 0; q < 10; ++q) xcd_barrier(bar); }
#undef NREP
#undef PHASE_ON
#undef SEAM
}

static void launch_mega(const Args& a0, unsigned mask, int li, int grid, hipStream_t stream) {
    Args a = a0; a.mask = mask; a.li = li; a.rep = 0u; a.pad = 0;
    void* params[] = {&a};
    hipError_t e = hipLaunchCooperativeKernel((const void*)mega, dim3(grid), dim3(NWAVES * 64), params, LDS_BYTES, stream);
    if (e != hipSuccess) fprintf(stderr, "kernel_launch: cooperative launch failed: %s (grid %d)\n", hipGetErrorString(e), grid);
}

extern "C" void kernel_launch(void* const* d_in, const int* in_sizes, int n_in, void* d_out, int out_size, void* d_ws, size_t ws_size, hipStream_t stream) {
    static int grid = 0;
    if (grid == 0) {
        if (n_in != 15 || out_size != T * D || ws_size < WS_END) { fprintf(stderr, "kernel_launch: unexpected shapes (n_in %d out %d ws %zu)\n", n_in, out_size, ws_size); grid = -1; return; }
        int dev = 0, cus = 0, per_cu = 0;
        if (hipGetDevice(&dev) != hipSuccess || hipDeviceGetAttribute(&cus, hipDeviceAttributeMultiprocessorCount, dev) != hipSuccess) { grid = -1; return; }
        if (hipFuncSetAttribute((const void*)mega, hipFuncAttributeMaxDynamicSharedMemorySize, LDS_BYTES) != hipSuccess) { fprintf(stderr, "kernel_launch: hipFuncSetAttribute failed\n"); grid = -1; return; }
        if (hipOccupancyMaxActiveBlocksPerMultiprocessor(&per_cu, (const void*)mega, NWAVES * 64, LDS_BYTES) != hipSuccess || per_cu < 1) { fprintf(stderr, "kernel_launch: occupancy query says %d blocks per CU\n", per_cu); per_cu = 1; }
        (void)hipGetLastError();
        grid = cus;
        if (grid != 256) fprintf(stderr, "kernel_launch: note: %d CUs (tuned for 256)\n", grid);
    }
    if (grid < 0) return;
    (void)hipMemsetAsync((char*)d_ws + WS_CTL, 0, CTL_ZERO_BYTES, stream);
    Args a{};
    for (int i = 0; i < 15; ++i) a.in[i] = (const float*)d_in[i];
    a.out = (float*)d_out; a.ws = (unsigned char*)d_ws;
#define M(k) (1u << (k))
    launch_mega(a, (1u << PH_N) - 1u, 0, grid, stream);
#undef M
}
```
